# Optimizing an MI355X kernel written in HIP

```python
import jax, jax.numpy as jnp
from jax import lax
import numpy as np

D_MODEL = 2048
BATCH = 4
SEQ = 4096
DEPTH = 2

HEAD_DIM = 128
ROPE_THETA = 10000.0
GRID_W = 64
Q_BLOCK = 128
EPS = 1e-6
NEG = -1e30

A_HEADS = 4
A_Q_RANK = 512
A_KV_RANK = 512
A_NOPE = 128
A_ROPE = 64
A_V = 128
B_HEADS = 6
B_PATTERNS = ((128, 1), (512, 4), (2048, 16))
B_BLOCK = 64
C_HEADS = 6
C_KV_HEADS = 2
C_GROUP = C_HEADS // C_KV_HEADS

A_WIDTH = A_HEADS * A_V
B_WIDTH = B_HEADS * HEAD_DIM
C_WIDTH = C_HEADS * HEAD_DIM
MIX_WIDTH = A_WIDTH + B_WIDTH + C_WIDTH

IN_A = A_Q_RANK + A_KV_RANK + A_ROPE
IN_B = 3 * B_WIDTH
IN_C = C_WIDTH + 2 * C_KV_HEADS * HEAD_DIM
IN_WIDTH = IN_A + IN_B + IN_C

D_FF = -(-8 * D_MODEL // (3 * 256)) * 256

kernel_name = "hymba_mla_dilated_axial_gqa_encoder"


def rms_norm(x, g):
    xf = x.astype(jnp.float32)
    y = xf * lax.rsqrt(jnp.mean(xf * xf, axis=-1, keepdims=True) + EPS)
    return (y * g.astype(jnp.float32)).astype(x.dtype)


def rope_angles(pos, dim):
    inv = ROPE_THETA ** (-jnp.arange(0, dim, 2, dtype=jnp.float32) / dim)
    return pos.astype(jnp.float32)[:, None] * inv[None, :]


def apply_rope(x, ang):
    cos = jnp.cos(ang)[:, None, :]
    sin = jnp.sin(ang)[:, None, :]
    x1, x2 = jnp.split(x.astype(jnp.float32), 2, axis=-1)
    out = jnp.concatenate([x1 * cos - x2 * sin, x2 * cos + x1 * sin], axis=-1)
    return out.astype(x.dtype)


def dense_block_attention(q, k, v, scale):
    B, S, Hkv, G, Dk = q.shape
    nb = S // Q_BLOCK
    qb = jnp.moveaxis(q.reshape(B, nb, Q_BLOCK, Hkv, G, Dk), 1, 0)

    def attend(qblk):
        s = jnp.einsum('bqhgd,bkhd->bhgqk', qblk, k, preferred_element_type=jnp.float32) * scale
        p = jax.nn.softmax(s, axis=-1).astype(v.dtype)
        return jnp.einsum('bhgqk,bkhd->bqhgd', p, v)

    o = lax.map(attend, qb)
    return jnp.moveaxis(o, 0, 1).reshape(B, S, Hkv, G, v.shape[-1])


def dilated_pattern(q, k, v, window, dilation):
    B, S, H, D = q.shape
    half = window // (2 * dilation)
    L = S // dilation
    nb = -(-L // B_BLOCK)
    Lp = nb * B_BLOCK

    def to_res(t):
        return jnp.moveaxis(t.reshape(B, L, dilation, H, D), 2, 1)

    qr = jnp.pad(to_res(q), ((0, 0), (0, 0), (0, Lp - L), (0, 0), (0, 0)))
    kpad = ((0, 0), (0, 0), (B_BLOCK, Lp - L + B_BLOCK), (0, 0), (0, 0))
    kr = jnp.pad(to_res(k), kpad).reshape(B, dilation, nb + 2, B_BLOCK, H, D)
    vr = jnp.pad(to_res(v), kpad).reshape(B, dilation, nb + 2, B_BLOCK, H, D)
    qb = qr.reshape(B, dilation, nb, B_BLOCK, H, D)
    kb = jnp.concatenate([kr[:, :, :-2], kr[:, :, 1:-1], kr[:, :, 2:]], axis=3)
    vb = jnp.concatenate([vr[:, :, :-2], vr[:, :, 1:-1], vr[:, :, 2:]], axis=3)

    qi = jnp.arange(nb)[:, None] * B_BLOCK + jnp.arange(B_BLOCK)[None, :]
    kj = jnp.arange(nb)[:, None] * B_BLOCK - B_BLOCK + jnp.arange(3 * B_BLOCK)[None, :]
    rel = kj[:, None, :] - qi[:, :, None]
    mask = (jnp.abs(rel) <= half) & (kj[:, None, :] >= 0) & (kj[:, None, :] < L)

    s = jnp.einsum('brnqhd,brnkhd->brnhqk', qb, kb, preferred_element_type=jnp.float32) * (D ** -0.5)
    s = jnp.where(mask[:, None, :, :], s, NEG)
    m = jnp.max(s, axis=-1, keepdims=True)
    e = jnp.exp(s - m)
    den = jnp.sum(e, axis=-1)
    o = jnp.einsum('brnhqk,brnkhd->brnqhd', e.astype(v.dtype), vb, preferred_element_type=jnp.float32)
    o = o / jnp.moveaxis(den, -1, -2)[..., None]
    lse = jnp.moveaxis(m[..., 0] + jnp.log(den), -1, -2)

    def from_res(t):
        t = t.reshape((B, dilation, Lp) + t.shape[4:])[:, :, :L]
        return jnp.moveaxis(t, 1, 2).reshape((B, S) + t.shape[3:])

    return from_res(o), from_res(lse)


def mixer_mla(pa, q_norm, w_uq, kv_norm, w_ukv, ang_a):
    B, S, _ = pa.shape
    c_q, c_kv, k_rope = jnp.split(pa, [A_Q_RANK, A_Q_RANK + A_KV_RANK], axis=-1)
    q = (rms_norm(c_q, q_norm) @ w_uq).reshape(B, S, A_HEADS, A_NOPE + A_ROPE)
    q_nope, q_rope = jnp.split(q, [A_NOPE], axis=-1)
    q_rope = apply_rope(q_rope, ang_a)
    k_rope = apply_rope(k_rope[:, :, None, :], ang_a)
    kv = (rms_norm(c_kv, kv_norm) @ w_ukv).reshape(B, S, A_HEADS, A_NOPE + A_V)
    k_nope, v = jnp.split(kv, [A_NOPE], axis=-1)
    q_full = jnp.concatenate([q_nope, q_rope], axis=-1)[:, :, :, None, :]
    k_full = jnp.concatenate([k_nope, jnp.broadcast_to(k_rope, (B, S, A_HEADS, A_ROPE))], axis=-1)
    o = dense_block_attention(q_full, k_full, v, (A_NOPE + A_ROPE) ** -0.5)
    return o.reshape(B, S, A_WIDTH)


def mixer_dilated(pb, ang_1d):
    B, S, _ = pb.shape
    q, k, v = [t.reshape(B, S, B_HEADS, HEAD_DIM) for t in jnp.split(pb, 3, axis=-1)]
    q = apply_rope(q, ang_1d)
    k = apply_rope(k, ang_1d)
    outs, lses = [], []
    for window, dilation in B_PATTERNS:
        o, lse = dilated_pattern(q, k, v, window, dilation)
        outs.append(o)
        lses.append(lse)
    w = jax.nn.softmax(jnp.stack(lses, axis=0), axis=0)
    o = jnp.sum(w[..., None] * jnp.stack(outs, axis=0), axis=0)
    return o.astype(pb.dtype).reshape(B, S, B_WIDTH)


def mixer_axial_gqa(pc, q_norm, k_norm, ang_row, ang_col):
    B, S, _ = pc.shape
    q, k, v = jnp.split(pc, [C_WIDTH, C_WIDTH + C_KV_HEADS * HEAD_DIM], axis=-1)
    q = rms_norm(q.reshape(B, S, C_HEADS, HEAD_DIM), q_norm)
    k = rms_norm(k.reshape(B, S, C_KV_HEADS, HEAD_DIM), k_norm)
    v = v.reshape(B, S, C_KV_HEADS, HEAD_DIM)
    hd = HEAD_DIM // 2

    def axial(t):
        return jnp.concatenate([apply_rope(t[..., :hd], ang_row), apply_rope(t[..., hd:], ang_col)], axis=-1)

    q = axial(q).reshape(B, S, C_KV_HEADS, C_GROUP, HEAD_DIM)
    k = axial(k)
    o = dense_block_attention(q, k, v, HEAD_DIM ** -0.5)
    return o.reshape(B, S, C_WIDTH)


def setup_inputs(seed: int = 0) -> dict:
    key = jax.random.key(seed)
    ks = jax.random.split(key, 20)
    f32 = jnp.float32

    def nrm(k, shape, scale):
        return jax.random.normal(k, shape, f32) * scale

    def gain(k, shape):
        return 1.0 + 0.02 * jax.random.normal(k, shape, f32)

    return {
        "x": jax.random.normal(ks[0], (BATCH, SEQ, D_MODEL), f32),
        "attn_norm": gain(ks[1], (DEPTH, D_MODEL)),
        "w_in": nrm(ks[2], (DEPTH, D_MODEL, IN_WIDTH), D_MODEL ** -0.5),
        "a_q_norm": gain(ks[3], (DEPTH, A_Q_RANK)),
        "a_w_uq": nrm(ks[4], (DEPTH, A_Q_RANK, A_HEADS * (A_NOPE + A_ROPE)), A_Q_RANK ** -0.5),
        "a_kv_norm": gain(ks[5], (DEPTH, A_KV_RANK)),
        "a_w_ukv": nrm(ks[6], (DEPTH, A_KV_RANK, A_HEADS * (A_NOPE + A_V)), A_KV_RANK ** -0.5),
        "c_q_norm": gain(ks[7], (DEPTH, HEAD_DIM)),
        "c_k_norm": gain(ks[8], (DEPTH, HEAD_DIM)),
        "out_norm": gain(ks[9], (DEPTH, MIX_WIDTH)),
        "w_out": nrm(ks[10], (DEPTH, MIX_WIDTH, D_MODEL), MIX_WIDTH ** -0.5),
        "ffn_norm": gain(ks[11], (DEPTH, D_MODEL)),
        "w_gate": nrm(ks[12], (DEPTH, D_MODEL, D_FF), D_MODEL ** -0.5),
        "w_up": nrm(ks[13], (DEPTH, D_MODEL, D_FF), D_MODEL ** -0.5),
        "w_down": nrm(ks[14], (DEPTH, D_FF, D_MODEL), D_FF ** -0.5),
        "final_norm": gain(ks[15], (D_MODEL,)),
    }


def reference(x, attn_norm, w_in, a_q_norm, a_w_uq, a_kv_norm, a_w_ukv, c_q_norm, c_k_norm,
              out_norm, w_out, ffn_norm, w_gate, w_up, w_down, final_norm):
    B, S, _ = x.shape
    rows = S // GRID_W
    pos = jnp.arange(S, dtype=jnp.int32)
    row = jnp.repeat(jnp.arange(rows, dtype=jnp.int32), GRID_W)
    col = jnp.tile(jnp.arange(GRID_W, dtype=jnp.int32), rows)
    ang_1d = rope_angles(pos, HEAD_DIM)
    ang_a = rope_angles(pos, A_ROPE)
    ang_row = rope_angles(row, HEAD_DIM // 2)
    ang_col = rope_angles(col, HEAD_DIM // 2)

    for l in range(DEPTH):
        h = rms_norm(x, attn_norm[l])
        proj = jnp.einsum('bsd,de->bse', h, w_in[l])
        pa, pb, pc = jnp.split(proj, [IN_A, IN_A + IN_B], axis=-1)
        ya = mixer_mla(pa, a_q_norm[l], a_w_uq[l], a_kv_norm[l], a_w_ukv[l], ang_a)
        yb = mixer_dilated(pb, ang_1d)
        yc = mixer_axial_gqa(pc, c_q_norm[l], c_k_norm[l], ang_row, ang_col)
        g = out_norm[l]
        y = jnp.concatenate([
            rms_norm(ya, g[:A_WIDTH]),
            rms_norm(yb, g[A_WIDTH:A_WIDTH + B_WIDTH]),
            rms_norm(yc, g[A_WIDTH + B_WIDTH:]),
        ], axis=-1).astype(x.dtype)
        x = x + jnp.einsum('bse,ed->bsd', y, w_out[l])
        h = rms_norm(x, ffn_norm[l])
        ff = jax.nn.silu(h @ w_gate[l]) * (h @ w_up[l])
        x = x + ff @ w_down[l]
    return rms_norm(x, final_norm)
```

```cpp
#include <hip/hip_runtime.h>
#include <hip/hip_cooperative_groups.h>
#include <cstdio>
#include <cstdint>
namespace cg = cooperative_groups;

#ifndef PROBE_ATT
#define PROBE_ATT 0
#endif
#ifndef PROBE_GEMM
#define PROBE_GEMM 0
#endif
#ifndef PROBE_ELEM
#define PROBE_ELEM 0
#endif
#ifndef MK_SINGLE
#define MK_SINGLE 1
#endif

#define LAS __attribute__((address_space(3)))
typedef unsigned short bf16_t;
typedef short bf16x8 __attribute__((ext_vector_type(8)));
typedef short s16x4 __attribute__((ext_vector_type(4)));
typedef float f32x4 __attribute__((ext_vector_type(4)));
typedef float f32x2 __attribute__((ext_vector_type(2)));
typedef float f32x16 __attribute__((ext_vector_type(16)));
typedef unsigned u32x4 __attribute__((ext_vector_type(4)));
typedef unsigned u32x2 __attribute__((ext_vector_type(2)));
typedef unsigned long long u64;
constexpr float FXS = 1048576.f, FXI = 1.f / 1048576.f;
__device__ __forceinline__ void fx_add(u64* p, float v) { atomicAdd(p, (u64)(v * FXS + 0.5f)); }
__device__ __forceinline__ float fx_get(const u64* p) { return (float)(*p) * FXI; }

constexpr int NB = 4, SEQ = 4096, T = NB * SEQ, DM = 2048, INW = 4672, INP = 4864, DFF = 5632;
constexpr int NWAVES = 8;
constexpr int NPH = 14;
constexpr float EPS = 1e-6f;
constexpr int PA_CQ = 0, PA_CKV = 512, PA_KR = 1024, PB_Q = 1088, PB_K = 1856, PB_V = 2624, PC_Q = 3392, PC_K = 4160, PC_V = 4416;

constexpr size_t WS_CTL = 0, CTL_BYTES = 4u << 20;
constexpr size_t RSS_OFF = 512 * 1024;
constexpr size_t YSS_OFF = 1024 * 1024;
constexpr size_t CSS_OFF = 2048 * 1024;
constexpr size_t WS_ROPEA = WS_CTL + CTL_BYTES;
constexpr size_t WS_ROPE1 = WS_ROPEA + (size_t)4096 * 32 * 8;
constexpr size_t WS_W = WS_ROPE1 + (size_t)4096 * 64 * 8;
constexpr size_t W_IN = 0, W_UQ = W_IN + (size_t)INP * DM * 2, W_UKV = W_UQ + (size_t)768 * 512 * 2, W_OUT = W_UKV + (size_t)1024 * 512 * 2,
                 W_GU = W_OUT + (size_t)DM * DM * 2, W_DN = W_GU + (size_t)2 * DFF * DM * 2, W_LAYER = W_DN + (size_t)DM * DFF * 2;
constexpr size_t WS_XN = WS_W + 2 * W_LAYER;
constexpr size_t WS_BIG = WS_XN + (size_t)T * DM * 2;
constexpr size_t BIG_BYTES = (size_t)T * DFF * 2;
constexpr size_t WS_QA = WS_BIG + BIG_BYTES;
constexpr size_t WS_KA = WS_QA + (size_t)T * 768 * 2;
constexpr size_t WS_VA = WS_KA + (size_t)T * 768 * 2;
constexpr size_t WS_END = WS_VA + (size_t)T * 512 * 2;
static_assert((size_t)T * INP * 2 <= BIG_BYTES, "PROJ fits under FF");
static_assert(WS_END <= (size_t)536870912, "workspace map fits 512 MiB");

constexpr int LDS_SLOT = 139264;
constexpr int LDS_BYTES = LDS_SLOT + 256;

__device__ __forceinline__ unsigned cvt_pk_bf16(float lo, float hi) { unsigned r; asm volatile("v_cvt_pk_bf16_f32 %0, %1, %2" : "=v"(r) : "v"(lo), "v"(hi)); return r; }
__device__ __forceinline__ float bf2f(unsigned short b) { return __uint_as_float(((unsigned)b) << 16); }
__device__ __forceinline__ float bflo(unsigned w) { return __uint_as_float(w << 16); }
__device__ __forceinline__ float bfhi(unsigned w) { return __uint_as_float(w & 0xffff0000u); }
__device__ __forceinline__ unsigned short f2bf(float f) { return (unsigned short)(cvt_pk_bf16(f, f) & 0xffffu); }
__device__ __forceinline__ float wave_sum(float v, const int lane) {
#pragma unroll
    for (int o = 1; o < 64; o <<= 1) v += __builtin_bit_cast(float, __builtin_amdgcn_ds_bpermute((lane ^ o) << 2, __builtin_bit_cast(int, v)));
    return v;
}


#define XB_TMO      128
#define XB_XCNT(j)  (256  + 64 * (j))
#define XB_XSUB(j)  (1280 + 64 * (j))
#define XB_XGEN(j)  (2304 + 64 * (j))
#define XB_TOP      3328
#define XB_TOPGEN   3392
#define XCD_BAR_WORDS 3456
#define XB_SPIN_CAP (1u << 18)
__device__ __forceinline__ unsigned xb_ld(unsigned* p)              { return __hip_atomic_load(p, __ATOMIC_RELAXED, __HIP_MEMORY_SCOPE_AGENT); }
__device__ __forceinline__ unsigned xb_add(unsigned* p, unsigned v) { return __hip_atomic_fetch_add(p, v, __ATOMIC_RELAXED, __HIP_MEMORY_SCOPE_AGENT); }
__device__ __forceinline__ unsigned xb_xcc_id() { return (unsigned)__builtin_amdgcn_s_getreg((3 << 11) | 20) & 0xFu; }
#define XB_SPIN(cond, bar) do { unsigned _sp = 0; while (cond) { __builtin_amdgcn_s_sleep(1); \
    if ((++_sp & 255u) == 0u) { if (xb_ld(&(bar)[XB_TMO])) break; if (_sp > XB_SPIN_CAP) { atomicAdd(&(bar)[XB_TMO], 1u); break; } } } } while (0)
struct XcdBarrier { unsigned* bar; unsigned x; volatile LAS unsigned* st; };
__device__ __forceinline__ XcdBarrier xcd_barrier_post(unsigned* bar, volatile LAS unsigned* st) {
    XcdBarrier b; b.bar = bar; b.x = xb_xcc_id(); b.st = st;
    if (threadIdx.x == 0) (void)xb_add(&bar[XB_XCNT(b.x)], 1u);
    return b;
}
__device__ __forceinline__ void xcd_barrier_complete(unsigned* bar, unsigned x, unsigned& nloc, unsigned& nx) {
    const unsigned G = gridDim.x * gridDim.y * gridDim.z;
    unsigned sum, cnt, mine, sp = 0u;
    for (;;) {
        sum = 0u; cnt = 0u; mine = 0u;
#pragma unroll
        for (unsigned j = 0; j < 16; ++j) { const unsigned c = xb_ld(&bar[XB_XCNT(j)]); sum += c; cnt += (c > 0u) ? 1u : 0u; mine = (j == x) ? c : mine; }
        if (sum == G) break;
        __builtin_amdgcn_s_sleep(1);
        if ((++sp & 255u) == 0u) { if (xb_ld(&bar[XB_TMO])) break; if (sp > XB_SPIN_CAP) { atomicAdd(&bar[XB_TMO], 1u); break; } }
    }
    nloc = mine > 0u ? mine : 1u; nx = cnt > 0u ? cnt : 1u;
}
__device__ __forceinline__ void xcd_barrier(const XcdBarrier& b) {
    asm volatile("s_waitcnt vmcnt(0)" ::: "memory");
    __syncthreads();
    if (threadIdx.x == 0) {
        unsigned* bar = b.bar;
        __builtin_amdgcn_s_waitcnt(0);
        unsigned nloc = b.st[0], nx = b.st[1];
        if (nloc == 0u) { xcd_barrier_complete(bar, b.x, nloc, nx); b.st[0] = nloc; b.st[1] = nx; }
        const unsigned old = xb_add(&bar[XB_XSUB(b.x)], 1u);
        const unsigned gen = old / nloc;
        if (old + 1u == (gen + 1u) * nloc) {
            __builtin_amdgcn_fence(__ATOMIC_RELEASE, "agent");
            asm volatile("s_waitcnt vmcnt(0)" ::: "memory");
            const unsigned og = xb_add(&bar[XB_TOP], 1u);
            const unsigned tg = og / nx;
            if (og + 1u == (tg + 1u) * nx) xb_add(&bar[XB_TOPGEN], 1u);
            else XB_SPIN(xb_ld(&bar[XB_TOPGEN]) == tg, bar);
            __builtin_amdgcn_fence(__ATOMIC_ACQUIRE, "agent");
            xb_add(&bar[XB_XGEN(b.x)], 1u);
            asm volatile("s_waitcnt vmcnt(0)" ::: "memory");
        } else {
            XB_SPIN(xb_ld(&bar[XB_XGEN(b.x)]) == gen, bar);
            __builtin_amdgcn_fence(__ATOMIC_ACQUIRE, "agent");
            asm volatile("s_waitcnt vmcnt(0)" ::: "memory");
        }
    }
    __syncthreads();
}

namespace pg8 {
constexpr int BM = 256, BK = 64, HALF = 128, HTB = HALF * BK * 2, STAGE_BYTES = 8 * HTB, NXCD = 8, WGM = 8;
__host__ __device__ __forceinline__ int lds_byte(int r, int c) { const int st = (r >> 4) * 2 + (c >> 5), rr = r & 15, cc = c & 31, ob = rr * 64 + cc * 2; return st * 1024 + (ob ^ (((ob >> 9) & 1) << 5)); }
__host__ __device__ __forceinline__ void stage_rc(int b, int& R, int& C) { const int st = b / 1024, sb = b % 1024, swz = sb ^ (((sb >> 9) & 1) << 5); R = (st >> 1) * 16 + swz / 64; C = (st & 1) * 32 + (swz % 64) / 2; }
__host__ __device__ __forceinline__ int perm32(int rho) { const int n = rho >> 4, i = rho & 15; return 8 * (i >> 2) + 4 * n + (i & 3); }

struct Unit { int pm, pn; };
struct Gemm { const bf16_t* A; const bf16_t* Bt; int lda, K; };

struct StaticOrder {
    int nM, nN, nwg, G, c;
    __device__ void init(int M, int N, int G_, int c_) { nM = M / BM; nN = N / BM; nwg = nM * nN; G = G_; c = c_; }
    __device__ bool next(int i, Unit& u) const {
        const long L = (long)i * G + c; if (L >= nwg) return false;
        int wgid = (int)L; { const int q = nwg / NXCD, r = nwg % NXCD, xcd = wgid % NXCD, off = wgid / NXCD; wgid = (xcd < r ? xcd * (q + 1) : r * (q + 1) + (xcd - r) * q) + off; }
        const int nig = WGM * nN, gid = wgid / nig, fm = gid * WGM, gsz = (nM - fm) < WGM ? (nM - fm) : WGM;
        u.pm = fm + ((wgid % nig) % gsz); u.pn = (wgid % nig) / gsz; return true;
    }
};

struct EpiRes {
    static constexpr bool KSCALE = true;
    static constexpr bool PERM = true;
    const float* base32; const bf16_t* base16; float* out32; bf16_t* out16; int ldc; u64* rss; const u64* yss;
    __device__ __forceinline__ void kscale(f32x4 (&acc)[2][2][4][2], const Unit& u, int t, int tid_) const {
        asm volatile("" : "+v"(tid_)); const int row0 = u.pm * BM + (__builtin_amdgcn_readfirstlane(tid_ >> 6) >> 2) * 64 + (tid_ & 15);
#pragma unroll
        for (int ai = 0; ai < 2; ++ai)
#pragma unroll
            for (int m = 0; m < 4; ++m) { const u64* yq = yss + (size_t)(row0 + ai * HALF + m * 16) * 4 + (t == 8 ? 0 : 1);
                const float wp = (t == 8) ? (1.f / 512.f) : (1.f / 768.f);
                const float vp = fx_get(yq) * wp + 1e-6f, vn = fx_get(yq + 1) * (1.f / 768.f) + 1e-6f;
                const float sc = __builtin_amdgcn_sqrtf(vn * __builtin_amdgcn_rcpf(vp));
#pragma unroll
                for (int bj = 0; bj < 2; ++bj)
#pragma unroll
                    for (int n = 0; n < 2; ++n) acc[ai][bj][m][n] *= sc;
                asm volatile("" ::: "memory"); }
    }
    __device__ __forceinline__ void operator()(const f32x4 (&acc)[2][2][4][2], const Unit& u, int tid_) const {
        asm volatile("" : "+v"(tid_)); const int lane = tid_ & 63, wid_ = __builtin_amdgcn_readfirstlane(tid_ >> 6), wr = wid_ >> 2, wc = wid_ & 3, fr = lane & 15, fq = lane >> 4;
        const int row0 = u.pm * BM + wr * 64 + fr, col0 = u.pn * BM + wc * 32 + 8 * fq;
#pragma unroll
        for (int ai = 0; ai < 2; ++ai)
#pragma unroll
            for (int m = 0; m < 4; ++m) { const size_t off = (size_t)(row0 + ai * HALF + m * 16) * ldc + col0; float ss = 0.f;
                const float rc = yss ? 1.0f / sqrtf(fx_get(yss + (size_t)(row0 + ai * HALF + m * 16) * 4 + 2) * (1.f / 768.f) + 1e-6f) : 1.0f;
#pragma unroll
                for (int bj = 0; bj < 2; ++bj) { f32x4 b0, b1;
                    if (base16) { const u32x4 w = *(const u32x4*)(base16 + off + bj * HALF); b0 = (f32x4){bflo(w.x), bfhi(w.x), bflo(w.y), bfhi(w.y)}; b1 = (f32x4){bflo(w.z), bfhi(w.z), bflo(w.w), bfhi(w.w)}; }
                    else { b0 = *(const f32x4*)(base32 + off + bj * HALF); b1 = *(const f32x4*)(base32 + off + bj * HALF + 4); }
                    const f32x4 v0 = b0 + acc[ai][bj][m][0] * rc, v1 = b1 + acc[ai][bj][m][1] * rc;
                    if (out16) { u32x4 w; w.x = cvt_pk_bf16(v0[0], v0[1]); w.y = cvt_pk_bf16(v0[2], v0[3]); w.z = cvt_pk_bf16(v1[0], v1[1]); w.w = cvt_pk_bf16(v1[2], v1[3]); *(u32x4*)(out16 + off + bj * HALF) = w; }
                    if (out32) { *(f32x4*)(out32 + off + bj * HALF) = v0; *(f32x4*)(out32 + off + bj * HALF + 4) = v1; }
                    ss += (v0[0] * v0[0] + v0[1] * v0[1]) + (v0[2] * v0[2] + v0[3] * v0[3]) + (v1[0] * v1[0] + v1[1] * v1[1]) + (v1[2] * v1[2] + v1[3] * v1[3]); }
                if (rss) {
                    ss += __builtin_bit_cast(float, __builtin_amdgcn_ds_bpermute((lane ^ 16) << 2, __builtin_bit_cast(int, ss)));
                    ss += __builtin_bit_cast(float, __builtin_amdgcn_ds_bpermute((lane ^ 32) << 2, __builtin_bit_cast(int, ss)));
                    if (fq == 0) fx_add(rss + row0 + ai * HALF + m * 16, ss); } }
    }
};
struct EpiBf {
    static constexpr bool KSCALE = false;
    static constexpr bool PERM = true;
    bf16_t* O; bf16_t* O2; int ldc; int mode; const u64* rss; int rstride; float invw; u64* css;
    __device__ __forceinline__ void operator()(const f32x4 (&acc)[2][2][4][2], const Unit& u, int tid_) const {
        asm volatile("" : "+v"(tid_)); const int lane = tid_ & 63, wid_ = __builtin_amdgcn_readfirstlane(tid_ >> 6), wr = wid_ >> 2, wc = wid_ & 3, fr = lane & 15, fq = lane >> 4;
        const int row0 = u.pm * BM + wr * 64 + fr, cw = wc * 32 + 8 * fq;
        if (mode == 2) {
#pragma unroll
            for (int ai = 0; ai < 2; ++ai)
#pragma unroll
                for (int m = 0; m < 4; ++m) { const int r = row0 + ai * HALF + m * 16; bf16_t* rowp = O + (size_t)r * ldc + u.pn * HALF + cw;
                    const float rs = 1.0f / sqrtf(fx_get(rss + (size_t)r * rstride) * invw + 1e-6f);
                    float v[8];
#pragma unroll
                    for (int n = 0; n < 2; ++n)
#pragma unroll
                        for (int j = 0; j < 4; ++j) { const float g = acc[ai][0][m][n][j] * rs, up = acc[ai][1][m][n][j] * rs;
                            const float e = __builtin_amdgcn_exp2f(-g * 1.4426950408889634f); v[n * 4 + j] = g * __builtin_amdgcn_rcpf(1.0f + e) * up; }
                    u32x4 w; w.x = cvt_pk_bf16(v[0], v[1]); w.y = cvt_pk_bf16(v[2], v[3]); w.z = cvt_pk_bf16(v[4], v[5]); w.w = cvt_pk_bf16(v[6], v[7]);
                    *(u32x4*)rowp = w; }
        } else {
#pragma unroll
            for (int ai = 0; ai < 2; ++ai)
#pragma unroll
                for (int m = 0; m < 4; ++m) { const size_t r = (size_t)(row0 + ai * HALF + m * 16);
                    const float rs = rss ? 1.0f / sqrtf(fx_get(rss + r * rstride) * invw + 1e-6f) : 1.0f; float ss = 0.f;
#pragma unroll
                    for (int bj = 0; bj < 2; ++bj) { const f32x4 v0 = acc[ai][bj][m][0] * rs, v1 = acc[ai][bj][m][1] * rs;
                        ss += (v0[0] * v0[0] + v0[1] * v0[1]) + (v0[2] * v0[2] + v0[3] * v0[3]) + (v1[0] * v1[0] + v1[1] * v1[1]) + (v1[2] * v1[2] + v1[3] * v1[3]);
                        u32x4 w; w.x = cvt_pk_bf16(v0[0], v0[1]); w.y = cvt_pk_bf16(v0[2], v0[3]); w.z = cvt_pk_bf16(v1[0], v1[1]); w.w = cvt_pk_bf16(v1[2], v1[3]);
                        bf16_t* p;
                        if (mode == 0) p = O + r * ldc + u.pn * BM + bj * HALF + cw;
                        else p = (bj == 0) ? (O + r * 768 + u.pn * 192 + cw) : (O2 + r * 512 + u.pn * 128 + cw);
                        *(u32x4*)p = w; }
                    if (css != nullptr && u.pn < 4) {
                        ss += __builtin_bit_cast(float, __builtin_amdgcn_ds_bpermute((lane ^ 16) << 2, __builtin_bit_cast(int, ss)));
                        ss += __builtin_bit_cast(float, __builtin_amdgcn_ds_bpermute((lane ^ 32) << 2, __builtin_bit_cast(int, ss)));
                        if (fq == 0) fx_add(css + r * 2 + (u.pn >> 1), ss); } }
        }
    }
};

template <class Epi, class Sched, bool ALIGN_EPI = true, bool SP2 = true>
__device__ __forceinline__ void gemm_phase(LAS unsigned char* lds, const Gemm g, const Sched& S, const Epi& E, const int tid) {
    const int wid = __builtin_amdgcn_readfirstlane(tid >> 6), lane = tid & 63, wr = wid >> 2, wc = wid & 3, fr = lane & 15, fq = lane >> 4;
    const int K = g.K, nt = K / BK, lda = g.lda;
    unsigned voffA[2], voffB[2];
#pragma unroll
    for (int i = 0; i < 2; ++i) { int R, C; stage_rc(tid * 16 + i * 8192, R, C); const int Rb = Epi::PERM ? ((R & ~31) + perm32(R & 31)) : R;
        voffA[i] = (unsigned)(R * lda + C) * 2u; voffB[i] = (unsigned)(Rb * K + C) * 2u; }
    const size_t kstep = (size_t)(BK * 2);
    const size_t hstepA = (size_t)HALF * lda * 2, hstepB = (size_t)HALF * K * 2;
    const size_t tstepA = 2 * hstepA, tstepB = 2 * hstepB;
    const unsigned ldsw = (unsigned)wid * 1024u;
    const int aoff = lds_byte(wr * 64 + fr, fq * 8), boff = lds_byte(wc * 32 + fr, fq * 8);
#define PG8_SA(b, h) (((b) * 2 + (h)) * HTB)
#define PG8_SB(b, h) ((4 + (b) * 2 + (h)) * HTB)
#define PG8_STAGE(bufoff, gbase, voff) do { _Pragma("unroll") for (int _i = 0; _i < 2; ++_i) \
        __builtin_amdgcn_global_load_lds((const unsigned*)((const char*)(gbase) + (voff)[_i]), (LAS unsigned*)(lds + (bufoff) + ldsw + _i * 8192), 16, 0, 0); } while (0)
#define PG8_LDA(dst, b, h) do { _Pragma("unroll") for (int m = 0; m < 4; ++m) _Pragma("unroll") for (int k = 0; k < 2; ++k) dst[m][k] = *(const LAS bf16x8*)(lds + PG8_SA(b, h) + aoff + m * 2048 + k * 1024); } while (0)
#define PG8_LDB(dst, b, h) do { _Pragma("unroll") for (int n = 0; n < 2; ++n) _Pragma("unroll") for (int k = 0; k < 2; ++k) dst[n][k] = *(const LAS bf16x8*)(lds + PG8_SB(b, h) + boff + n * 2048 + k * 1024); } while (0)
#define PG8_MMA(ai, bj, At, Bt) do { __builtin_amdgcn_s_setprio(1); _Pragma("unroll") for (int m = 0; m < 4; ++m) _Pragma("unroll") for (int n = 0; n < 2; ++n) _Pragma("unroll") for (int k = 0; k < 2; ++k) \
        acc[ai][bj][m][n] = __builtin_amdgcn_mfma_f32_16x16x32_bf16(Bt[n][k], At[m][k], acc[ai][bj][m][n], 0, 0, 0); __builtin_amdgcn_s_setprio(0); } while (0)
#define PG8_WAIT_V(n) asm volatile("s_waitcnt vmcnt(" #n ")" ::: "memory")
#define PG8_WAIT_L(n) asm volatile("s_waitcnt lgkmcnt(" #n ")" ::: "memory")
#define PG8_BAR __builtin_amdgcn_s_barrier()
#define PG8_SCHED __builtin_amdgcn_sched_barrier(0)
    Unit cur, nxt; int ui = 0;
    if (!S.next(0, cur)) return;
    f32x4 acc[2][2][4][2];
#pragma unroll
    for (int a = 0; a < 2; ++a)
#pragma unroll
        for (int b = 0; b < 2; ++b)
#pragma unroll
            for (int m = 0; m < 4; ++m)
#pragma unroll
                for (int n = 0; n < 2; ++n) acc[a][b][m][n] = (f32x4){0.f, 0.f, 0.f, 0.f};
    bf16x8 At[4][2], B0[2][2], B1[2][2];
    const char* cA = (const char*)g.A + (size_t)cur.pm * tstepA; const char* cB = (const char*)g.Bt + (size_t)cur.pn * tstepB;
    if constexpr (SP2) {
        PG8_STAGE(PG8_SB(0, 0), cB, voffB); PG8_STAGE(PG8_SB(0, 1), cB + hstepB, voffB); PG8_STAGE(PG8_SA(0, 0), cA, voffA); PG8_STAGE(PG8_SA(0, 1), cA + hstepA, voffA);
        if (wr == 1) PG8_BAR;
        PG8_WAIT_V(2); PG8_BAR;
        PG8_STAGE(PG8_SB(1, 0), cB + kstep, voffB); PG8_STAGE(PG8_SA(1, 0), cA + kstep, voffA); PG8_STAGE(PG8_SB(1, 1), cB + hstepB + kstep, voffB);
        PG8_WAIT_V(6); PG8_BAR;
    } else {
        PG8_STAGE(PG8_SB(0, 0), cB, voffB); PG8_STAGE(PG8_SA(0, 0), cA, voffA); PG8_STAGE(PG8_SB(0, 1), cB + hstepB, voffB); PG8_STAGE(PG8_SA(0, 1), cA + hstepA, voffA);
        if (wr == 1) PG8_BAR;
        PG8_WAIT_V(4); PG8_BAR;
        PG8_STAGE(PG8_SB(1, 0), cB + kstep, voffB); PG8_STAGE(PG8_SA(1, 0), cA + kstep, voffA); PG8_STAGE(PG8_SB(1, 1), cB + hstepB + kstep, voffB);
        PG8_WAIT_V(6); PG8_BAR;
    }
    for (;;) {
        const bool has_next = S.next(ui + 1, nxt);
        const char* nA = has_next ? (const char*)g.A + (size_t)nxt.pm * tstepA : cA; const char* nB = has_next ? (const char*)g.Bt + (size_t)nxt.pn * tstepB : cB;
        for (int t = 0; t < nt; t += 2) {
            const bool last = (t == nt - 2);
            const char* a1 = cA + (size_t)(t + 1) * kstep;
            const char* a2 = last ? nA : cA + (size_t)(t + 2) * kstep; const char* b2 = last ? nB : cB + (size_t)(t + 2) * kstep;
            const char* a3 = a2 + kstep; const char* b3 = b2 + kstep;
            if constexpr (Epi::KSCALE) { if (E.yss != nullptr && (t == 8 || t == 20)) E.kscale(acc, cur, t, tid); }
            if constexpr (SP2) {
            PG8_LDB(B0, 0, 0); PG8_LDB(B1, 0, 1); PG8_SCHED; PG8_LDA(At, 0, 0); PG8_STAGE(PG8_SA(1, 1), a1 + hstepA, voffA);
            PG8_WAIT_V(8); PG8_WAIT_L(0); PG8_BAR; PG8_MMA(0, 0, At, B0); PG8_MMA(0, 1, At, B1); PG8_BAR; PG8_SCHED;
            PG8_LDA(At, 0, 1); PG8_STAGE(PG8_SB(0, 0), b2, voffB); PG8_STAGE(PG8_SB(0, 1), b2 + hstepB, voffB); PG8_STAGE(PG8_SA(0, 0), a2, voffA);
            PG8_WAIT_V(8); PG8_WAIT_L(0); PG8_BAR; PG8_MMA(1, 0, At, B0); PG8_MMA(1, 1, At, B1); PG8_BAR; PG8_SCHED;
            PG8_LDB(B0, 1, 0); PG8_LDB(B1, 1, 1); PG8_SCHED; PG8_LDA(At, 1, 0); PG8_STAGE(PG8_SA(0, 1), a2 + hstepA, voffA);
            PG8_WAIT_V(8); PG8_WAIT_L(0); PG8_BAR; PG8_MMA(0, 0, At, B0); PG8_MMA(0, 1, At, B1); PG8_BAR; PG8_SCHED;
            PG8_LDA(At, 1, 1); PG8_STAGE(PG8_SB(1, 0), b3, voffB); PG8_STAGE(PG8_SB(1, 1), b3 + hstepB, voffB); PG8_STAGE(PG8_SA(1, 0), a3, voffA);
            PG8_WAIT_V(8); PG8_WAIT_L(0); PG8_BAR; PG8_MMA(1, 0, At, B0); PG8_MMA(1, 1, At, B1); PG8_BAR; PG8_SCHED;
            } else {
            PG8_LDB(B0, 0, 0); PG8_SCHED; PG8_LDA(At, 0, 0); PG8_STAGE(PG8_SA(1, 1), a1 + hstepA, voffA);
            PG8_WAIT_L(8); PG8_BAR; PG8_WAIT_L(0); PG8_MMA(0, 0, At, B0); PG8_BAR; PG8_SCHED;
            PG8_LDB(B1, 0, 1); PG8_STAGE(PG8_SB(0, 0), b2, voffB);
            PG8_BAR; PG8_WAIT_L(0); PG8_MMA(0, 1, At, B1); PG8_BAR;
            PG8_LDA(At, 0, 1); PG8_STAGE(PG8_SA(0, 0), a2, voffA);
            PG8_BAR; PG8_WAIT_L(0); PG8_MMA(1, 0, At, B0); PG8_BAR; PG8_SCHED;
            PG8_STAGE(PG8_SB(0, 1), b2 + hstepB, voffB);
            PG8_WAIT_V(6); PG8_BAR; PG8_MMA(1, 1, At, B1); PG8_BAR;
            PG8_LDB(B0, 1, 0); PG8_SCHED; PG8_LDA(At, 1, 0); PG8_STAGE(PG8_SA(0, 1), a2 + hstepA, voffA);
            PG8_WAIT_L(8); PG8_BAR; PG8_WAIT_L(0); PG8_MMA(0, 0, At, B0); PG8_BAR; PG8_SCHED;
            PG8_LDB(B1, 1, 1); PG8_STAGE(PG8_SB(1, 0), b3, voffB);
            PG8_BAR; PG8_WAIT_L(0); PG8_MMA(0, 1, At, B1); PG8_BAR;
            PG8_LDA(At, 1, 1); PG8_STAGE(PG8_SA(1, 0), a3, voffA);
            PG8_BAR; PG8_WAIT_L(0); PG8_MMA(1, 0, At, B0); PG8_BAR; PG8_SCHED;
            PG8_STAGE(PG8_SB(1, 1), b3 + hstepB, voffB);
            PG8_WAIT_V(6); PG8_BAR; PG8_MMA(1, 1, At, B1); PG8_BAR;
            }
        }
        if constexpr (ALIGN_EPI) { if (wr == 0) PG8_BAR; }
        E(acc, cur, tid);
        if (!has_next) break;
#pragma unroll
        for (int a = 0; a < 2; ++a)
#pragma unroll
            for (int b = 0; b < 2; ++b)
#pragma unroll
                for (int m = 0; m < 4; ++m)
#pragma unroll
                    for (int n = 0; n < 2; ++n) acc[a][b][m][n] = (f32x4){0.f, 0.f, 0.f, 0.f};
        cur = nxt; cA = nA; cB = nB; ++ui;
        if constexpr (ALIGN_EPI) { if (wr == 1) PG8_BAR; }
    }
    PG8_WAIT_V(0);
    if constexpr (!ALIGN_EPI) { if (wr == 0) PG8_BAR; }
    PG8_BAR;
#undef PG8_SA
#undef PG8_SB
#undef PG8_STAGE
#undef PG8_LDA
#undef PG8_LDB
#undef PG8_MMA
#undef PG8_WAIT_V
#undef PG8_WAIT_L
#undef PG8_BAR
#undef PG8_SCHED
}
}

namespace att {
constexpr int KVBLK = 64, QBLK = 32;
constexpr float THR = 8.f;
#define SBAR() __builtin_amdgcn_sched_barrier(0)
__device__ __forceinline__ int crow(int r, int hi) { return (r & 3) + 8 * (r >> 2) + 4 * hi; }
__device__ __forceinline__ float dbias(int d) {
    const int ad = d < 0 ? -d : d;
    const int c = (ad <= 64 ? 1 : 0) + ((((d & 3) == 0) && ad <= 256) ? 1 : 0) + ((((d & 15) == 0) && ad <= 1024) ? 1 : 0);
    return c == 0 ? -__builtin_inff() : (c == 1 ? 0.f : (c == 2 ? 1.f : 1.5849625007211562f));
}
template <bool MASK>
__device__ __forceinline__ void partialSM(f32x16& p0, f32x16& p1, float& m_reg, float& mn, float& alpha, const float C, const float thr, const int dbase, const int dwave) {
    if constexpr (MASK) {
        if ((dwave - 31 > 256 && dwave + 63 <= 1024) || (dwave + 63 < -256 && dwave - 31 >= -1024)) {
            const int tl = dbase & 15; const float ninf = -__builtin_inff();
#pragma unroll
            for (int r = 0; r < 8; ++r) { const bool hit = tl == ((16 - ((r & 3) + 8 * (r >> 2))) & 15);
                p0[r] = hit ? p0[r] * C : ninf; p0[r + 8] = hit ? p0[r + 8] * C : ninf; p1[r] = hit ? p1[r] * C : ninf; p1[r + 8] = hit ? p1[r + 8] * C : ninf; }
        } else {
#pragma unroll
            for (int r = 0; r < 16; ++r) { const int d = dbase + (r & 3) + 8 * (r >> 2); p0[r] = fmaf(p0[r], C, dbias(d)); p1[r] = fmaf(p1[r], C, dbias(d + 32)); }
        }
        float pmax = p0[0];
#pragma unroll
        for (int r = 1; r < 16; ++r) pmax = fmaxf(pmax, p0[r]);
#pragma unroll
        for (int r = 0; r < 16; ++r) pmax = fmaxf(pmax, p1[r]);
        { auto rr = __builtin_amdgcn_permlane32_swap(__float_as_uint(pmax), __float_as_uint(pmax), false, false);
          pmax = fmaxf(__uint_as_float(rr[0]), __uint_as_float(rr[1])); }
        if (__builtin_expect(__all(pmax - m_reg <= thr), 1)) { mn = m_reg; alpha = 1.f; }
        else { mn = fmaxf(m_reg, pmax); alpha = __builtin_amdgcn_exp2f(m_reg - mn); m_reg = mn; }
#pragma unroll
        for (int r = 0; r < 16; ++r) { p0[r] = p0[r] - mn; p1[r] = p1[r] - mn; }
#pragma unroll
        for (int r = 0; r < 16; ++r) p0[r] = __builtin_amdgcn_exp2f(p0[r]);
    } else {
        float pmax = p0[0];
#pragma unroll
        for (int r = 1; r < 16; ++r) pmax = fmaxf(pmax, p0[r]);
#pragma unroll
        for (int r = 0; r < 16; ++r) pmax = fmaxf(pmax, p1[r]);
        { auto rr = __builtin_amdgcn_permlane32_swap(__float_as_uint(pmax), __float_as_uint(pmax), false, false);
          pmax = fmaxf(__uint_as_float(rr[0]), __uint_as_float(rr[1])); }
        if (__builtin_expect(__all(pmax - m_reg <= thr), 1)) { mn = m_reg; alpha = 1.f; }
        else { mn = fmaxf(m_reg, pmax); alpha = __builtin_amdgcn_exp2f((m_reg - mn) * C); m_reg = mn; }
        const float mnC = -mn * C;
#pragma unroll
        for (int r = 0; r < 16; ++r) p0[r] = fmaf(p0[r], C, mnC);
#pragma unroll
        for (int r = 0; r < 16; ++r) p1[r] = fmaf(p1[r], C, mnC);
#pragma unroll
        for (int r = 0; r < 16; ++r) p0[r] = __builtin_amdgcn_exp2f(p0[r]);
    }
}
__device__ __forceinline__ void finishSM(f32x16& p0, f32x16& p1, float alpha, float& l_reg, bf16x8& pa0, bf16x8& pa1, bf16x8& pa2, bf16x8& pa3) {
#pragma unroll
    for (int r = 0; r < 16; ++r) p1[r] = __builtin_amdgcn_exp2f(p1[r]);
    float ps = 0;
#pragma unroll
    for (int r = 0; r < 16; ++r) ps += p0[r];
#pragma unroll
    for (int r = 0; r < 16; ++r) ps += p1[r];
    { auto rr = __builtin_amdgcn_permlane32_swap(__float_as_uint(ps), __float_as_uint(ps), false, false);
      ps = __uint_as_float(rr[0]) + __uint_as_float(rr[1]); }
    l_reg = l_reg * alpha + ps;
#define PK4(P, BASE, OUT) do { unsigned a0 = cvt_pk_bf16(P[BASE + 0], P[BASE + 1]), a1 = cvt_pk_bf16(P[BASE + 2], P[BASE + 3]);   \
    unsigned b0 = cvt_pk_bf16(P[BASE + 4], P[BASE + 5]), b1 = cvt_pk_bf16(P[BASE + 6], P[BASE + 7]);                              \
    auto r0 = __builtin_amdgcn_permlane32_swap(a0, b0, false, false); auto r1 = __builtin_amdgcn_permlane32_swap(a1, b1, false, false); \
    u32x4 w = {r0[0], r1[0], r0[1], r1[1]}; OUT = __builtin_bit_cast(bf16x8, w); } while (0)
    PK4(p0, 0, pa0); PK4(p0, 8, pa1); PK4(p1, 0, pa2); PK4(p1, 8, pa3);
#undef PK4
}
template <int DK>
__device__ __forceinline__ void qkt(f32x16& p0, f32x16& p1, const LAS char* Ks, const bf16x8* qr, const int (&kb)[4], int hi, const LAS char* lds0, unsigned qoff) {
    constexpr int RB = DK * 2;
    p0 = f32x16{}; p1 = f32x16{};
    if constexpr (DK == 128) {
#pragma unroll
        for (int d0 = 0; d0 < 8; ++d0) {
            const bf16x8 b0 = *(const LAS bf16x8*)(Ks + kb[d0 & 3] + (d0 >> 2) * 128);
            const bf16x8 b1 = *(const LAS bf16x8*)(Ks + kb[d0 & 3] + (d0 >> 2) * 128 + 32 * RB);
            p0 = __builtin_amdgcn_mfma_f32_32x32x16_bf16(b0, qr[d0], p0, 0, 0, 0);
            p1 = __builtin_amdgcn_mfma_f32_32x32x16_bf16(b1, qr[d0], p1, 0, 0, 0); }
    } else {
        asm volatile("" : "+v"(qoff));
        bf16x8 b0[2][2], b1[2][2], q[2][2];
#define QK_LD(g, s) do { _Pragma("unroll") for (int e = 0; e < 2; ++e) { const int d0 = 2 * (g) + e; \
            b0[s][e] = *(const LAS bf16x8*)(Ks + kb[d0 & 3] + (d0 >> 2) * 128); b1[s][e] = *(const LAS bf16x8*)(Ks + kb[d0 & 3] + (d0 >> 2) * 128 + 32 * RB); \
            if (d0 >= 6) q[s][e] = *(const LAS bf16x8*)(lds0 + qoff + (d0 - 6) * 1024); } } while (0)
#define QK_MM(g, s) do { _Pragma("unroll") for (int e = 0; e < 2; ++e) { const int d0 = 2 * (g) + e; \
            if (d0 >= 6) { p0 = __builtin_amdgcn_mfma_f32_32x32x16_bf16(b0[s][e], q[s][e], p0, 0, 0, 0); p1 = __builtin_amdgcn_mfma_f32_32x32x16_bf16(b1[s][e], q[s][e], p1, 0, 0, 0); } \
            else { p0 = __builtin_amdgcn_mfma_f32_32x32x16_bf16(b0[s][e], qr[d0], p0, 0, 0, 0); p1 = __builtin_amdgcn_mfma_f32_32x32x16_bf16(b1[s][e], qr[d0], p1, 0, 0, 0); } } } while (0)
        QK_LD(0, 0); SBAR();
        QK_LD(1, 1); SBAR(); QK_MM(0, 0); SBAR();
        QK_LD(2, 0); SBAR(); QK_MM(1, 1); SBAR();
        QK_LD(3, 1); SBAR(); QK_MM(2, 0); SBAR();
        QK_LD(4, 0); SBAR(); QK_MM(3, 1); SBAR();
        QK_LD(5, 1); SBAR(); QK_MM(4, 0); SBAR();
        QK_MM(5, 1); SBAR();
#undef QK_LD
#undef QK_MM
    }
}
__device__ __forceinline__ int v_st(int k, int c) { const int kk = (k & ~0xC) | ((k & 4) << 1) | ((k & 8) >> 1); return ((kk >> 3) * 4 + (c >> 5)) * 512 + ((kk & 7) * 32 + (c & 31)) * 2; }
__device__ __forceinline__ int v_rd_base(int lane) { return ((lane & 3) << 3) | (((lane >> 2) & 3) << 6) | (((lane >> 4) & 1) << 5) | (((lane >> 5) & 1) << 8); }
constexpr int v_rd_off(int d0, int ks, int half) { return d0 * 512 + ks * 4096 + half * 2048; }
template <int OFF> __device__ __forceinline__ s16x4 tr_read(int vb) {
    s16x4 r; asm volatile("ds_read_b64_tr_b16 %0, %1 offset:%2" : "=&v"(r) : "v"(vb), "i"(OFF) : "memory"); return r;
}
template <int D0> __device__ __forceinline__ void pv_one(f32x16& od, int vb, bf16x8 pa0, bf16x8 pa1, bf16x8 pa2, bf16x8 pa3) {
    const s16x4 l0 = tr_read<v_rd_off(D0, 0, 0)>(vb), h0 = tr_read<v_rd_off(D0, 0, 1)>(vb), l1 = tr_read<v_rd_off(D0, 1, 0)>(vb), h1 = tr_read<v_rd_off(D0, 1, 1)>(vb);
    const s16x4 l2 = tr_read<v_rd_off(D0, 2, 0)>(vb), h2 = tr_read<v_rd_off(D0, 2, 1)>(vb), l3 = tr_read<v_rd_off(D0, 3, 0)>(vb), h3 = tr_read<v_rd_off(D0, 3, 1)>(vb);
    asm volatile("s_waitcnt lgkmcnt(0)" ::: "memory"); SBAR();
#define PKV(L, H) (bf16x8){L[0], L[1], L[2], L[3], H[0], H[1], H[2], H[3]}
    od = __builtin_amdgcn_mfma_f32_32x32x16_bf16(pa0, PKV(l0, h0), od, 0, 0, 0);
    od = __builtin_amdgcn_mfma_f32_32x32x16_bf16(pa1, PKV(l1, h1), od, 0, 0, 0);
    od = __builtin_amdgcn_mfma_f32_32x32x16_bf16(pa2, PKV(l2, h2), od, 0, 0, 0);
    od = __builtin_amdgcn_mfma_f32_32x32x16_bf16(pa3, PKV(l3, h3), od, 0, 0, 0);
#undef PKV
}
__device__ __forceinline__ void pv_d0(f32x16* o, int vb, bf16x8 pa0, bf16x8 pa1, bf16x8 pa2, bf16x8 pa3) {
    pv_one<0>(o[0], vb, pa0, pa1, pa2, pa3); pv_one<1>(o[1], vb, pa0, pa1, pa2, pa3); pv_one<2>(o[2], vb, pa0, pa1, pa2, pa3); pv_one<3>(o[3], vb, pa0, pa1, pa2, pa3);
}

template <int DK, bool MASK, int SDEPTH>
__device__ __forceinline__ void attn_unit(const bf16_t* __restrict__ Qb, const int ldq, const bf16_t* __restrict__ Kh, const int ldk, const bf16_t* __restrict__ Vh, const int ldv,
                                          bf16_t* __restrict__ Ob, const int ldo, const int NT, const float scale, LAS char* lds, const f32x2* __restrict__ ropeA, const int qpos0, const int dq0, const int tid, u64* __restrict__ yss) {
    constexpr int RB = DK * 2, SHM_V = KVBLK * 128 * 2, SHM_K = KVBLK * RB;
    const int wid = tid >> 6, lane = tid & 63, r32 = lane & 31, hi = lane >> 5;
    LAS char* V_lds = lds; LAS char* K_lds = lds + 2 * SHM_V;
    const float C = scale * 1.4426950408889634f;
    const float thr = MASK ? THR * 1.4426950408889634f : THR / scale;
    float m_reg = -1e30f, l_reg = 0; f32x16 o[4] = {}; bf16x8 qr[(DK == 192) ? 6 : 8];
    const unsigned qoff = 2 * SHM_V + 2 * SHM_K + 2048 + wid * 6144 + lane * 16;
    int kb[4];
#pragma unroll
    for (int k = 0; k < 4; ++k) kb[k] = r32 * RB + ((hi ^ (r32 & 1)) << 4) + ((k ^ ((r32 & 7) >> 1)) << 5);
    int tq = tid; asm volatile("" : "+v"(tq));
    const bf16_t* Qw = Qb + (size_t)(unsigned)(((tq >> 6) * QBLK + (tq & 31)) * ldq + ((tq >> 5) & 1) * 8);
    constexpr int NQR = (DK == 192) ? 6 : 8;
#pragma unroll
    for (int d0 = 0; d0 < NQR; ++d0) qr[d0] = *(const bf16x8*)(Qw + d0 * 16);
    if constexpr (DK == 192) {
        *(LAS bf16x8*)(lds + qoff) = *(const bf16x8*)(Qw + 6 * 16); *(LAS bf16x8*)(lds + qoff + 1024) = *(const bf16x8*)(Qw + 7 * 16);
        const f32x2* rp = ropeA + (size_t)(unsigned)((qpos0 + (tq >> 6) * QBLK + (tq & 31)) * 32 + ((tq >> 5) & 1) * 8);
#pragma unroll
        for (int dd = 0; dd < 2; ++dd) {
            bf16x8 x1 = *(const bf16x8*)(Qw + (8 + dd) * 16), x2 = *(const bf16x8*)(Qw + (10 + dd) * 16);
#pragma unroll
            for (int e = 0; e < 8; ++e) { const f32x2 cs = rp[dd * 16 + e]; const float a = bf2f((unsigned short)x1[e]), b = bf2f((unsigned short)x2[e]);
                x1[e] = (short)f2bf(a * cs.x - b * cs.y); x2[e] = (short)f2bf(b * cs.x + a * cs.y); }
            *(LAS bf16x8*)(lds + qoff + (2 + dd) * 1024) = x1; *(LAS bf16x8*)(lds + qoff + (4 + dd) * 1024) = x2;
        }
        asm volatile("s_waitcnt lgkmcnt(0)" ::: "memory");
    }
    const int sr = tid >> 4, sc = (tid & 15) * 8, vst0 = v_st(sr, sc); constexpr int vst1d = 8192;
    const int kst0 = sr * RB + ((sc * 2) ^ ((sr & 7) << 4));
    const int kr2 = tid >> 3, kc2 = 128 + (tid & 7) * 8, kst2 = kr2 * RB + ((kc2 * 2) ^ ((kr2 & 7) << 4));
    const int vb0 = (int)(uintptr_t)V_lds + v_rd_base(lane);
    bf16x8 vs0[SDEPTH], vs1[SDEPTH], ks0[SDEPTH], ks1[SDEPTH], ks2[SDEPTH];
    const unsigned voV0 = (unsigned)(sr * ldv + sc) * 2u, voK0 = (unsigned)(sr * ldk + sc) * 2u, voK2 = (unsigned)(kr2 * ldk + kc2) * 2u;
#define SLOAD(i, k0) do { const char* Vt = (const char*)Vh + (size_t)(k0) * (size_t)(ldv * 2); const char* Kt = (const char*)Kh + (size_t)(k0) * (size_t)(ldk * 2); \
    vs0[i] = *(const bf16x8*)(Vt + (size_t)voV0); vs1[i] = *(const bf16x8*)(Vt + (size_t)(ldv * 64) + (size_t)voV0); \
    ks0[i] = *(const bf16x8*)(Kt + (size_t)voK0); ks1[i] = *(const bf16x8*)(Kt + (size_t)(ldk * 64) + (size_t)voK0); \
    if constexpr (DK == 192) ks2[i] = *(const bf16x8*)(Kt + (size_t)voK2); } while (0)
#define SWRITE(b, i) do { *(LAS bf16x8*)(V_lds + (b) * SHM_V + vst0) = vs0[i]; *(LAS bf16x8*)(V_lds + (b) * SHM_V + vst1d + vst0) = vs1[i]; \
    *(LAS bf16x8*)(K_lds + (b) * SHM_K + kst0) = ks0[i]; *(LAS bf16x8*)(K_lds + (b) * SHM_K + 32 * RB + kst0) = ks1[i]; \
    if constexpr (DK == 192) *(LAS bf16x8*)(K_lds + (b) * SHM_K + kst2) = ks2[i]; } while (0)
#define SWAIT() do { if constexpr (SDEPTH == 2) { if constexpr (DK == 192) asm volatile("s_waitcnt vmcnt(5)" ::: "memory"); else asm volatile("s_waitcnt vmcnt(4)" ::: "memory"); } \
    else asm volatile("s_waitcnt vmcnt(0)" ::: "memory"); } while (0)
#define RESC(a) do { if (__any((a) < 1.f)) { int t3 = tid; asm volatile("" : "+v"(t3)); LAS float* al3 = (LAS float*)(lds + 2 * SHM_V + 2 * SHM_K) + (t3 >> 6) * 64 + 32; \
    if (((t3 >> 5) & 1) == 0) al3[t3 & 31] = (a); asm volatile("s_waitcnt lgkmcnt(0)" ::: "memory"); const LAS float* ar3 = al3 + 4 * ((t3 >> 5) & 1); \
    _Pragma("unroll") for (int d = 0; d < 4; ++d) _Pragma("unroll") for (int r = 0; r < 16; ++r) o[d][r] *= ar3[(r & 3) + 8 * (r >> 2)]; } } while (0)
    f32x16 pA0, pA1, pB0, pB1; float mnA, mnB, alA, alB; bf16x8 pa0, pa1, pa2, pa3;
    const int dw0 = dq0 - __builtin_amdgcn_readfirstlane(wid) * QBLK;
    const int db0 = dq0 + 4 * hi - (wid * QBLK + r32);
    constexpr int SE = 0, SO = SDEPTH - 1;
    SLOAD(SE, 0); asm volatile("s_waitcnt vmcnt(0)" ::: "memory"); SWRITE(0, SE); __syncthreads();
    qkt<DK>(pA0, pA1, K_lds, qr, kb, hi, lds, qoff); partialSM<MASK>(pA0, pA1, m_reg, mnA, alA, C, thr, db0, dw0);
    SLOAD(SO, KVBLK); if constexpr (SDEPTH == 2) { if (2 < NT) SLOAD(SE, 2 * KVBLK); }
    SWAIT(); SWRITE(1, SO); __syncthreads();
    for (int j = 1; j + 1 < NT; j += 2) {
        SBAR(); qkt<DK>(pB0, pB1, K_lds + SHM_K, qr, kb, hi, lds, qoff);
        finishSM(pA0, pA1, alA, l_reg, pa0, pa1, pa2, pa3); SBAR();
        SLOAD(SO, (j + SDEPTH) * KVBLK); SBAR();
        pv_d0(o, vb0, pa0, pa1, pa2, pa3); partialSM<MASK>(pB0, pB1, m_reg, mnB, alB, C, thr, db0 + j * KVBLK, dw0 + j * KVBLK);
        __syncthreads(); SWAIT(); SWRITE(0, SE);
        RESC(alB); __syncthreads();
        SBAR(); qkt<DK>(pA0, pA1, K_lds, qr, kb, hi, lds, qoff);
        finishSM(pB0, pB1, alB, l_reg, pa0, pa1, pa2, pa3); SBAR();
        if (SDEPTH == 1 || j + 3 < NT) SLOAD(SE, (j + 1 + SDEPTH) * KVBLK); SBAR();
        pv_d0(o, vb0 + SHM_V, pa0, pa1, pa2, pa3); partialSM<MASK>(pA0, pA1, m_reg, mnA, alA, C, thr, db0 + (j + 1) * KVBLK, dw0 + (j + 1) * KVBLK);
        __syncthreads(); SWAIT(); SWRITE(1, SO);
        RESC(alA); __syncthreads();
    }
    SBAR(); qkt<DK>(pB0, pB1, K_lds + SHM_K, qr, kb, hi, lds, qoff);
    finishSM(pA0, pA1, alA, l_reg, pa0, pa1, pa2, pa3); SBAR();
    pv_d0(o, vb0, pa0, pa1, pa2, pa3); partialSM<MASK>(pB0, pB1, m_reg, mnB, alB, C, thr, db0 + (NT - 1) * KVBLK, dw0 + (NT - 1) * KVBLK);
    __syncthreads(); RESC(alB);
    finishSM(pB0, pB1, alB, l_reg, pa0, pa1, pa2, pa3); SBAR();
    pv_d0(o, vb0 + SHM_V, pa0, pa1, pa2, pa3);
    int to = tid; asm volatile("" : "+v"(to));
    { LAS float* li3 = (LAS float*)(lds + 2 * SHM_V + 2 * SHM_K) + (to >> 6) * 64;
      if (((to >> 5) & 1) == 0) li3[to & 31] = l_reg; asm volatile("s_waitcnt lgkmcnt(0)" ::: "memory"); }
    float rli[16];
    { const LAS float* lr3 = (const LAS float*)(lds + 2 * SHM_V + 2 * SHM_K) + (to >> 6) * 64 + 4 * ((to >> 5) & 1);
#pragma unroll
      for (int r = 0; r < 16; ++r) rli[r] = __builtin_amdgcn_rcpf(lr3[(r & 3) + 8 * (r >> 2)]); }
    const unsigned ooff = (unsigned)((((to >> 6) * QBLK + 4 * ((to >> 5) & 1)) * ldo + (to & 31)) * 2);
    float sq[16];
#pragma unroll
    for (int r = 0; r < 16; ++r) { sq[r] = 0.f;
#pragma unroll
        for (int d0 = 0; d0 < 4; ++d0) { const float v = o[d0][r] * rli[r]; sq[r] += v * v;
            *(bf16_t*)((char*)Ob + (size_t)(ooff + (unsigned)((((r & 3) + 8 * (r >> 2)) * ldo + d0 * 32) * 2))) = f2bf(v); } }
#pragma unroll
    for (int r = 0; r < 16; ++r) {
#pragma unroll
        for (int x = 1; x < 32; x <<= 1) sq[r] += __builtin_bit_cast(float, __builtin_amdgcn_ds_bpermute(((to & 63) ^ x) << 2, __builtin_bit_cast(int, sq[r])));
        if ((to & 31) == r) fx_add(yss + (size_t)((to >> 6) * QBLK + 4 * ((to >> 5) & 1) + (r & 3) + 8 * (r >> 2)) * 4, sq[r]); }
#undef SLOAD
#undef SWRITE
#undef SWAIT
#undef RESC
}
}

struct TrJob { const float* W; bf16_t* WT; const float* gain; int N, Kd, mode, item; };
__device__ __forceinline__ void tr_load(const TrJob& j, int lane, f32x4 (&v)[8]) {
    const int nblk = j.N / 32, kb = j.item / nblk, nb = j.item % nblk, k0 = 64 * kb, n0 = 32 * nb;
    const float* p = j.W + (size_t)(k0 + (lane >> 3)) * j.N + n0 + 4 * (lane & 7);
#pragma unroll
    for (int i = 0; i < 8; ++i) v[i] = *(const f32x4*)(p + (size_t)(8 * i) * j.N);
}
__device__ __forceinline__ void tr_write(LAS float* scr, int lane, const f32x4 (&v)[8]) {
#pragma unroll
    for (int i = 0; i < 8; ++i) { LAS float* d = scr + (8 * i + (lane >> 3)) * 33 + 4 * (lane & 7); d[0] = v[i].x; d[1] = v[i].y; d[2] = v[i].z; d[3] = v[i].w; }
}
__device__ __forceinline__ void tr_store(const TrJob& j, LAS float* scr, int lane) {
    const int nblk = j.N / 32, kb = j.item / nblk, nb = j.item % nblk, k0 = 64 * kb, n0 = 32 * nb;
    const int rb = (j.mode == 0) ? n0 : (256 * (n0 >> 7) + (n0 & 127) + (j.mode == 2 ? 128 : 0));
    const int c = lane & 7;
    f32x4 g0 = {1.f, 1.f, 1.f, 1.f}, g1 = g0;
    if (j.gain) { g0 = *(const f32x4*)(j.gain + k0 + 8 * c); g1 = *(const f32x4*)(j.gain + k0 + 8 * c + 4); }
    asm volatile("s_waitcnt lgkmcnt(0)" ::: "memory");
#pragma unroll
    for (int jj = 0; jj < 4; ++jj) { const int n = (lane >> 3) + 8 * jj; const LAS float* s = scr + (8 * c) * 33 + n;
        u32x4 o; o.x = cvt_pk_bf16(s[0 * 33] * g0.x, s[1 * 33] * g0.y); o.y = cvt_pk_bf16(s[2 * 33] * g0.z, s[3 * 33] * g0.w);
        o.z = cvt_pk_bf16(s[4 * 33] * g1.x, s[5 * 33] * g1.y); o.w = cvt_pk_bf16(s[6 * 33] * g1.z, s[7 * 33] * g1.w);
        *(u32x4*)(j.WT + (size_t)(rb + n) * j.Kd + k0 + 8 * c) = o; }
    asm volatile("s_waitcnt lgkmcnt(0)" ::: "memory");
}

struct Args { const float* in[16]; float* out; unsigned char* ws; int ph_lo, ph_hi; };

__device__ __forceinline__ void ph_prologue(const Args& a, LAS unsigned char* lds, int gw, int NGW, int lane, int wave) {
    LAS float* scr = (LAS float*)(lds + wave * 16384);
    unsigned char* ws = a.ws;
    constexpr int I_IN = 32 * 146, I_UQ = 8 * 24, I_UKV = 8 * 32, I_OUT = 32 * 64, I_G = 32 * 176, I_DN = 88 * 64;
    constexpr int I_LAYER = I_IN + I_UQ + I_UKV + I_OUT + 2 * I_G + I_DN;
    auto job = [&](int it) -> TrJob {
        const int l = it / I_LAYER; int r = it % I_LAYER; unsigned char* wl = ws + WS_W + (size_t)l * W_LAYER; TrJob j;
        if (r < I_IN) { j = TrJob{a.in[2] + (size_t)l * DM * INW, (bf16_t*)(wl + W_IN), a.in[1] + l * DM, INW, DM, 0, r}; return j; } r -= I_IN;
        if (r < I_UQ) { j = TrJob{a.in[4] + (size_t)l * 512 * 768, (bf16_t*)(wl + W_UQ), a.in[3] + l * 512, 768, 512, 0, r}; return j; } r -= I_UQ;
        if (r < I_UKV) { j = TrJob{a.in[6] + (size_t)l * 512 * 1024, (bf16_t*)(wl + W_UKV), a.in[5] + l * 512, 1024, 512, 0, r}; return j; } r -= I_UKV;
        if (r < I_OUT) { j = TrJob{a.in[10] + (size_t)l * DM * DM, (bf16_t*)(wl + W_OUT), a.in[9] + l * DM, DM, DM, 0, r}; return j; } r -= I_OUT;
        if (r < I_G) { j = TrJob{a.in[12] + (size_t)l * DM * DFF, (bf16_t*)(wl + W_GU), a.in[11] + l * DM, DFF, DM, 1, r}; return j; } r -= I_G;
        if (r < I_G) { j = TrJob{a.in[13] + (size_t)l * DM * DFF, (bf16_t*)(wl + W_GU), a.in[11] + l * DM, DFF, DM, 2, r}; return j; } r -= I_G;
        j = TrJob{a.in[14] + (size_t)l * DFF * DM, (bf16_t*)(wl + W_DN), nullptr, DM, DFF, 0, r}; return j;
    };
    { f32x4 v[8]; int it = gw; TrJob cur = job(it < 2 * I_LAYER ? it : 0);
      if (it < 2 * I_LAYER) tr_load(cur, lane, v);
      while (it < 2 * I_LAYER) {
          const int nit = it + NGW;
          tr_write(scr, lane, v);
          TrJob nxt = cur;
          if (nit < 2 * I_LAYER) { nxt = job(nit); tr_load(nxt, lane, v); }
          tr_store(cur, scr, lane);
          cur = nxt; it = nit;
      } }
    const int gt = gw * 64 + lane, NGT = NGW * 64;
    for (int l = 0; l < 2; ++l) { u32x4* z = (u32x4*)(ws + WS_W + (size_t)l * W_LAYER + W_IN + (size_t)INW * DM * 2);
        for (int i = gt; i < (INP - INW) * DM * 2 / 16; i += NGT) z[i] = (u32x4){0u, 0u, 0u, 0u}; }
    { u64* rss = (u64*)(ws + WS_CTL + RSS_OFF); bf16_t* XB = (bf16_t*)(ws + WS_XN);
      for (int i = gt; i < 3 * T; i += NGT) rss[T + i] = 0ull;
      { u64* yz = (u64*)(ws + WS_CTL + YSS_OFF); for (int i = gt; i < 2 * T * 4; i += NGT) yz[i] = 0ull; }
      { u64* cz = (u64*)(ws + WS_CTL + CSS_OFF); for (int i = gt; i < 2 * T * 2; i += NGT) cz[i] = 0ull; }
      for (int m = gw; m < T; m += NGW) {
          const f32x4* xr = (const f32x4*)(a.in[0] + (size_t)m * DM) + lane; u32x2* o = (u32x2*)(XB + (size_t)m * DM) + lane; float sq = 0.f;
#pragma unroll
          for (int j = 0; j < 8; ++j) { const f32x4 v = xr[64 * j]; sq += (v.x * v.x + v.y * v.y) + (v.z * v.z + v.w * v.w);
              u32x2 w; w.x = cvt_pk_bf16(v.x, v.y); w.y = cvt_pk_bf16(v.z, v.w); o[64 * j] = w; }
          sq = wave_sum(sq, lane); if (lane == 0) rss[m] = (u64)(sq * FXS + 0.5f); } }
    f32x2* ra = (f32x2*)(ws + WS_ROPEA); f32x2* r1 = (f32x2*)(ws + WS_ROPE1);
    for (int i = gt; i < 4096 * 32 + 4096 * 64; i += NGT) {
        int pos, fi; float inv; f32x2* dst;
        if (i < 4096 * 32) { pos = i >> 5; fi = i & 31; inv = __builtin_amdgcn_exp2f(-(float)(2 * fi) * (13.287712379549449f / 64.f)); dst = ra + i; }
        else { const int j = i - 4096 * 32; pos = j >> 6; fi = j & 63; inv = __builtin_amdgcn_exp2f(-(float)(2 * fi) * (13.287712379549449f / 128.f)); dst = r1 + j; }
        const float ang = (float)pos * inv;
        const double rev = (double)ang * 0.15915494309189535; const float fr = (float)(rev - __builtin_rint(rev));
        *dst = (f32x2){__builtin_amdgcn_cosf(fr), __builtin_amdgcn_sinf(fr)};
    }
}

__device__ __forceinline__ void ph_norm_bf16(const float* x, const float* g, bf16_t* out, int gw, int NGW, int lane) {
    for (int m = gw; m < T; m += NGW) {
        const f32x4* xr = (const f32x4*)(x + (size_t)m * DM) + lane; f32x4 v[8]; float s = 0.f;
#pragma unroll
        for (int j = 0; j < 8; ++j) { v[j] = xr[64 * j]; s += (v[j].x * v[j].x + v[j].y * v[j].y) + (v[j].z * v[j].z + v[j].w * v[j].w); }
        const float rs = 1.0f / sqrtf(wave_sum(s, lane) * (1.f / DM) + EPS);
        u32x2* o = (u32x2*)(out + (size_t)m * DM) + lane;
#pragma unroll
        for (int j = 0; j < 8; ++j) { const f32x4 gg = ((const f32x4*)g)[lane + 64 * j]; u32x2 w; w.x = cvt_pk_bf16(v[j].x * rs * gg.x, v[j].y * rs * gg.y); w.y = cvt_pk_bf16(v[j].z * rs * gg.z, v[j].w * rs * gg.w); o[64 * j] = w; }
    }
}
__device__ __forceinline__ void unpack8(const u32x4 w, float (&x)[8]) { x[0] = bflo(w.x); x[1] = bfhi(w.x); x[2] = bflo(w.y); x[3] = bfhi(w.y); x[4] = bflo(w.z); x[5] = bfhi(w.z); x[6] = bflo(w.w); x[7] = bfhi(w.w); }
__device__ __forceinline__ u32x4 pack8(const float (&x)[8]) { u32x4 o; o.x = cvt_pk_bf16(x[0], x[1]); o.y = cvt_pk_bf16(x[2], x[3]); o.z = cvt_pk_bf16(x[4], x[5]); o.w = cvt_pk_bf16(x[6], x[7]); return o; }
__device__ __forceinline__ void ph_final(const bf16_t* xb, float* out, const float* g, int gw, int NGW, int lane) {
    for (int m0 = gw; m0 < T; m0 += 2 * NGW) {
        float v[2][4][8]; float s[2] = {0.f, 0.f};
#pragma unroll
        for (int rr = 0; rr < 2; ++rr) { const int mr = (m0 + rr * NGW < T) ? m0 + rr * NGW : m0; const u32x4* xr = (const u32x4*)(xb + (size_t)mr * DM) + lane;
#pragma unroll
            for (int j = 0; j < 4; ++j) { unpack8(xr[64 * j], v[rr][j]);
#pragma unroll
                for (int e = 0; e < 8; ++e) s[rr] += v[rr][j][e] * v[rr][j][e]; } }
#pragma unroll
        for (int rr = 0; rr < 2; ++rr) { if (m0 + rr * NGW >= T) continue; f32x4* o = (f32x4*)(out + (size_t)(m0 + rr * NGW) * DM) + 2 * lane;
            const float rs = 1.0f / sqrtf(wave_sum(s[rr], lane) * (1.f / DM) + EPS);
#pragma unroll
            for (int j = 0; j < 4; ++j) { const f32x4 g0 = ((const f32x4*)g)[2 * (lane + 64 * j)], g1 = ((const f32x4*)g)[2 * (lane + 64 * j) + 1];
                o[128 * j] = (f32x4){v[rr][j][0] * rs * g0.x, v[rr][j][1] * rs * g0.y, v[rr][j][2] * rs * g0.z, v[rr][j][3] * rs * g0.w};
                o[128 * j + 1] = (f32x4){v[rr][j][4] * rs * g1.x, v[rr][j][5] * rs * g1.y, v[rr][j][6] * rs * g1.z, v[rr][j][7] * rs * g1.w}; } }
    }
}
__device__ __forceinline__ void ph_prep(const Args& a, int l, int gw, int NGW, int lane) {
    bf16_t* PROJ = (bf16_t*)(a.ws + WS_BIG); bf16_t* KA = (bf16_t*)(a.ws + WS_KA);
    const f32x2* ra = (const f32x2*)(a.ws + WS_ROPEA); const f32x2* r1 = (const f32x2*)(a.ws + WS_ROPE1);
    const float* gq = a.in[3] + l * 512; const float* gkv = a.in[5] + l * 512; const float* cqn = a.in[7] + l * 128; const float* ckn = a.in[8] + l * 128;
    const int j8 = lane & 7, hd = lane >> 3;
    for (int m0 = gw; m0 < T; m0 += 2 * NGW) {
#pragma unroll
      for (int rr = 0; rr < 2; ++rr) { const int m = m0 + rr * NGW; if (m >= T) continue;
        bf16_t* P = PROJ + (size_t)m * INP; const int s = m & (SEQ - 1);
        if (lane < 4) {
            float x1[8], x2[8]; unpack8(*(const u32x4*)(P + PA_KR + 8 * lane), x1); unpack8(*(const u32x4*)(P + PA_KR + 32 + 8 * lane), x2);
            const f32x4* cp = (const f32x4*)(ra + s * 32 + 8 * lane);
#pragma unroll
            for (int e2 = 0; e2 < 4; ++e2) { const f32x4 cs = cp[e2];
                const float a0 = x1[2 * e2], b0 = x2[2 * e2], a1 = x1[2 * e2 + 1], b1 = x2[2 * e2 + 1];
                x1[2 * e2] = a0 * cs.x - b0 * cs.y; x2[2 * e2] = b0 * cs.x + a0 * cs.y; x1[2 * e2 + 1] = a1 * cs.z - b1 * cs.w; x2[2 * e2 + 1] = b1 * cs.z + a1 * cs.w; }
            const u32x4 y1 = pack8(x1), y2 = pack8(x2); bf16_t* kp = KA + (size_t)m * 768 + 128 + 8 * lane;
#pragma unroll
            for (int h = 0; h < 4; ++h) { *(u32x4*)(kp + h * 192) = y1; *(u32x4*)(kp + h * 192 + 32) = y2; }
        }
        { const f32x4* cp = (const f32x4*)(r1 + s * 64 + 8 * j8); const f32x4 c0 = cp[0], c1 = cp[1], c2 = cp[2], c3 = cp[3];
#pragma unroll
          for (int pass = 0; pass < 2; ++pass) { const int head = 8 * pass + hd;
              if (head < 12) { bf16_t* hp = P + PB_Q + head * 128 + 8 * j8; float x1[8], x2[8]; unpack8(*(const u32x4*)hp, x1); unpack8(*(const u32x4*)(hp + 64), x2);
                  const float cc[8] = {c0.x, c0.z, c1.x, c1.z, c2.x, c2.z, c3.x, c3.z}, sn[8] = {c0.y, c0.w, c1.y, c1.w, c2.y, c2.w, c3.y, c3.w};
#pragma unroll
                  for (int e = 0; e < 8; ++e) { const float p = x1[e], q = x2[e]; x1[e] = p * cc[e] - q * sn[e]; x2[e] = q * cc[e] + p * sn[e]; }
                  *(u32x4*)hp = pack8(x1); *(u32x4*)(hp + 64) = pack8(x2); } } }
        { const int half = j8 >> 2, jj = j8 & 3; bf16_t* hp = P + PC_Q + hd * 128 + 64 * half + 8 * jj;
          float x1[8], x2[8]; unpack8(*(const u32x4*)hp, x1); unpack8(*(const u32x4*)(hp + 32), x2);
          const f32x4* cp = (const f32x4*)(ra + (half ? (s & 63) : (s >> 6)) * 32 + 8 * jj); const f32x4 c0 = cp[0], c1 = cp[1], c2 = cp[2], c3 = cp[3];
          const float* g = (hd < 6 ? cqn : ckn) + 64 * half + 8 * jj; const f32x4 ga = *(const f32x4*)g, gb = *(const f32x4*)(g + 4), gc = *(const f32x4*)(g + 32), gd = *(const f32x4*)(g + 36);
          float ss = 0.f;
#pragma unroll
          for (int e = 0; e < 8; ++e) ss += x1[e] * x1[e] + x2[e] * x2[e];
          ss += __builtin_bit_cast(float, __builtin_amdgcn_ds_bpermute((lane ^ 1) << 2, __builtin_bit_cast(int, ss)));
          ss += __builtin_bit_cast(float, __builtin_amdgcn_ds_bpermute((lane ^ 2) << 2, __builtin_bit_cast(int, ss)));
          ss += __builtin_bit_cast(float, __builtin_amdgcn_ds_bpermute((lane ^ 4) << 2, __builtin_bit_cast(int, ss)));
          const float rs = 1.0f / sqrtf(ss * (1.f / 128.f) + EPS);
          const float g1[8] = {ga.x, ga.y, ga.z, ga.w, gb.x, gb.y, gb.z, gb.w}, g2[8] = {gc.x, gc.y, gc.z, gc.w, gd.x, gd.y, gd.z, gd.w};
          const float cc[8] = {c0.x, c0.z, c1.x, c1.z, c2.x, c2.z, c3.x, c3.z}, sn[8] = {c0.y, c0.w, c1.y, c1.w, c2.y, c2.w, c3.y, c3.w};
#pragma unroll
          for (int e = 0; e < 8; ++e) { const float p = x1[e] * rs * g1[e], q = x2[e] * rs * g2[e]; x1[e] = p * cc[e] - q * sn[e]; x2[e] = q * cc[e] + p * sn[e]; }
          *(u32x4*)hp = pack8(x1); *(u32x4*)(hp + 32) = pack8(x2); }
      }
    }
}
__device__ __forceinline__ void ph_ynorm(bf16_t* Y, const float* g, int gw, int NGW, int lane) {
    for (int m = gw; m < T; m += NGW) {
        u32x4* p = (u32x4*)(Y + (size_t)m * DM) + lane; float x[4][8]; float sa = 0.f, sb = 0.f, sc = 0.f;
#pragma unroll
        for (int j = 0; j < 4; ++j) { const u32x4 w = p[64 * j];
            x[j][0] = bflo(w.x); x[j][1] = bfhi(w.x); x[j][2] = bflo(w.y); x[j][3] = bfhi(w.y); x[j][4] = bflo(w.z); x[j][5] = bfhi(w.z); x[j][6] = bflo(w.w); x[j][7] = bfhi(w.w);
            float ss = 0.f;
#pragma unroll
            for (int e = 0; e < 8; ++e) ss += x[j][e] * x[j][e];
            if (j == 0) sa += ss; else if (j == 1) sb += ss; else if (j == 2) { if (lane < 32) sb += ss; else sc += ss; } else sc += ss; }
        const float ra_ = 1.0f / sqrtf(wave_sum(sa, lane) * (1.f / 512.f) + EPS), rb_ = 1.0f / sqrtf(wave_sum(sb, lane) * (1.f / 768.f) + EPS), rc_ = 1.0f / sqrtf(wave_sum(sc, lane) * (1.f / 768.f) + EPS);
#pragma unroll
        for (int j = 0; j < 4; ++j) { const float rs = (j == 0) ? ra_ : (j == 1) ? rb_ : (j == 2) ? (lane < 32 ? rb_ : rc_) : rc_;
            const float* gp = g + (lane + 64 * j) * 8; const f32x4 g0 = *(const f32x4*)gp, g1 = *(const f32x4*)(gp + 4);
            u32x4 o; o.x = cvt_pk_bf16(x[j][0] * rs * g0.x, x[j][1] * rs * g0.y); o.y = cvt_pk_bf16(x[j][2] * rs * g0.z, x[j][3] * rs * g0.w);
            o.z = cvt_pk_bf16(x[j][4] * rs * g1.x, x[j][5] * rs * g1.y); o.w = cvt_pk_bf16(x[j][6] * rs * g1.z, x[j][7] * rs * g1.w);
            p[64 * j] = o; }
    }
}

#if defined(__HIP_DEVICE_COMPILE__)
__device__ __forceinline__ void ph_attention(const __attribute__((address_space(4))) Args* ap, int l, LAS unsigned char* lds, const int rep) {
    volatile LAS int* slot = (volatile LAS int*)(lds + LDS_SLOT);
#if !defined(NO_ATT_A)
    for (;;) {
        asm volatile("" : "+s"(ap));
        unsigned char* ws = ap->ws;
        const bf16_t* QA = (const bf16_t*)(ws + WS_QA); const bf16_t* KA = (const bf16_t*)(ws + WS_KA);
        const bf16_t* VA = (const bf16_t*)(ws + WS_VA); bf16_t* Y = (bf16_t*)(ws + WS_XN); const f32x2* ra = (const f32x2*)(ws + WS_ROPEA);
        if (threadIdx.x == 0) *slot = (int)__hip_atomic_fetch_add((unsigned*)(ws + WS_CTL) + 64 * (1 + l + 4 * rep), 1u, __ATOMIC_RELAXED, __HIP_MEMORY_SCOPE_AGENT);
        __syncthreads(); const int u = __builtin_amdgcn_readfirstlane(*slot); __syncthreads();
        if (u >= 256) break;
        int tid = threadIdx.x; asm volatile("" : "+v"(tid));
        const int b = u >> 6, h = (u >> 4) & 3, qb = u & 15; const size_t row = (size_t)b * SEQ + qb * 256;
        att::attn_unit<192, false, 1>(QA + row * 768 + h * 192, 768, KA + (size_t)b * SEQ * 768 + h * 192, 768, VA + (size_t)b * SEQ * 512 + h * 128, 512,
                                      Y + row * DM + h * 128, DM, SEQ / 64, 0.07216878364870322f, (LAS char*)lds, ra, qb * 256, 0, tid, (u64*)(ws + WS_CTL + YSS_OFF) + ((size_t)l * T + row) * 4 + 0);
    }
#endif
    for (;;) {
        asm volatile("" : "+s"(ap));
        unsigned char* ws = ap->ws;
        const bf16_t* PROJ = (const bf16_t*)(ws + WS_BIG); bf16_t* Y = (bf16_t*)(ws + WS_XN);
        if (threadIdx.x == 0) *slot = (int)__hip_atomic_fetch_add((unsigned*)(ws + WS_CTL) + 64 * (3 + l + 4 * rep), 1u, __ATOMIC_RELAXED, __HIP_MEMORY_SCOPE_AGENT);
        __syncthreads(); const int v = __builtin_amdgcn_readfirstlane(*slot); __syncthreads();
        if (v >= 768) break;
        int tid = threadIdx.x; asm volatile("" : "+v"(tid));
#if !defined(NO_ATT_C)
        if (v < 384) { const int b = v / 96, h = (v >> 4) % 6, qb = v & 15, kvh = h / 3; const size_t row = (size_t)b * SEQ + qb * 256;
            att::attn_unit<128, false, 1>(PROJ + row * INP + PC_Q + h * 128, INP, PROJ + (size_t)b * SEQ * INP + PC_K + kvh * 128, INP, PROJ + (size_t)b * SEQ * INP + PC_V + kvh * 128, INP,
                                          Y + row * DM + 1280 + h * 128, DM, SEQ / 64, 0.08838834764831845f, (LAS char*)lds, nullptr, 0, 0, tid, (u64*)(ws + WS_CTL + YSS_OFF) + ((size_t)l * T + row) * 4 + 2);
        } else
#endif
#if !defined(NO_ATT_B)
        { const int w = v - 384, b = w / 96, h = (w >> 4) % 6, qb = w & 15; const size_t row = (size_t)b * SEQ + qb * 256;
            const int q0 = qb * 256, lo = q0 - 1024 < 0 ? 0 : q0 - 1024, hi_ = q0 + 1280 > SEQ ? SEQ : q0 + 1280;
            att::attn_unit<128, true, 1>(PROJ + row * INP + PB_Q + h * 128, INP, PROJ + ((size_t)b * SEQ + lo) * INP + PB_K + h * 128, INP, PROJ + ((size_t)b * SEQ + lo) * INP + PB_V + h * 128, INP,
                                         Y + row * DM + 512 + h * 128, DM, (hi_ - lo) / 64, 0.08838834764831845f, (LAS char*)lds, nullptr, 0, lo - q0, tid, (u64*)(ws + WS_CTL + YSS_OFF) + ((size_t)l * T + row) * 4 + 1);
        }
#endif
        {}
    }
}

#endif
#if defined(__HIP_DEVICE_COMPILE__)
typedef const __attribute__((address_space(4))) Args* ArgsP;
template <int PH, int REP = 0>
__device__ __forceinline__ void run_phase(ArgsP ap, LAS unsigned char* lds) {
    asm volatile("" : "+s"(ap));
    const Args a = *ap;
    int tid = threadIdx.x, bid = blockIdx.x, G = gridDim.x; asm volatile("" : "+v"(tid)); asm volatile("" : "+s"(bid), "+s"(G));
    const int lane = tid & 63, wave = __builtin_amdgcn_readfirstlane(tid >> 6);
    const int gw = bid * NWAVES + wave, NGW = G * NWAVES;
    unsigned char* ws = a.ws;
    bf16_t* XN = (bf16_t*)(ws + WS_XN); bf16_t* BIG = (bf16_t*)(ws + WS_BIG); bf16_t* XB2 = (bf16_t*)(ws + WS_QA); u64* rss = (u64*)(ws + WS_CTL + RSS_OFF);
    if constexpr (PH == 0) ph_prologue(a, lds, gw, NGW, lane, wave);
    else if constexpr (PH == NPH - 1) ph_final(XN, a.out, a.in[15], gw, NGW, lane);
    else {
        constexpr int l = (PH - 1) / 6, sp = (PH - 1) % 6; unsigned char* wl = ws + WS_W + (size_t)l * W_LAYER;
        bf16_t* R1 = (bf16_t*)a.out;
        u64* css = (u64*)(ws + WS_CTL + CSS_OFF) + (size_t)l * T * 2;
        if constexpr (sp == 0) { pg8::Gemm g{(l == 0) ? XN : R1, (const bf16_t*)(wl + W_IN), DM, DM}; pg8::StaticOrder S; S.init(T, INP, G, bid);
            pg8::EpiBf E{BIG, nullptr, INP, 0, rss + (2 * l) * T, 1, 1.f / 2048.f, css}; pg8::gemm_phase(lds, g, S, E, tid); }
        else if constexpr (sp == 1) {
            { pg8::Gemm g{BIG + PA_CQ, (const bf16_t*)(wl + W_UQ), INP, 512}; pg8::StaticOrder S; S.init(T, 768, G, bid);
              pg8::EpiBf E{(bf16_t*)(ws + WS_QA), nullptr, 768, 0, css, 2, 1.f / 512.f, nullptr}; pg8::gemm_phase(lds, g, S, E, tid); }
            { pg8::Gemm g{BIG + PA_CKV, (const bf16_t*)(wl + W_UKV), INP, 512}; pg8::StaticOrder S; S.init(T, 1024, G, bid);
              pg8::EpiBf E{(bf16_t*)(ws + WS_KA), (bf16_t*)(ws + WS_VA), 0, 1, css + 1, 2, 1.f / 512.f, nullptr}; pg8::gemm_phase(lds, g, S, E, tid); }
            ph_prep(a, l, gw, NGW, lane);
        }
        else if constexpr (sp == 2) ph_attention(ap, l, lds, REP);
        else if constexpr (sp == 3) { pg8::Gemm g{XN, (const bf16_t*)(wl + W_OUT), DM, DM}; pg8::StaticOrder S; S.init(T, DM, G, bid);
            pg8::EpiRes E{(l == 0) ? a.in[0] : nullptr, (l == 0) ? nullptr : R1, nullptr, XB2, DM, rss + (2 * l + 1) * T, (const u64*)(ws + WS_CTL + YSS_OFF) + (size_t)l * T * 4}; pg8::gemm_phase(lds, g, S, E, tid); }
        else if constexpr (sp == 4) { pg8::Gemm g{XB2, (const bf16_t*)(wl + W_GU), DM, DM}; pg8::StaticOrder S; S.init(T, 2 * DFF, G, bid);
            pg8::EpiBf E{BIG, nullptr, DFF, 2, rss + (2 * l + 1) * T, 1, 1.f / 2048.f, nullptr}; pg8::gemm_phase(lds, g, S, E, tid); }
        else { pg8::Gemm g{BIG, (const bf16_t*)(wl + W_DN), DFF, DFF}; pg8::StaticOrder S; S.init(T, DM, G, bid);
            pg8::EpiRes E{nullptr, XB2, nullptr, (l == 0) ? R1 : XN, DM, (l == 0) ? rss + 2 * T : nullptr, nullptr}; pg8::gemm_phase(lds, g, S, E, tid); }
    }
}

#endif
__global__ void __launch_bounds__(NWAVES * 64, 2) mega_fwd(Args a_unused) {
#if defined(__HIP_DEVICE_COMPILE__)
    extern __shared__ __attribute__((aligned(16))) unsigned char lds_raw[];
    LAS unsigned char* lds = (LAS unsigned char*)lds_raw;
    ArgsP ap = (ArgsP)__builtin_amdgcn_kernarg_segment_ptr();
    const int ph_lo = ap->ph_lo, ph_hi = ap->ph_hi;
    XcdBarrier xbar; xbar.bar = (unsigned*)(ap->ws + WS_CTL) + 4096; xbar.x = 0; xbar.st = (volatile LAS unsigned*)(lds + LDS_SLOT + 16);
    if (ph_hi - ph_lo > 1) {
        if (threadIdx.x < 2) xbar.st[threadIdx.x] = 0u;
        __syncthreads();
        xbar = xcd_barrier_post(xbar.bar, xbar.st);
    }
#define GRID_BAR() do { xcd_barrier(xbar); } while (0)
#define RUN_AGAIN(PH) do { if (ph_lo <= (PH) && (PH) + 1 < ph_hi) { run_phase<PH, 1>(ap, lds); GRID_BAR(); } } while (0)
#define RUN_PHASE(PH) do { if (ph_lo <= (PH) && (PH) < ph_hi) { run_phase<PH>(ap, lds); if ((PH) + 1 < ph_hi) { if (ph_lo < 0) { __syncthreads(); cg::this_grid().sync(); } else GRID_BAR(); } } } while (0)
#define PA(PH) do { if (PROBE_ATT) RUN_AGAIN(PH); } while (0)
#define PG(PH) do { if (PROBE_GEMM) RUN_AGAIN(PH); } while (0)
#define PE(PH) do { if (PROBE_ELEM) RUN_AGAIN(PH); } while (0)
    RUN_PHASE(0); PE(0); RUN_PHASE(1); RUN_PHASE(2); RUN_PHASE(3); PA(3); RUN_PHASE(4); RUN_PHASE(5); PG(5); RUN_PHASE(6);
    RUN_PHASE(7); RUN_PHASE(8); RUN_PHASE(9); PA(9); RUN_PHASE(10); RUN_PHASE(11); PG(11); RUN_PHASE(12); RUN_PHASE(13);
#undef RUN_PHASE
#endif
}

extern "C" void kernel_launch(void* const* d_in, const int* in_sizes, int n_in, void* d_out, int out_size, void* d_ws, size_t ws_size, hipStream_t stream) {
    static int grid = 0;
    if (grid == 0) {
        if (n_in != 16 || out_size != T * DM || ws_size < WS_END) { fprintf(stderr, "kernel_launch: unexpected shapes n_in %d out %d ws %zu (need %zu)\n", n_in, out_size, ws_size, (size_t)WS_END); grid = -1; return; }
        int dev = 0, cus = 0, per_cu = 0;
        hipGetDevice(&dev); hipDeviceGetAttribute(&cus, hipDeviceAttributeMultiprocessorCount, dev);
        if (hipFuncSetAttribute((const void*)mega_fwd, hipFuncAttributeMaxDynamicSharedMemorySize, LDS_BYTES) != hipSuccess) { fprintf(stderr, "kernel_launch: hipFuncSetAttribute failed\n"); grid = -1; return; }
        hipOccupancyMaxActiveBlocksPerMultiprocessor(&per_cu, (const void*)mega_fwd, NWAVES * 64, LDS_BYTES);
        (void)hipGetLastError();
        if (per_cu < 1) per_cu = 1;
        grid = cus * 1;
    }
    if (grid < 0) return;
    hipMemsetAsync((char*)d_ws + WS_CTL, 0, 32768, stream);
    Args a{};
    for (int i = 0; i < 16; ++i) a.in[i] = (const float*)d_in[i];
    a.out = (float*)d_out; a.ws = (unsigned char*)d_ws;
#if MK_SINGLE
    a.ph_lo = 0; a.ph_hi = NPH;
    void* args[] = {&a};
    hipError_t e = hipLaunchCooperativeKernel((const void*)mega_fwd, dim3(grid), dim3(NWAVES * 64), args, LDS_BYTES, stream);
    if (e != hipSuccess) fprintf(stderr, "cooperative launch failed: %s (grid %d)\n", hipGetErrorString(e), grid);
#else
    for (int ph = 0; ph < NPH; ++ph) { a.ph_lo = ph; a.ph_hi = ph + 1;
        hipLaunchKernelGGL(mega_fwd, dim3(grid), dim3(NWAVES * 64), LDS_BYTES, stream, a); }
#endif
}
```

```cpp
#include <hip/hip_runtime.h>
#include <hip/hip_cooperative_groups.h>
#include <cstdio>
#include <cstdint>
namespace cg = cooperative_groups;

#ifndef PROBE_ATT
#define PROBE_ATT 0
#endif
#ifndef PROBE_GEMM
#define PROBE_GEMM 0
#endif
#ifndef PROBE_ELEM
#define PROBE_ELEM 0
#endif
#ifndef MK_SINGLE
#define MK_SINGLE 1
#endif

#define LAS __attribute__((address_space(3)))
typedef unsigned short bf16_t;
typedef short bf16x8 __attribute__((ext_vector_type(8)));
typedef short s16x4 __attribute__((ext_vector_type(4)));
typedef float f32x4 __attribute__((ext_vector_type(4)));
typedef float f32x2 __attribute__((ext_vector_type(2)));
typedef float f32x16 __attribute__((ext_vector_type(16)));
typedef unsigned u32x4 __attribute__((ext_vector_type(4)));
typedef unsigned u32x2 __attribute__((ext_vector_type(2)));
typedef unsigned long long u64;
constexpr float FXS = 1048576.f, FXI = 1.f / 1048576.f;
__device__ __forceinline__ void fx_add(u64* p, float v) { atomicAdd(p, (u64)(v * FXS + 0.5f)); }
__device__ __forceinline__ float fx_get(const u64* p) { return (float)(*p) * FXI; }

constexpr int NB = 4, SEQ = 4096, T = NB * SEQ, DM = 2048, INW = 4672, INP = 4864, DFF = 5632;
constexpr int NWAVES = 8;
constexpr int NPH = 14;
constexpr float EPS = 1e-6f;
constexpr int PA_CQ = 0, PA_CKV = 512, PA_KR = 1024, PB_Q = 1088, PB_K = 1856, PB_V = 2624, PC_Q = 3392, PC_K = 4160, PC_V = 4416;

constexpr size_t WS_CTL = 0, CTL_BYTES = 4u << 20;
constexpr size_t RSS_OFF = 512 * 1024;
constexpr size_t YSS_OFF = 1024 * 1024;
constexpr size_t CSS_OFF = 2048 * 1024;
constexpr size_t WS_ROPEA = WS_CTL + CTL_BYTES;
constexpr size_t WS_ROPE1 = WS_ROPEA + (size_t)4096 * 32 * 8;
constexpr size_t WS_W = WS_ROPE1 + (size_t)4096 * 64 * 8;
constexpr size_t W_IN = 0, W_UQ = W_IN + (size_t)INP * DM * 2, W_UKV = W_UQ + (size_t)768 * 512 * 2, W_OUT = W_UKV + (size_t)1024 * 512 * 2,
                 W_GU = W_OUT + (size_t)DM * DM * 2, W_DN = W_GU + (size_t)2 * DFF * DM * 2, W_LAYER = W_DN + (size_t)DM * DFF * 2;
constexpr size_t WS_XN = WS_W + 2 * W_LAYER;
constexpr size_t WS_BIG = WS_XN + (size_t)T * DM * 2;
constexpr size_t BIG_BYTES = (size_t)T * DFF * 2;
constexpr size_t WS_QA = WS_BIG + BIG_BYTES;
constexpr size_t WS_KA = WS_QA + (size_t)T * 768 * 2;
constexpr size_t WS_VA = WS_KA + (size_t)T * 768 * 2;
constexpr size_t WS_END = WS_VA + (size_t)T * 512 * 2;
static_assert((size_t)T * INP * 2 <= BIG_BYTES, "PROJ fits under FF");
static_assert(WS_END <= (size_t)536870912, "workspace map fits 512 MiB");

constexpr int LDS_SLOT = 139264;
constexpr int LDS_BYTES = LDS_SLOT + 256;

__device__ __forceinline__ unsigned cvt_pk_bf16(float lo, float hi) { unsigned r; asm volatile("v_cvt_pk_bf16_f32 %0, %1, %2" : "=v"(r) : "v"(lo), "v"(hi)); return r; }
__device__ __forceinline__ float bf2f(unsigned short b) { return __uint_as_float(((unsigned)b) << 16); }
__device__ __forceinline__ float bflo(unsigned w) { return __uint_as_float(w << 16); }
__device__ __forceinline__ float bfhi(unsigned w) { return __uint_as_float(w & 0xffff0000u); }
__device__ __forceinline__ unsigned short f2bf(float f) { return (unsigned short)(cvt_pk_bf16(f, f) & 0xffffu); }
__device__ __forceinline__ float wave_sum(float v, const int lane) {
#pragma unroll
    for (int o = 1; o < 64; o <<= 1) v += __builtin_bit_cast(float, __builtin_amdgcn_ds_bpermute((lane ^ o) << 2, __builtin_bit_cast(int, v)));
    return v;
}


#define XB_TMO      128
#define XB_XCNT(j)  (256  + 64 * (j))
#define XB_XSUB(j)  (1280 + 64 * (j))
#define XB_XGEN(j)  (2304 + 64 * (j))
#define XB_TOP      3328
#define XB_TOPGEN   3392
#define XCD_BAR_WORDS 3456
#define XB_SPIN_CAP (1u << 18)
__device__ __forceinline__ unsigned xb_ld(unsigned* p)              { return __hip_atomic_load(p, __ATOMIC_RELAXED, __HIP_MEMORY_SCOPE_AGENT); }
__device__ __forceinline__ unsigned xb_add(unsigned* p, unsigned v) { return __hip_atomic_fetch_add(p, v, __ATOMIC_RELAXED, __HIP_MEMORY_SCOPE_AGENT); }
__device__ __forceinline__ unsigned xb_xcc_id() { return (unsigned)__builtin_amdgcn_s_getreg((3 << 11) | 20) & 0xFu; }
#define XB_SPIN(cond, bar) do { unsigned _sp = 0; while (cond) { __builtin_amdgcn_s_sleep(1); \
    if ((++_sp & 255u) == 0u) { if (xb_ld(&(bar)[XB_TMO])) break; if (_sp > XB_SPIN_CAP) { atomicAdd(&(bar)[XB_TMO], 1u); break; } } } } while (0)
struct XcdBarrier { unsigned* bar; unsigned x; volatile LAS unsigned* st; };
__device__ __forceinline__ XcdBarrier xcd_barrier_post(unsigned* bar, volatile LAS unsigned* st) {
    XcdBarrier b; b.bar = bar; b.x = xb_xcc_id(); b.st = st;
    if (threadIdx.x == 0) (void)xb_add(&bar[XB_XCNT(b.x)], 1u);
    return b;
}
__device__ __forceinline__ void xcd_barrier_complete(unsigned* bar, unsigned x, unsigned& nloc, unsigned& nx) {
    const unsigned G = gridDim.x * gridDim.y * gridDim.z;
    unsigned sum, cnt, mine, sp = 0u;
    for (;;) {
        sum = 0u; cnt = 0u; mine = 0u;
#pragma unroll
        for (unsigned j = 0; j < 16; ++j) { const unsigned c = xb_ld(&bar[XB_XCNT(j)]); sum += c; cnt += (c > 0u) ? 1u : 0u; mine = (j == x) ? c : mine; }
        if (sum == G) break;
        __builtin_amdgcn_s_sleep(1);
        if ((++sp & 255u) == 0u) { if (xb_ld(&bar[XB_TMO])) break; if (sp > XB_SPIN_CAP) { atomicAdd(&bar[XB_TMO], 1u); break; } }
    }
    nloc = mine > 0u ? mine : 1u; nx = cnt > 0u ? cnt : 1u;
}
__device__ __forceinline__ void xcd_barrier(const XcdBarrier& b) {
    asm volatile("s_waitcnt vmcnt(0)" ::: "memory");
    __syncthreads();
    if (threadIdx.x == 0) {
        unsigned* bar = b.bar;
        __builtin_amdgcn_s_waitcnt(0);
        unsigned nloc = b.st[0], nx = b.st[1];
        if (nloc == 0u) { xcd_barrier_complete(bar, b.x, nloc, nx); b.st[0] = nloc; b.st[1] = nx; }
        const unsigned old = xb_add(&bar[XB_XSUB(b.x)], 1u);
        const unsigned gen = old / nloc;
        if (old + 1u == (gen + 1u) * nloc) {
            __builtin_amdgcn_fence(__ATOMIC_RELEASE, "agent");
            asm volatile("s_waitcnt vmcnt(0)" ::: "memory");
            const unsigned og = xb_add(&bar[XB_TOP], 1u);
            const unsigned tg = og / nx;
            if (og + 1u == (tg + 1u) * nx) xb_add(&bar[XB_TOPGEN], 1u);
            else XB_SPIN(xb_ld(&bar[XB_TOPGEN]) == tg, bar);
            __builtin_amdgcn_fence(__ATOMIC_ACQUIRE, "agent");
            xb_add(&bar[XB_XGEN(b.x)], 1u);
            asm volatile("s_waitcnt vmcnt(0)" ::: "memory");
        } else {
            XB_SPIN(xb_ld(&bar[XB_XGEN(b.x)]) == gen, bar);
            __builtin_amdgcn_fence(__ATOMIC_ACQUIRE, "agent");
            asm volatile("s_waitcnt vmcnt(0)" ::: "memory");
        }
    }
    __syncthreads();
}

namespace pg8 {
constexpr int BM = 256, BK = 64, HALF = 128, HTB = HALF * BK * 2, STAGE_BYTES = 8 * HTB, NXCD = 8, WGM = 8;
__host__ __device__ __forceinline__ int lds_byte(int r, int c) { const int st = (r >> 4) * 2 + (c >> 5), rr = r & 15, cc = c & 31, ob = rr * 64 + cc * 2; return st * 1024 + (ob ^ (((ob >> 9) & 1) << 5)); }
__host__ __device__ __forceinline__ void stage_rc(int b, int& R, int& C) { const int st = b / 1024, sb = b % 1024, swz = sb ^ (((sb >> 9) & 1) << 5); R = (st >> 1) * 16 + swz / 64; C = (st & 1) * 32 + (swz % 64) / 2; }
__host__ __device__ __forceinline__ int perm32(int rho) { const int n = rho >> 4, i = rho & 15; return 8 * (i >> 2) + 4 * n + (i & 3); }

struct Unit { int pm, pn; };
struct Gemm { const bf16_t* A; const bf16_t* Bt; int lda, K; };

struct StaticOrder {
    int nM, nN, nwg, G, c;
    __device__ void init(int M, int N, int G_, int c_) { nM = M / BM; nN = N / BM; nwg = nM * nN; G = G_; c = c_; }
    __device__ bool next(int i, Unit& u) const {
        const long L = (long)i * G + c; if (L >= nwg) return false;
        int wgid = (int)L; { const int q = nwg / NXCD, r = nwg % NXCD, xcd = wgid % NXCD, off = wgid / NXCD; wgid = (xcd < r ? xcd * (q + 1) : r * (q + 1) + (xcd - r) * q) + off; }
        const int nig = WGM * nN, gid = wgid / nig, fm = gid * WGM, gsz = (nM - fm) < WGM ? (nM - fm) : WGM;
        u.pm = fm + ((wgid % nig) % gsz); u.pn = (wgid % nig) / gsz; return true;
    }
};

struct EpiRes {
    static constexpr bool KSCALE = true;
    static constexpr bool PERM = true;
    const float* base32; const bf16_t* base16; float* out32; bf16_t* out16; int ldc; u64* rss; const u64* yss;
    __device__ __forceinline__ void kscale(f32x4 (&acc)[2][2][4][2], const Unit& u, int t, int tid_) const {
        asm volatile("" : "+v"(tid_)); const int row0 = u.pm * BM + (__builtin_amdgcn_readfirstlane(tid_ >> 6) >> 2) * 64 + (tid_ & 15);
#pragma unroll
        for (int ai = 0; ai < 2; ++ai)
#pragma unroll
            for (int m = 0; m < 4; ++m) { const u64* yq = yss + (size_t)(row0 + ai * HALF + m * 16) * 4 + (t == 8 ? 0 : 1);
                const float wp = (t == 8) ? (1.f / 512.f) : (1.f / 768.f);
                const float vp = fx_get(yq) * wp + 1e-6f, vn = fx_get(yq + 1) * (1.f / 768.f) + 1e-6f;
                const float sc = __builtin_amdgcn_sqrtf(vn * __builtin_amdgcn_rcpf(vp));
#pragma unroll
                for (int bj = 0; bj < 2; ++bj)
#pragma unroll
                    for (int n = 0; n < 2; ++n) acc[ai][bj][m][n] *= sc;
                asm volatile("" ::: "memory"); }
    }
    __device__ __forceinline__ void operator()(const f32x4 (&acc)[2][2][4][2], const Unit& u, int tid_) const {
        asm volatile("" : "+v"(tid_)); const int lane = tid_ & 63, wid_ = __builtin_amdgcn_readfirstlane(tid_ >> 6), wr = wid_ >> 2, wc = wid_ & 3, fr = lane & 15, fq = lane >> 4;
        const int row0 = u.pm * BM + wr * 64 + fr, col0 = u.pn * BM + wc * 32 + 8 * fq;
#pragma unroll
        for (int ai = 0; ai < 2; ++ai)
#pragma unroll
            for (int m = 0; m < 4; ++m) { const size_t off = (size_t)(row0 + ai * HALF + m * 16) * ldc + col0; float ss = 0.f;
                const float rc = yss ? 1.0f / sqrtf(fx_get(yss + (size_t)(row0 + ai * HALF + m * 16) * 4 + 2) * (1.f / 768.f) + 1e-6f) : 1.0f;
#pragma unroll
                for (int bj = 0; bj < 2; ++bj) { f32x4 b0, b1;
                    if (base16) { const u32x4 w = *(const u32x4*)(base16 + off + bj * HALF); b0 = (f32x4){bflo(w.x), bfhi(w.x), bflo(w.y), bfhi(w.y)}; b1 = (f32x4){bflo(w.z), bfhi(w.z), bflo(w.w), bfhi(w.w)}; }
                    else { b0 = *(const f32x4*)(base32 + off + bj * HALF); b1 = *(const f32x4*)(base32 + off + bj * HALF + 4); }
                    const f32x4 v0 = b0 + acc[ai][bj][m][0] * rc, v1 = b1 + acc[ai][bj][m][1] * rc;
                    if (out16) { u32x4 w; w.x = cvt_pk_bf16(v0[0], v0[1]); w.y = cvt_pk_bf16(v0[2], v0[3]); w.z = cvt_pk_bf16(v1[0], v1[1]); w.w = cvt_pk_bf16(v1[2], v1[3]); *(u32x4*)(out16 + off + bj * HALF) = w; }
                    if (out32) { *(f32x4*)(out32 + off + bj * HALF) = v0; *(f32x4*)(out32 + off + bj * HALF + 4) = v1; }
                    ss += (v0[0] * v0[0] + v0[1] * v0[1]) + (v0[2] * v0[2] + v0[3] * v0[3]) + (v1[0] * v1[0] + v1[1] * v1[1]) + (v1[2] * v1[2] + v1[3] * v1[3]); }
                if (rss) {
                    ss += __builtin_bit_cast(float, __builtin_amdgcn_ds_bpermute((lane ^ 16) << 2, __builtin_bit_cast(int, ss)));
                    ss += __builtin_bit_cast(float, __builtin_amdgcn_ds_bpermute((lane ^ 32) << 2, __builtin_bit_cast(int, ss)));
                    if (fq == 0) fx_add(rss + row0 + ai * HALF + m * 16, ss); } }
    }
};
struct EpiBf {
    static constexpr bool KSCALE = false;
    static constexpr bool PERM = true;
    bf16_t* O; bf16_t* O2; int ldc; int mode; const u64* rss; int rstride; float invw; u64* css;
    __device__ __forceinline__ void operator()(const f32x4 (&acc)[2][2][4][2], const Unit& u, int tid_) const {
        asm volatile("" : "+v"(tid_)); const int lane = tid_ & 63, wid_ = __builtin_amdgcn_readfirstlane(tid_ >> 6), wr = wid_ >> 2, wc = wid_ & 3, fr = lane & 15, fq = lane >> 4;
        const int row0 = u.pm * BM + wr * 64 + fr, cw = wc * 32 + 8 * fq;
        if (mode == 2) {
#pragma unroll
            for (int ai = 0; ai < 2; ++ai)
#pragma unroll
                for (int m = 0; m < 4; ++m) { const int r = row0 + ai * HALF + m * 16; bf16_t* rowp = O + (size_t)r * ldc + u.pn * HALF + cw;
                    const float rs = 1.0f / sqrtf(fx_get(rss + (size_t)r * rstride) * invw + 1e-6f);
                    float v[8];
#pragma unroll
                    for (int n = 0; n < 2; ++n)
#pragma unroll
                        for (int j = 0; j < 4; ++j) { const float g = acc[ai][0][m][n][j] * rs, up = acc[ai][1][m][n][j] * rs;
                            const float e = __builtin_amdgcn_exp2f(-g * 1.4426950408889634f); v[n * 4 + j] = g * __builtin_amdgcn_rcpf(1.0f + e) * up; }
                    u32x4 w; w.x = cvt_pk_bf16(v[0], v[1]); w.y = cvt_pk_bf16(v[2], v[3]); w.z = cvt_pk_bf16(v[4], v[5]); w.w = cvt_pk_bf16(v[6], v[7]);
                    *(u32x4*)rowp = w; }
        } else {
#pragma unroll
            for (int ai = 0; ai < 2; ++ai)
#pragma unroll
                for (int m = 0; m < 4; ++m) { const size_t r = (size_t)(row0 + ai * HALF + m * 16);
                    const float rs = rss ? 1.0f / sqrtf(fx_get(rss + r * rstride) * invw + 1e-6f) : 1.0f; float ss = 0.f;
#pragma unroll
                    for (int bj = 0; bj < 2; ++bj) { const f32x4 v0 = acc[ai][bj][m][0] * rs, v1 = acc[ai][bj][m][1] * rs;
                        ss += (v0[0] * v0[0] + v0[1] * v0[1]) + (v0[2] * v0[2] + v0[3] * v0[3]) + (v1[0] * v1[0] + v1[1] * v1[1]) + (v1[2] * v1[2] + v1[3] * v1[3]);
                        u32x4 w; w.x = cvt_pk_bf16(v0[0], v0[1]); w.y = cvt_pk_bf16(v0[2], v0[3]); w.z = cvt_pk_bf16(v1[0], v1[1]); w.w = cvt_pk_bf16(v1[2], v1[3]);
                        bf16_t* p;
                        if (mode == 0) p = O + r * ldc + u.pn * BM + bj * HALF + cw;
                        else p = (bj == 0) ? (O + r * 768 + u.pn * 192 + cw) : (O2 + r * 512 + u.pn * 128 + cw);
                        *(u32x4*)p = w; }
                    if (css != nullptr && u.pn < 4) {
                        ss += __builtin_bit_cast(float, __builtin_amdgcn_ds_bpermute((lane ^ 16) << 2, __builtin_bit_cast(int, ss)));
                        ss += __builtin_bit_cast(float, __builtin_amdgcn_ds_bpermute((lane ^ 32) << 2, __builtin_bit_cast(int, ss)));
                        if (fq == 0) fx_add(css + r * 2 + (u.pn >> 1), ss); } }
        }
    }
};

template <class Epi, class Sched, bool ALIGN_EPI = true, bool SP2 = true>
__device__ __forceinline__ void gemm_phase(LAS unsigned char* lds, const Gemm g, const Sched& S, const Epi& E, const int tid) {
    const int wid = __builtin_amdgcn_readfirstlane(tid >> 6), lane = tid & 63, wr = wid >> 2, wc = wid & 3, fr = lane & 15, fq = lane >> 4;
    const int K = g.K, nt = K / BK, lda = g.lda;
    unsigned voffA[2], voffB[2];
#pragma unroll
    for (int i = 0; i < 2; ++i) { int R, C; stage_rc(tid * 16 + i * 8192, R, C); const int Rb = Epi::PERM ? ((R & ~31) + perm32(R & 31)) : R;
        voffA[i] = (unsigned)(R * lda + C) * 2u; voffB[i] = (unsigned)(Rb * K + C) * 2u; }
    const size_t kstep = (size_t)(BK * 2);
    const size_t hstepA = (size_t)HALF * lda * 2, hstepB = (size_t)HALF * K * 2;
    const size_t tstepA = 2 * hstepA, tstepB = 2 * hstepB;
    const unsigned ldsw = (unsigned)wid * 1024u;
    const int aoff = lds_byte(wr * 64 + fr, fq * 8), boff = lds_byte(wc * 32 + fr, fq * 8);
#define PG8_SA(b, h) (((b) * 2 + (h)) * HTB)
#define PG8_SB(b, h) ((4 + (b) * 2 + (h)) * HTB)
#define PG8_STAGE(bufoff, gbase, voff) do { _Pragma("unroll") for (int _i = 0; _i < 2; ++_i) \
        __builtin_amdgcn_global_load_lds((const unsigned*)((const char*)(gbase) + (voff)[_i]), (LAS unsigned*)(lds + (bufoff) + ldsw + _i * 8192), 16, 0, 0); } while (0)
#define PG8_LDA(dst, b, h) do { _Pragma("unroll") for (int m = 0; m < 4; ++m) _Pragma("unroll") for (int k = 0; k < 2; ++k) dst[m][k] = *(const LAS bf16x8*)(lds + PG8_SA(b, h) + aoff + m * 2048 + k * 1024); } while (0)
#define PG8_LDB(dst, b, h) do { _Pragma("unroll") for (int n = 0; n < 2; ++n) _Pragma("unroll") for (int k = 0; k < 2; ++k) dst[n][k] = *(const LAS bf16x8*)(lds + PG8_SB(b, h) + boff + n * 2048 + k * 1024); } while (0)
#define PG8_MMA(ai, bj, At, Bt) do { __builtin_amdgcn_s_setprio(1); _Pragma("unroll") for (int m = 0; m < 4; ++m) _Pragma("unroll") for (int n = 0; n < 2; ++n) _Pragma("unroll") for (int k = 0; k < 2; ++k) \
        acc[ai][bj][m][n] = __builtin_amdgcn_mfma_f32_16x16x32_bf16(Bt[n][k], At[m][k], acc[ai][bj][m][n], 0, 0, 0); __builtin_amdgcn_s_setprio(0); } while (0)
#define PG8_WAIT_V(n) asm volatile("s_waitcnt vmcnt(" #n ")" ::: "memory")
#define PG8_WAIT_L(n) asm volatile("s_waitcnt lgkmcnt(" #n ")" ::: "memory")
#define PG8_BAR __builtin_amdgcn_s_barrier()
#define PG8_SCHED __builtin_amdgcn_sched_barrier(0)
    Unit cur, nxt; int ui = 0;
    if (!S.next(0, cur)) return;
    f32x4 acc[2][2][4][2];
#pragma unroll
    for (int a = 0; a < 2; ++a)
#pragma unroll
        for (int b = 0; b < 2; ++b)
#pragma unroll
            for (int m = 0; m < 4; ++m)
#pragma unroll
                for (int n = 0; n < 2; ++n) acc[a][b][m][n] = (f32x4){0.f, 0.f, 0.f, 0.f};
    bf16x8 At[4][2], B0[2][2], B1[2][2];
    const char* cA = (const char*)g.A + (size_t)cur.pm * tstepA; const char* cB = (const char*)g.Bt + (size_t)cur.pn * tstepB;
    if constexpr (SP2) {
        PG8_STAGE(PG8_SB(0, 0), cB, voffB); PG8_STAGE(PG8_SB(0, 1), cB + hstepB, voffB); PG8_STAGE(PG8_SA(0, 0), cA, voffA); PG8_STAGE(PG8_SA(0, 1), cA + hstepA, voffA);
        if (wr == 1) PG8_BAR;
        PG8_WAIT_V(2); PG8_BAR;
        PG8_STAGE(PG8_SB(1, 0), cB + kstep, voffB); PG8_STAGE(PG8_SA(1, 0), cA + kstep, voffA); PG8_STAGE(PG8_SB(1, 1), cB + hstepB + kstep, voffB);
        PG8_WAIT_V(6); PG8_BAR;
    } else {
        PG8_STAGE(PG8_SB(0, 0), cB, voffB); PG8_STAGE(PG8_SA(0, 0), cA, voffA); PG8_STAGE(PG8_SB(0, 1), cB + hstepB, voffB); PG8_STAGE(PG8_SA(0, 1), cA + hstepA, voffA);
        if (wr == 1) PG8_BAR;
        PG8_WAIT_V(4); PG8_BAR;
        PG8_STAGE(PG8_SB(1, 0), cB + kstep, voffB); PG8_STAGE(PG8_SA(1, 0), cA + kstep, voffA); PG8_STAGE(PG8_SB(1, 1), cB + hstepB + kstep, voffB);
        PG8_WAIT_V(6); PG8_BAR;
    }
    for (;;) {
        const bool has_next = S.next(ui + 1, nxt);
        const char* nA = has_next ? (const char*)g.A + (size_t)nxt.pm * tstepA : cA; const char* nB = has_next ? (const char*)g.Bt + (size_t)nxt.pn * tstepB : cB;
        for (int t = 0; t < nt; t += 2) {
            const bool last = (t == nt - 2);
            const char* a1 = cA + (size_t)(t + 1) * kstep;
            const char* a2 = last ? nA : cA + (size_t)(t + 2) * kstep; const char* b2 = last ? nB : cB + (size_t)(t + 2) * kstep;
            const char* a3 = a2 + kstep; const char* b3 = b2 + kstep;
            if constexpr (Epi::KSCALE) { if (E.yss != nullptr && (t == 8 || t == 20)) E.kscale(acc, cur, t, tid); }
            if constexpr (SP2) {
            PG8_LDB(B0, 0, 0); PG8_LDB(B1, 0, 1); PG8_SCHED; PG8_LDA(At, 0, 0); PG8_STAGE(PG8_SA(1, 1), a1 + hstepA, voffA);
            PG8_WAIT_V(8); PG8_WAIT_L(0); PG8_BAR; PG8_MMA(0, 0, At, B0); PG8_MMA(0, 1, At, B1); PG8_BAR; PG8_SCHED;
            PG8_LDA(At, 0, 1); PG8_STAGE(PG8_SB(0, 0), b2, voffB); PG8_STAGE(PG8_SB(0, 1), b2 + hstepB, voffB); PG8_STAGE(PG8_SA(0, 0), a2, voffA);
            PG8_WAIT_V(8); PG8_WAIT_L(0); PG8_BAR; PG8_MMA(1, 0, At, B0); PG8_MMA(1, 1, At, B1); PG8_BAR; PG8_SCHED;
            PG8_LDB(B0, 1, 0); PG8_LDB(B1, 1, 1); PG8_SCHED; PG8_LDA(At, 1, 0); PG8_STAGE(PG8_SA(0, 1), a2 + hstepA, voffA);
            PG8_WAIT_V(8); PG8_WAIT_L(0); PG8_BAR; PG8_MMA(0, 0, At, B0); PG8_MMA(0, 1, At, B1); PG8_BAR; PG8_SCHED;
            PG8_LDA(At, 1, 1); PG8_STAGE(PG8_SB(1, 0), b3, voffB); PG8_STAGE(PG8_SB(1, 1), b3 + hstepB, voffB); PG8_STAGE(PG8_SA(1, 0), a3, voffA);
            PG8_WAIT_V(8); PG8_WAIT_L(0); PG8_BAR; PG8_MMA(1, 0, At, B0); PG8_MMA(1, 1, At, B1); PG8_BAR; PG8_SCHED;
            } else {
            PG8_LDB(B0, 0, 0); PG8_SCHED; PG8_LDA(At, 0, 0); PG8_STAGE(PG8_SA(1, 1), a1 + hstepA, voffA);
            PG8_WAIT_L(8); PG8_BAR; PG8_WAIT_L(0); PG8_MMA(0, 0, At, B0); PG8_BAR; PG8_SCHED;
            PG8_LDB(B1, 0, 1); PG8_STAGE(PG8_SB(0, 0), b2, voffB);
            PG8_BAR; PG8_WAIT_L(0); PG8_MMA(0, 1, At, B1); PG8_BAR;
            PG8_LDA(At, 0, 1); PG8_STAGE(PG8_SA(0, 0), a2, voffA);
            PG8_BAR; PG8_WAIT_L(0); PG8_MMA(1, 0, At, B0); PG8_BAR; PG8_SCHED;
            PG8_STAGE(PG8_SB(0, 1), b2 + hstepB, voffB);
            PG8_WAIT_V(6); PG8_BAR; PG8_MMA(1, 1, At, B1); PG8_BAR;
            PG8_LDB(B0, 1, 0); PG8_SCHED; PG8_LDA(At, 1, 0); PG8_STAGE(PG8_SA(0, 1), a2 + hstepA, voffA);
            PG8_WAIT_L(8); PG8_BAR; PG8_WAIT_L(0); PG8_MMA(0, 0, At, B0); PG8_BAR; PG8_SCHED;
            PG8_LDB(B1, 1, 1); PG8_STAGE(PG8_SB(1, 0), b3, voffB);
            PG8_BAR; PG8_WAIT_L(0); PG8_MMA(0, 1, At, B1); PG8_BAR;
            PG8_LDA(At, 1, 1); PG8_STAGE(PG8_SA(1, 0), a3, voffA);
            PG8_BAR; PG8_WAIT_L(0); PG8_MMA(1, 0, At, B0); PG8_BAR; PG8_SCHED;
            PG8_STAGE(PG8_SB(1, 1), b3 + hstepB, voffB);
            PG8_WAIT_V(6); PG8_BAR; PG8_MMA(1, 1, At, B1); PG8_BAR;
            }
        }
        if constexpr (ALIGN_EPI) { if (wr == 0) PG8_BAR; }
        E(acc, cur, tid);
        if (!has_next) break;
#pragma unroll
        for (int a = 0; a < 2; ++a)
#pragma unroll
            for (int b = 0; b < 2; ++b)
#pragma unroll
                for (int m = 0; m < 4; ++m)
#pragma unroll
                    for (int n = 0; n < 2; ++n) acc[a][b][m][n] = (f32x4){0.f, 0.f, 0.f, 0.f};
        cur = nxt; cA = nA; cB = nB; ++ui;
        if constexpr (ALIGN_EPI) { if (wr == 1) PG8_BAR; }
    }
    PG8_WAIT_V(0);
    if constexpr (!ALIGN_EPI) { if (wr == 0) PG8_BAR; }
    PG8_BAR;
#undef PG8_SA
#undef PG8_SB
#undef PG8_STAGE
#undef PG8_LDA
#undef PG8_LDB
#undef PG8_MMA
#undef PG8_WAIT_V
#undef PG8_WAIT_L
#undef PG8_BAR
#undef PG8_SCHED
}
}

namespace att {
constexpr int KVBLK = 64, QBLK = 32;
constexpr float THR = 8.f;
#define SBAR() __builtin_amdgcn_sched_barrier(0)
__device__ __forceinline__ int crow(int r, int hi) { return (r & 3) + 8 * (r >> 2) + 4 * hi; }
__device__ __forceinline__ float dbias(int d) {
    const int ad = d < 0 ? -d : d;
    const int c = (ad <= 64 ? 1 : 0) + ((((d & 3) == 0) && ad <= 256) ? 1 : 0) + ((((d & 15) == 0) && ad <= 1024) ? 1 : 0);
    return c == 0 ? -__builtin_inff() : (c == 1 ? 0.f : (c == 2 ? 1.f : 1.5849625007211562f));
}
template <bool MASK>
__device__ __forceinline__ void partialSM(f32x16& p0, f32x16& p1, float& m_reg, float& mn, float& alpha, const float C, const float thr, const int dbase, const int dwave) {
    if constexpr (MASK) {
        if ((dwave - 31 > 256 && dwave + 63 <= 1024) || (dwave + 63 < -256 && dwave - 31 >= -1024)) {
            const int tl = dbase & 15; const float ninf = -__builtin_inff();
#pragma unroll
            for (int r = 0; r < 8; ++r) { const bool hit = tl == ((16 - ((r & 3) + 8 * (r >> 2))) & 15);
                p0[r] = hit ? p0[r] * C : ninf; p0[r + 8] = hit ? p0[r + 8] * C : ninf; p1[r] = hit ? p1[r] * C : ninf; p1[r + 8] = hit ? p1[r + 8] * C : ninf; }
        } else {
#pragma unroll
            for (int r = 0; r < 16; ++r) { const int d = dbase + (r & 3) + 8 * (r >> 2); p0[r] = fmaf(p0[r], C, dbias(d)); p1[r] = fmaf(p1[r], C, dbias(d + 32)); }
        }
        float pmax = p0[0];
#pragma unroll
        for (int r = 1; r < 16; ++r) pmax = fmaxf(pmax, p0[r]);
#pragma unroll
        for (int r = 0; r < 16; ++r) pmax = fmaxf(pmax, p1[r]);
        { auto rr = __builtin_amdgcn_permlane32_swap(__float_as_uint(pmax), __float_as_uint(pmax), false, false);
          pmax = fmaxf(__uint_as_float(rr[0]), __uint_as_float(rr[1])); }
        if (__builtin_expect(__all(pmax - m_reg <= thr), 1)) { mn = m_reg; alpha = 1.f; }
        else { mn = fmaxf(m_reg, pmax); alpha = __builtin_amdgcn_exp2f(m_reg - mn); m_reg = mn; }
#pragma unroll
        for (int r = 0; r < 16; ++r) { p0[r] = p0[r] - mn; p1[r] = p1[r] - mn; }
#pragma unroll
        for (int r = 0; r < 16; ++r) p0[r] = __builtin_amdgcn_exp2f(p0[r]);
    } else {
        float pmax = p0[0];
#pragma unroll
        for (int r = 1; r < 16; ++r) pmax = fmaxf(pmax, p0[r]);
#pragma unroll
        for (int r = 0; r < 16; ++r) pmax = fmaxf(pmax, p1[r]);
        { auto rr = __builtin_amdgcn_permlane32_swap(__float_as_uint(pmax), __float_as_uint(pmax), false, false);
          pmax = fmaxf(__uint_as_float(rr[0]), __uint_as_float(rr[1])); }
        if (__builtin_expect(__all(pmax - m_reg <= thr), 1)) { mn = m_reg; alpha = 1.f; }
        else { mn = fmaxf(m_reg, pmax); alpha = __builtin_amdgcn_exp2f((m_reg - mn) * C); m_reg = mn; }
        const float mnC = -mn * C;
#pragma unroll
        for (int r = 0; r < 16; ++r) p0[r] = fmaf(p0[r], C, mnC);
#pragma unroll
        for (int r = 0; r < 16; ++r) p1[r] = fmaf(p1[r], C, mnC);
#pragma unroll
        for (int r = 0; r < 16; ++r) p0[r] = __builtin_amdgcn_exp2f(p0[r]);
    }
}
__device__ __forceinline__ void finishSM(f32x16& p0, f32x16& p1, float alpha, float& l_reg, bf16x8& pa0, bf16x8& pa1, bf16x8& pa2, bf16x8& pa3) {
#pragma unroll
    for (int r = 0; r < 16; ++r) p1[r] = __builtin_amdgcn_exp2f(p1[r]);
    float ps = 0;
#pragma unroll
    for (int r = 0; r < 16; ++r) ps += p0[r];
#pragma unroll
    for (int r = 0; r < 16; ++r) ps += p1[r];
    { auto rr = __builtin_amdgcn_permlane32_swap(__float_as_uint(ps), __float_as_uint(ps), false, false);
      ps = __uint_as_float(rr[0]) + __uint_as_float(rr[1]); }
    l_reg = l_reg * alpha + ps;
#define PK4(P, BASE, OUT) do { unsigned a0 = cvt_pk_bf16(P[BASE + 0], P[BASE + 1]), a1 = cvt_pk_bf16(P[BASE + 2], P[BASE + 3]);   \
    unsigned b0 = cvt_pk_bf16(P[BASE + 4], P[BASE + 5]), b1 = cvt_pk_bf16(P[BASE + 6], P[BASE + 7]);                              \
    auto r0 = __builtin_amdgcn_permlane32_swap(a0, b0, false, false); auto r1 = __builtin_amdgcn_permlane32_swap(a1, b1, false, false); \
    u32x4 w = {r0[0], r1[0], r0[1], r1[1]}; OUT = __builtin_bit_cast(bf16x8, w); } while (0)
    PK4(p0, 0, pa0); PK4(p0, 8, pa1); PK4(p1, 0, pa2); PK4(p1, 8, pa3);
#undef PK4
}
template <int DK>
__device__ __forceinline__ void qkt(f32x16& p0, f32x16& p1, const LAS char* Ks, const bf16x8* qr, const int (&kb)[4], int hi, const LAS char* lds0, unsigned qoff) {
    constexpr int RB = DK * 2;
    p0 = f32x16{}; p1 = f32x16{};
    if constexpr (DK == 128) {
#pragma unroll
        for (int d0 = 0; d0 < 8; ++d0) {
            const bf16x8 b0 = *(const LAS bf16x8*)(Ks + kb[d0 & 3] + (d0 >> 2) * 128);
            const bf16x8 b1 = *(const LAS bf16x8*)(Ks + kb[d0 & 3] + (d0 >> 2) * 128 + 32 * RB);
            p0 = __builtin_amdgcn_mfma_f32_32x32x16_bf16(b0, qr[d0], p0, 0, 0, 0);
            p1 = __builtin_amdgcn_mfma_f32_32x32x16_bf16(b1, qr[d0], p1, 0, 0, 0); }
    } else {
        asm volatile("" : "+v"(qoff));
        bf16x8 b0[2][2], b1[2][2], q[2][2];
#define QK_LD(g, s) do { _Pragma("unroll") for (int e = 0; e < 2; ++e) { const int d0 = 2 * (g) + e; \
            b0[s][e] = *(const LAS bf16x8*)(Ks + kb[d0 & 3] + (d0 >> 2) * 128); b1[s][e] = *(const LAS bf16x8*)(Ks + kb[d0 & 3] + (d0 >> 2) * 128 + 32 * RB); \
            if (d0 >= 6) q[s][e] = *(const LAS bf16x8*)(lds0 + qoff + (d0 - 6) * 1024); } } while (0)
#define QK_MM(g, s) do { _Pragma("unroll") for (int e = 0; e < 2; ++e) { const int d0 = 2 * (g) + e; \
            if (d0 >= 6) { p0 = __builtin_amdgcn_mfma_f32_32x32x16_bf16(b0[s][e], q[s][e], p0, 0, 0, 0); p1 = __builtin_amdgcn_mfma_f32_32x32x16_bf16(b1[s][e], q[s][e], p1, 0, 0, 0); } \
            else { p0 = __builtin_amdgcn_mfma_f32_32x32x16_bf16(b0[s][e], qr[d0], p0, 0, 0, 0); p1 = __builtin_amdgcn_mfma_f32_32x32x16_bf16(b1[s][e], qr[d0], p1, 0, 0, 0); } } } while (0)
        QK_LD(0, 0); SBAR();
        QK_LD(1, 1); SBAR(); QK_MM(0, 0); SBAR();
        QK_LD(2, 0); SBAR(); QK_MM(1, 1); SBAR();
        QK_LD(3, 1); SBAR(); QK_MM(2, 0); SBAR();
        QK_LD(4, 0); SBAR(); QK_MM(3, 1); SBAR();
        QK_LD(5, 1); SBAR(); QK_MM(4, 0); SBAR();
        QK_MM(5, 1); SBAR();
#undef QK_LD
#undef QK_MM
    }
}
__device__ __forceinline__ int v_st(int k, int c) { const int kk = (k & ~0xC) | ((k & 4) << 1) | ((k & 8) >> 1); return ((kk >> 3) * 4 + (c >> 5)) * 512 + ((kk & 7) * 32 + (c & 31)) * 2; }
__device__ __forceinline__ int v_rd_base(int lane) { return ((lane & 3) << 3) | (((lane >> 2) & 3) << 6) | (((lane >> 4) & 1) << 5) | (((lane >> 5) & 1) << 8); }
constexpr int v_rd_off(int d0, int ks, int half) { return d0 * 512 + ks * 4096 + half * 2048; }
template <int OFF> __device__ __forceinline__ s16x4 tr_read(int vb) {
    s16x4 r; asm volatile("ds_read_b64_tr_b16 %0, %1 offset:%2" : "=&v"(r) : "v"(vb), "i"(OFF) : "memory"); return r;
}
template <int D0> __device__ __forceinline__ void pv_one(f32x16& od, int vb, bf16x8 pa0, bf16x8 pa1, bf16x8 pa2, bf16x8 pa3) {
    const s16x4 l0 = tr_read<v_rd_off(D0, 0, 0)>(vb), h0 = tr_read<v_rd_off(D0, 0, 1)>(vb), l1 = tr_read<v_rd_off(D0, 1, 0)>(vb), h1 = tr_read<v_rd_off(D0, 1, 1)>(vb);
    const s16x4 l2 = tr_read<v_rd_off(D0, 2, 0)>(vb), h2 = tr_read<v_rd_off(D0, 2, 1)>(vb), l3 = tr_read<v_rd_off(D0, 3, 0)>(vb), h3 = tr_read<v_rd_off(D0, 3, 1)>(vb);
    asm volatile("s_waitcnt lgkmcnt(0)" ::: "memory"); SBAR();
#define PKV(L, H) (bf16x8){L[0], L[1], L[2], L[3], H[0], H[1], H[2], H[3]}
    od = __builtin_amdgcn_mfma_f32_32x32x16_bf16(pa0, PKV(l0, h0), od, 0, 0, 0);
    od = __builtin_amdgcn_mfma_f32_32x32x16_bf16(pa1, PKV(l1, h1), od, 0, 0, 0);
    od = __builtin_amdgcn_mfma_f32_32x32x16_bf16(pa2, PKV(l2, h2), od, 0, 0, 0);
    od = __builtin_amdgcn_mfma_f32_32x32x16_bf16(pa3, PKV(l3, h3), od, 0, 0, 0);
#undef PKV
}
__device__ __forceinline__ void pv_d0(f32x16* o, int vb, bf16x8 pa0, bf16x8 pa1, bf16x8 pa2, bf16x8 pa3) {
    pv_one<0>(o[0], vb, pa0, pa1, pa2, pa3); pv_one<1>(o[1], vb, pa0, pa1, pa2, pa3); pv_one<2>(o[2], vb, pa0, pa1, pa2, pa3); pv_one<3>(o[3], vb, pa0, pa1, pa2, pa3);
}

template <int DK, bool MASK, int SDEPTH>
__device__ __forceinline__ void attn_unit(const bf16_t* __restrict__ Qb, const int ldq, const bf16_t* __restrict__ Kh, const int ldk, const bf16_t* __restrict__ Vh, const int ldv,
                                          bf16_t* __restrict__ Ob, const int ldo, const int NT, const float scale, LAS char* lds, const f32x2* __restrict__ ropeA, const int qpos0, const int dq0, const int tid, u64* __restrict__ yss) {
    constexpr int RB = DK * 2, SHM_V = KVBLK * 128 * 2, SHM_K = KVBLK * RB;
    const int wid = tid >> 6, lane = tid & 63, r32 = lane & 31, hi = lane >> 5;
    LAS char* V_lds = lds; LAS char* K_lds = lds + 2 * SHM_V;
    const float C = scale * 1.4426950408889634f;
    const float thr = MASK ? THR * 1.4426950408889634f : THR / scale;
    float m_reg = -1e30f, l_reg = 0; f32x16 o[4] = {}; bf16x8 qr[(DK == 192) ? 6 : 8];
    const unsigned qoff = 2 * SHM_V + 2 * SHM_K + 2048 + wid * 6144 + lane * 16;
    int kb[4];
#pragma unroll
    for (int k = 0; k < 4; ++k) kb[k] = r32 * RB + ((hi ^ (r32 & 1)) << 4) + ((k ^ ((r32 & 7) >> 1)) << 5);
    int tq = tid; asm volatile("" : "+v"(tq));
    const bf16_t* Qw = Qb + (size_t)(unsigned)(((tq >> 6) * QBLK + (tq & 31)) * ldq + ((tq >> 5) & 1) * 8);
    constexpr int NQR = (DK == 192) ? 6 : 8;
#pragma unroll
    for (int d0 = 0; d0 < NQR; ++d0) qr[d0] = *(const bf16x8*)(Qw + d0 * 16);
    if constexpr (DK == 192) {
        *(LAS bf16x8*)(lds + qoff) = *(const bf16x8*)(Qw + 6 * 16); *(LAS bf16x8*)(lds + qoff + 1024) = *(const bf16x8*)(Qw + 7 * 16);
        const f32x2* rp = ropeA + (size_t)(unsigned)((qpos0 + (tq >> 6) * QBLK + (tq & 31)) * 32 + ((tq >> 5) & 1) * 8);
#pragma unroll
        for (int dd = 0; dd < 2; ++dd) {
            bf16x8 x1 = *(const bf16x8*)(Qw + (8 + dd) * 16), x2 = *(const bf16x8*)(Qw + (10 + dd) * 16);
#pragma unroll
            for (int e = 0; e < 8; ++e) { const f32x2 cs = rp[dd * 16 + e]; const float a = bf2f((unsigned short)x1[e]), b = bf2f((unsigned short)x2[e]);
                x1[e] = (short)f2bf(a * cs.x - b * cs.y); x2[e] = (short)f2bf(b * cs.x + a * cs.y); }
            *(LAS bf16x8*)(lds + qoff + (2 + dd) * 1024) = x1; *(LAS bf16x8*)(lds + qoff + (4 + dd) * 1024) = x2;
        }
        asm volatile("s_waitcnt lgkmcnt(0)" ::: "memory");
    }
    const int sr = tid >> 4, sc = (tid & 15) * 8, vst0 = v_st(sr, sc); constexpr int vst1d = 8192;
    const int kst0 = sr * RB + ((sc * 2) ^ ((sr & 7) << 4));
    const int kr2 = tid >> 3, kc2 = 128 + (tid & 7) * 8, kst2 = kr2 * RB + ((kc2 * 2) ^ ((kr2 & 7) << 4));
    const int vb0 = (int)(uintptr_t)V_lds + v_rd_base(lane);
    bf16x8 vs0[SDEPTH], vs1[SDEPTH], ks0[SDEPTH], ks1[SDEPTH], ks2[SDEPTH];
    const unsigned voV0 = (unsigned)(sr * ldv + sc) * 2u, voK0 = (unsigned)(sr * ldk + sc) * 2u, voK2 = (unsigned)(kr2 * ldk + kc2) * 2u;
#define SLOAD(i, k0) do { const char* Vt = (const char*)Vh + (size_t)(k0) * (size_t)(ldv * 2); const char* Kt = (const char*)Kh + (size_t)(k0) * (size_t)(ldk * 2); \
    vs0[i] = *(const bf16x8*)(Vt + (size_t)voV0); vs1[i] = *(const bf16x8*)(Vt + (size_t)(ldv * 64) + (size_t)voV0); \
    ks0[i] = *(const bf16x8*)(Kt + (size_t)voK0); ks1[i] = *(const bf16x8*)(Kt + (size_t)(ldk * 64) + (size_t)voK0); \
    if constexpr (DK == 192) ks2[i] = *(const bf16x8*)(Kt + (size_t)voK2); } while (0)
#define SWRITE(b, i) do { *(LAS bf16x8*)(V_lds + (b) * SHM_V + vst0) = vs0[i]; *(LAS bf16x8*)(V_lds + (b) * SHM_V + vst1d + vst0) = vs1[i]; \
    *(LAS bf16x8*)(K_lds + (b) * SHM_K + kst0) = ks0[i]; *(LAS bf16x8*)(K_lds + (b) * SHM_K + 32 * RB + kst0) = ks1[i]; \
    if constexpr (DK == 192) *(LAS bf16x8*)(K_lds + (b) * SHM_K + kst2) = ks2[i]; } while (0)
#define SWAIT() do { if constexpr (SDEPTH == 2) { if constexpr (DK == 192) asm volatile("s_waitcnt vmcnt(5)" ::: "memory"); else asm volatile("s_waitcnt vmcnt(4)" ::: "memory"); } \
    else asm volatile("s_waitcnt vmcnt(0)" ::: "memory"); } while (0)
#define RESC(a) do { if (__any((a) < 1.f)) { int t3 = tid; asm volatile("" : "+v"(t3)); LAS float* al3 = (LAS float*)(lds + 2 * SHM_V + 2 * SHM_K) + (t3 >> 6) * 64 + 32; \
    if (((t3 >> 5) & 1) == 0) al3[t3 & 31] = (a); asm volatile("s_waitcnt lgkmcnt(0)" ::: "memory"); const LAS float* ar3 = al3 + 4 * ((t3 >> 5) & 1); \
    _Pragma("unroll") for (int d = 0; d < 4; ++d) _Pragma("unroll") for (int r = 0; r < 16; ++r) o[d][r] *= ar3[(r & 3) + 8 * (r >> 2)]; } } while (0)
    f32x16 pA0, pA1, pB0, pB1; float mnA, mnB, alA, alB; bf16x8 pa0, pa1, pa2, pa3;
    const int dw0 = dq0 - __builtin_amdgcn_readfirstlane(wid) * QBLK;
    const int db0 = dq0 + 4 * hi - (wid * QBLK + r32);
    constexpr int SE = 0, SO = SDEPTH - 1;
    SLOAD(SE, 0); asm volatile("s_waitcnt vmcnt(0)" ::: "memory"); SWRITE(0, SE); __syncthreads();
    qkt<DK>(pA0, pA1, K_lds, qr, kb, hi, lds, qoff); partialSM<MASK>(pA0, pA1, m_reg, mnA, alA, C, thr, db0, dw0);
    SLOAD(SO, KVBLK); if constexpr (SDEPTH == 2) { if (2 < NT) SLOAD(SE, 2 * KVBLK); }
    SWAIT(); SWRITE(1, SO); __syncthreads();
    for (int j = 1; j + 1 < NT; j += 2) {
        SBAR(); qkt<DK>(pB0, pB1, K_lds + SHM_K, qr, kb, hi, lds, qoff);
        finishSM(pA0, pA1, alA, l_reg, pa0, pa1, pa2, pa3); SBAR();
        SLOAD(SO, (j + SDEPTH) * KVBLK); SBAR();
        pv_d0(o, vb0, pa0, pa1, pa2, pa3); partialSM<MASK>(pB0, pB1, m_reg, mnB, alB, C, thr, db0 + j * KVBLK, dw0 + j * KVBLK);
        __syncthreads(); SWAIT(); SWRITE(0, SE);
        RESC(alB); __syncthreads();
        SBAR(); qkt<DK>(pA0, pA1, K_lds, qr, kb, hi, lds, qoff);
        finishSM(pB0, pB1, alB, l_reg, pa0, pa1, pa2, pa3); SBAR();
        if (SDEPTH == 1 || j + 3 < NT) SLOAD(SE, (j + 1 + SDEPTH) * KVBLK); SBAR();
        pv_d0(o, vb0 + SHM_V, pa0, pa1, pa2, pa3); partialSM<MASK>(pA0, pA1, m_reg, mnA, alA, C, thr, db0 + (j + 1) * KVBLK, dw0 + (j + 1) * KVBLK);
        __syncthreads(); SWAIT(); SWRITE(1, SO);
        RESC(alA); __syncthreads();
    }
    SBAR(); qkt<DK>(pB0, pB1, K_lds + SHM_K, qr, kb, hi, lds, qoff);
    finishSM(pA0, pA1, alA, l_reg, pa0, pa1, pa2, pa3); SBAR();
    pv_d0(o, vb0, pa0, pa1, pa2, pa3); partialSM<MASK>(pB0, pB1, m_reg, mnB, alB, C, thr, db0 + (NT - 1) * KVBLK, dw0 + (NT - 1) * KVBLK);
    __syncthreads(); RESC(alB);
    finishSM(pB0, pB1, alB, l_reg, pa0, pa1, pa2, pa3); SBAR();
    pv_d0(o, vb0 + SHM_V, pa0, pa1, pa2, pa3);
    int to = tid; asm volatile("" : "+v"(to));
    { LAS float* li3 = (LAS float*)(lds + 2 * SHM_V + 2 * SHM_K) + (to >> 6) * 64;
      if (((to >> 5) & 1) == 0) li3[to & 31] = l_reg; asm volatile("s_waitcnt lgkmcnt(0)" ::: "memory"); }
    float rli[16];
    { const LAS float* lr3 = (const LAS float*)(lds + 2 * SHM_V + 2 * SHM_K) + (to >> 6) * 64 + 4 * ((to >> 5) & 1);
#pragma unroll
      for (int r = 0; r < 16; ++r) rli[r] = __builtin_amdgcn_rcpf(lr3[(r & 3) + 8 * (r >> 2)]); }
    const unsigned ooff = (unsigned)((((to >> 6) * QBLK + 4 * ((to >> 5) & 1)) * ldo + (to & 31)) * 2);
    float sq[16];
#pragma unroll
    for (int r = 0; r < 16; ++r) { sq[r] = 0.f;
#pragma unroll
        for (int d0 = 0; d0 < 4; ++d0) { const float v = o[d0][r] * rli[r]; sq[r] += v * v;
            *(bf16_t*)((char*)Ob + (size_t)(ooff + (unsigned)((((r & 3) + 8 * (r >> 2)) * ldo + d0 * 32) * 2))) = f2bf(v); } }
#pragma unroll
    for (int r = 0; r < 16; ++r) {
#pragma unroll
        for (int x = 1; x < 32; x <<= 1) sq[r] += __builtin_bit_cast(float, __builtin_amdgcn_ds_bpermute(((to & 63) ^ x) << 2, __builtin_bit_cast(int, sq[r])));
        if ((to & 31) == r) fx_add(yss + (size_t)((to >> 6) * QBLK + 4 * ((to >> 5) & 1) + (r & 3) + 8 * (r >> 2)) * 4, sq[r]); }
#undef SLOAD
#undef SWRITE
#undef SWAIT
#undef RESC
}
}

struct TrJob { const float* W; bf16_t* WT; const float* gain; int N, Kd, mode, item; };
__device__ __forceinline__ void tr_load(const TrJob& j, int lane, f32x4 (&v)[8]) {
    const int nblk = j.N / 32, kb = j.item / nblk, nb = j.item % nblk, k0 = 64 * kb, n0 = 32 * nb;
    const float* p = j.W + (size_t)(k0 + (lane >> 3)) * j.N + n0 + 4 * (lane & 7);
#pragma unroll
    for (int i = 0; i < 8; ++i) v[i] = *(const f32x4*)(p + (size_t)(8 * i) * j.N);
}
__device__ __forceinline__ void tr_write(LAS float* scr, int lane, const f32x4 (&v)[8]) {
#pragma unroll
    for (int i = 0; i < 8; ++i) { LAS float* d = scr + (8 * i + (lane >> 3)) * 33 + 4 * (lane & 7); d[0] = v[i].x; d[1] = v[i].y; d[2] = v[i].z; d[3] = v[i].w; }
}
__device__ __forceinline__ void tr_store(const TrJob& j, LAS float* scr, int lane) {
    const int nblk = j.N / 32, kb = j.item / nblk, nb = j.item % nblk, k0 = 64 * kb, n0 = 32 * nb;
    const int rb = (j.mode == 0) ? n0 : (256 * (n0 >> 7) + (n0 & 127) + (j.mode == 2 ? 128 : 0));
    const int c = lane & 7;
    f32x4 g0 = {1.f, 1.f, 1.f, 1.f}, g1 = g0;
    if (j.gain) { g0 = *(const f32x4*)(j.gain + k0 + 8 * c); g1 = *(const f32x4*)(j.gain + k0 + 8 * c + 4); }
    asm volatile("s_waitcnt lgkmcnt(0)" ::: "memory");
#pragma unroll
    for (int jj = 0; jj < 4; ++jj) { const int n = (lane >> 3) + 8 * jj; const LAS float* s = scr + (8 * c) * 33 + n;
        u32x4 o; o.x = cvt_pk_bf16(s[0 * 33] * g0.x, s[1 * 33] * g0.y); o.y = cvt_pk_bf16(s[2 * 33] * g0.z, s[3 * 33] * g0.w);
        o.z = cvt_pk_bf16(s[4 * 33] * g1.x, s[5 * 33] * g1.y); o.w = cvt_pk_bf16(s[6 * 33] * g1.z, s[7 * 33] * g1.w);
        *(u32x4*)(j.WT + (size_t)(rb + n) * j.Kd + k0 + 8 * c) = o; }
    asm volatile("s_waitcnt lgkmcnt(0)" ::: "memory");
}

struct Args { const float* in[16]; float* out; unsigned char* ws; int ph_lo, ph_hi; };

constexpr int I_IN = 32 * 146, I_UQ = 8 * 24, I_UKV = 8 * 32, I_OUT = 32 * 64, I_G = 32 * 176, I_DN = 88 * 64;
constexpr int I_LAYER = I_IN + I_UQ + I_UKV + I_OUT + 2 * I_G + I_DN;
constexpr int TR_P0 = I_IN + I_UQ + I_UKV + I_OUT, TR_P1 = I_LAYER + I_IN + I_UQ + I_UKV;
template <class ArgsT>
__device__ __forceinline__ TrJob tr_job(const ArgsT& a, unsigned char* ws, int it) {
    const int l = it / I_LAYER; int r = it % I_LAYER; unsigned char* wl = ws + WS_W + (size_t)l * W_LAYER;
    const float* W; bf16_t* WT; const float* gain; int N, Kd, mode = 0;
    const float *p1 = a.in[1], *p2 = a.in[2], *p3 = a.in[3], *p4 = a.in[4], *p5 = a.in[5], *p6 = a.in[6], *p9 = a.in[9], *p10 = a.in[10], *p11 = a.in[11], *p12 = a.in[12], *p13 = a.in[13], *p14 = a.in[14];
    asm volatile("" : "+s"(p1), "+s"(p2), "+s"(p3), "+s"(p4), "+s"(p5), "+s"(p6)); asm volatile("" : "+s"(p9), "+s"(p10), "+s"(p11), "+s"(p12), "+s"(p13), "+s"(p14));
    if (r < I_IN) { W = p2 + (size_t)l * DM * INW; WT = (bf16_t*)(wl + W_IN); gain = p1 + l * DM; N = INW; Kd = DM; }
    else if ((r -= I_IN) < I_UQ) { W = p4 + (size_t)l * 512 * 768; WT = (bf16_t*)(wl + W_UQ); gain = p3 + l * 512; N = 768; Kd = 512; }
    else if ((r -= I_UQ) < I_UKV) { W = p6 + (size_t)l * 512 * 1024; WT = (bf16_t*)(wl + W_UKV); gain = p5 + l * 512; N = 1024; Kd = 512; }
    else if ((r -= I_UKV) < I_OUT) { W = p10 + (size_t)l * DM * DM; WT = (bf16_t*)(wl + W_OUT); gain = p9 + l * DM; N = DM; Kd = DM; }
    else if ((r -= I_OUT) < I_G) { W = p12 + (size_t)l * DM * DFF; WT = (bf16_t*)(wl + W_GU); gain = p11 + l * DM; N = DFF; Kd = DM; mode = 1; }
    else if ((r -= I_G) < I_G) { W = p13 + (size_t)l * DM * DFF; WT = (bf16_t*)(wl + W_GU); gain = p11 + l * DM; N = DFF; Kd = DM; mode = 2; }
    else { r -= I_G; W = p14 + (size_t)l * DFF * DM; WT = (bf16_t*)(wl + W_DN); gain = nullptr; N = DM; Kd = DFF; }
    TrJob j; j.W = W; j.WT = WT; j.gain = gain; j.N = N; j.Kd = Kd; j.mode = mode; j.item = r; return j;
}
__device__ __forceinline__ void ph_prologue(const Args& a, LAS unsigned char* lds, int gw, int NGW, int lane, int wave) {
    LAS float* scr = (LAS float*)(lds + wave * 16384);
    unsigned char* ws = a.ws;
    { f32x4 v[8]; int it = gw; TrJob cur = tr_job(a, ws, it < TR_P0 ? it : 0);
      if (it < TR_P0) tr_load(cur, lane, v);
      while (it < TR_P0) {
          const int nit = it + NGW;
          tr_write(scr, lane, v);
          TrJob nxt = cur;
          if (nit < TR_P0) { nxt = tr_job(a, ws, nit); tr_load(nxt, lane, v); }
          tr_store(cur, scr, lane);
          cur = nxt; it = nit;
      } }
    const int gt = gw * 64 + lane, NGT = NGW * 64;
    for (int l = 0; l < 2; ++l) { u32x4* z = (u32x4*)(ws + WS_W + (size_t)l * W_LAYER + W_IN + (size_t)INW * DM * 2);
        for (int i = gt; i < (INP - INW) * DM * 2 / 16; i += NGT) z[i] = (u32x4){0u, 0u, 0u, 0u}; }
    { u64* rss = (u64*)(ws + WS_CTL + RSS_OFF); bf16_t* XB = (bf16_t*)(ws + WS_XN);
      for (int i = gt; i < 3 * T; i += NGT) rss[T + i] = 0ull;
      { u64* yz = (u64*)(ws + WS_CTL + YSS_OFF); for (int i = gt; i < 2 * T * 4; i += NGT) yz[i] = 0ull; }
      { u64* cz = (u64*)(ws + WS_CTL + CSS_OFF); for (int i = gt; i < 2 * T * 2; i += NGT) cz[i] = 0ull; }
      for (int m = gw; m < T; m += NGW) {
          const f32x4* xr = (const f32x4*)(a.in[0] + (size_t)m * DM) + lane; u32x2* o = (u32x2*)(XB + (size_t)m * DM) + lane; float sq = 0.f;
#pragma unroll
          for (int j = 0; j < 8; ++j) { const f32x4 v = xr[64 * j]; sq += (v.x * v.x + v.y * v.y) + (v.z * v.z + v.w * v.w);
              u32x2 w; w.x = cvt_pk_bf16(v.x, v.y); w.y = cvt_pk_bf16(v.z, v.w); o[64 * j] = w; }
          sq = wave_sum(sq, lane); if (lane == 0) rss[m] = (u64)(sq * FXS + 0.5f); } }
    f32x2* ra = (f32x2*)(ws + WS_ROPEA); f32x2* r1 = (f32x2*)(ws + WS_ROPE1);
    for (int i = gt; i < 4096 * 32 + 4096 * 64; i += NGT) {
        int pos, fi; float inv; f32x2* dst;
        if (i < 4096 * 32) { pos = i >> 5; fi = i & 31; inv = __builtin_amdgcn_exp2f(-(float)(2 * fi) * (13.287712379549449f / 64.f)); dst = ra + i; }
        else { const int j = i - 4096 * 32; pos = j >> 6; fi = j & 63; inv = __builtin_amdgcn_exp2f(-(float)(2 * fi) * (13.287712379549449f / 128.f)); dst = r1 + j; }
        const float ang = (float)pos * inv;
        const double rev = (double)ang * 0.15915494309189535; const float fr = (float)(rev - __builtin_rint(rev));
        *dst = (f32x2){__builtin_amdgcn_cosf(fr), __builtin_amdgcn_sinf(fr)};
    }
}

__device__ __forceinline__ void ph_norm_bf16(const float* x, const float* g, bf16_t* out, int gw, int NGW, int lane) {
    for (int m = gw; m < T; m += NGW) {
        const f32x4* xr = (const f32x4*)(x + (size_t)m * DM) + lane; f32x4 v[8]; float s = 0.f;
#pragma unroll
        for (int j = 0; j < 8; ++j) { v[j] = xr[64 * j]; s += (v[j].x * v[j].x + v[j].y * v[j].y) + (v[j].z * v[j].z + v[j].w * v[j].w); }
        const float rs = 1.0f / sqrtf(wave_sum(s, lane) * (1.f / DM) + EPS);
        u32x2* o = (u32x2*)(out + (size_t)m * DM) + lane;
#pragma unroll
        for (int j = 0; j < 8; ++j) { const f32x4 gg = ((const f32x4*)g)[lane + 64 * j]; u32x2 w; w.x = cvt_pk_bf16(v[j].x * rs * gg.x, v[j].y * rs * gg.y); w.y = cvt_pk_bf16(v[j].z * rs * gg.z, v[j].w * rs * gg.w); o[64 * j] = w; }
    }
}
__device__ __forceinline__ void unpack8(const u32x4 w, float (&x)[8]) { x[0] = bflo(w.x); x[1] = bfhi(w.x); x[2] = bflo(w.y); x[3] = bfhi(w.y); x[4] = bflo(w.z); x[5] = bfhi(w.z); x[6] = bflo(w.w); x[7] = bfhi(w.w); }
__device__ __forceinline__ u32x4 pack8(const float (&x)[8]) { u32x4 o; o.x = cvt_pk_bf16(x[0], x[1]); o.y = cvt_pk_bf16(x[2], x[3]); o.z = cvt_pk_bf16(x[4], x[5]); o.w = cvt_pk_bf16(x[6], x[7]); return o; }
__device__ __forceinline__ void ph_final(const bf16_t* xb, float* out, const float* g, int gw, int NGW, int lane) {
    for (int m0 = gw; m0 < T; m0 += 2 * NGW) {
        float v[2][4][8]; float s[2] = {0.f, 0.f};
#pragma unroll
        for (int rr = 0; rr < 2; ++rr) { const int mr = (m0 + rr * NGW < T) ? m0 + rr * NGW : m0; const u32x4* xr = (const u32x4*)(xb + (size_t)mr * DM) + lane;
#pragma unroll
            for (int j = 0; j < 4; ++j) { unpack8(xr[64 * j], v[rr][j]);
#pragma unroll
                for (int e = 0; e < 8; ++e) s[rr] += v[rr][j][e] * v[rr][j][e]; } }
#pragma unroll
        for (int rr = 0; rr < 2; ++rr) { if (m0 + rr * NGW >= T) continue; f32x4* o = (f32x4*)(out + (size_t)(m0 + rr * NGW) * DM) + 2 * lane;
            const float rs = 1.0f / sqrtf(wave_sum(s[rr], lane) * (1.f / DM) + EPS);
#pragma unroll
            for (int j = 0; j < 4; ++j) { const f32x4 g0 = ((const f32x4*)g)[2 * (lane + 64 * j)], g1 = ((const f32x4*)g)[2 * (lane + 64 * j) + 1];
                o[128 * j] = (f32x4){v[rr][j][0] * rs * g0.x, v[rr][j][1] * rs * g0.y, v[rr][j][2] * rs * g0.z, v[rr][j][3] * rs * g0.w};
                o[128 * j + 1] = (f32x4){v[rr][j][4] * rs * g1.x, v[rr][j][5] * rs * g1.y, v[rr][j][6] * rs * g1.z, v[rr][j][7] * rs * g1.w}; } }
    }
}
__device__ __forceinline__ void ph_prep(const Args& a, int l, int gw, int NGW, int lane) {
    bf16_t* PROJ = (bf16_t*)(a.ws + WS_BIG); bf16_t* KA = (bf16_t*)(a.ws + WS_KA);
    const f32x2* ra = (const f32x2*)(a.ws + WS_ROPEA); const f32x2* r1 = (const f32x2*)(a.ws + WS_ROPE1);
    const float* gq = a.in[3] + l * 512; const float* gkv = a.in[5] + l * 512; const float* cqn = a.in[7] + l * 128; const float* ckn = a.in[8] + l * 128;
    const int j8 = lane & 7, hd = lane >> 3;
    for (int m0 = gw; m0 < T; m0 += 2 * NGW) {
#pragma unroll
      for (int rr = 0; rr < 2; ++rr) { const int m = m0 + rr * NGW; if (m >= T) continue;
        bf16_t* P = PROJ + (size_t)m * INP; const int s = m & (SEQ - 1);
        if (lane < 4) {
            float x1[8], x2[8]; unpack8(*(const u32x4*)(P + PA_KR + 8 * lane), x1); unpack8(*(const u32x4*)(P + PA_KR + 32 + 8 * lane), x2);
            const f32x4* cp = (const f32x4*)(ra + s * 32 + 8 * lane);
#pragma unroll
            for (int e2 = 0; e2 < 4; ++e2) { const f32x4 cs = cp[e2];
                const float a0 = x1[2 * e2], b0 = x2[2 * e2], a1 = x1[2 * e2 + 1], b1 = x2[2 * e2 + 1];
                x1[2 * e2] = a0 * cs.x - b0 * cs.y; x2[2 * e2] = b0 * cs.x + a0 * cs.y; x1[2 * e2 + 1] = a1 * cs.z - b1 * cs.w; x2[2 * e2 + 1] = b1 * cs.z + a1 * cs.w; }
            const u32x4 y1 = pack8(x1), y2 = pack8(x2); bf16_t* kp = KA + (size_t)m * 768 + 128 + 8 * lane;
#pragma unroll
            for (int h = 0; h < 4; ++h) { *(u32x4*)(kp + h * 192) = y1; *(u32x4*)(kp + h * 192 + 32) = y2; }
        }
        { const f32x4* cp = (const f32x4*)(r1 + s * 64 + 8 * j8); const f32x4 c0 = cp[0], c1 = cp[1], c2 = cp[2], c3 = cp[3];
#pragma unroll
          for (int pass = 0; pass < 2; ++pass) { const int head = 8 * pass + hd;
              if (head < 12) { bf16_t* hp = P + PB_Q + head * 128 + 8 * j8; float x1[8], x2[8]; unpack8(*(const u32x4*)hp, x1); unpack8(*(const u32x4*)(hp + 64), x2);
                  const float cc[8] = {c0.x, c0.z, c1.x, c1.z, c2.x, c2.z, c3.x, c3.z}, sn[8] = {c0.y, c0.w, c1.y, c1.w, c2.y, c2.w, c3.y, c3.w};
#pragma unroll
                  for (int e = 0; e < 8; ++e) { const float p = x1[e], q = x2[e]; x1[e] = p * cc[e] - q * sn[e]; x2[e] = q * cc[e] + p * sn[e]; }
                  *(u32x4*)hp = pack8(x1); *(u32x4*)(hp + 64) = pack8(x2); } } }
        { const int half = j8 >> 2, jj = j8 & 3; bf16_t* hp = P + PC_Q + hd * 128 + 64 * half + 8 * jj;
          float x1[8], x2[8]; unpack8(*(const u32x4*)hp, x1); unpack8(*(const u32x4*)(hp + 32), x2);
          const f32x4* cp = (const f32x4*)(ra + (half ? (s & 63) : (s >> 6)) * 32 + 8 * jj); const f32x4 c0 = cp[0], c1 = cp[1], c2 = cp[2], c3 = cp[3];
          const float* g = (hd < 6 ? cqn : ckn) + 64 * half + 8 * jj; const f32x4 ga = *(const f32x4*)g, gb = *(const f32x4*)(g + 4), gc = *(const f32x4*)(g + 32), gd = *(const f32x4*)(g + 36);
          float ss = 0.f;
#pragma unroll
          for (int e = 0; e < 8; ++e) ss += x1[e] * x1[e] + x2[e] * x2[e];
          ss += __builtin_bit_cast(float, __builtin_amdgcn_ds_bpermute((lane ^ 1) << 2, __builtin_bit_cast(int, ss)));
          ss += __builtin_bit_cast(float, __builtin_amdgcn_ds_bpermute((lane ^ 2) << 2, __builtin_bit_cast(int, ss)));
          ss += __builtin_bit_cast(float, __builtin_amdgcn_ds_bpermute((lane ^ 4) << 2, __builtin_bit_cast(int, ss)));
          const float rs = 1.0f / sqrtf(ss * (1.f / 128.f) + EPS);
          const float g1[8] = {ga.x, ga.y, ga.z, ga.w, gb.x, gb.y, gb.z, gb.w}, g2[8] = {gc.x, gc.y, gc.z, gc.w, gd.x, gd.y, gd.z, gd.w};
          const float cc[8] = {c0.x, c0.z, c1.x, c1.z, c2.x, c2.z, c3.x, c3.z}, sn[8] = {c0.y, c0.w, c1.y, c1.w, c2.y, c2.w, c3.y, c3.w};
#pragma unroll
          for (int e = 0; e < 8; ++e) { const float p = x1[e] * rs * g1[e], q = x2[e] * rs * g2[e]; x1[e] = p * cc[e] - q * sn[e]; x2[e] = q * cc[e] + p * sn[e]; }
          *(u32x4*)hp = pack8(x1); *(u32x4*)(hp + 32) = pack8(x2); }
      }
    }
}
__device__ __forceinline__ void ph_ynorm(bf16_t* Y, const float* g, int gw, int NGW, int lane) {
    for (int m = gw; m < T; m += NGW) {
        u32x4* p = (u32x4*)(Y + (size_t)m * DM) + lane; float x[4][8]; float sa = 0.f, sb = 0.f, sc = 0.f;
#pragma unroll
        for (int j = 0; j < 4; ++j) { const u32x4 w = p[64 * j];
            x[j][0] = bflo(w.x); x[j][1] = bfhi(w.x); x[j][2] = bflo(w.y); x[j][3] = bfhi(w.y); x[j][4] = bflo(w.z); x[j][5] = bfhi(w.z); x[j][6] = bflo(w.w); x[j][7] = bfhi(w.w);
            float ss = 0.f;
#pragma unroll
            for (int e = 0; e < 8; ++e) ss += x[j][e] * x[j][e];
            if (j == 0) sa += ss; else if (j == 1) sb += ss; else if (j == 2) { if (lane < 32) sb += ss; else sc += ss; } else sc += ss; }
        const float ra_ = 1.0f / sqrtf(wave_sum(sa, lane) * (1.f / 512.f) + EPS), rb_ = 1.0f / sqrtf(wave_sum(sb, lane) * (1.f / 768.f) + EPS), rc_ = 1.0f / sqrtf(wave_sum(sc, lane) * (1.f / 768.f) + EPS);
#pragma unroll
        for (int j = 0; j < 4; ++j) { const float rs = (j == 0) ? ra_ : (j == 1) ? rb_ : (j == 2) ? (lane < 32 ? rb_ : rc_) : rc_;
            const float* gp = g + (lane + 64 * j) * 8; const f32x4 g0 = *(const f32x4*)gp, g1 = *(const f32x4*)(gp + 4);
            u32x4 o; o.x = cvt_pk_bf16(x[j][0] * rs * g0.x, x[j][1] * rs * g0.y); o.y = cvt_pk_bf16(x[j][2] * rs * g0.z, x[j][3] * rs * g0.w);
            o.z = cvt_pk_bf16(x[j][4] * rs * g1.x, x[j][5] * rs * g1.y); o.w = cvt_pk_bf16(x[j][6] * rs * g1.z, x[j][7] * rs * g1.w);
            p[64 * j] = o; }
    }
}

#if defined(__HIP_DEVICE_COMPILE__)
__device__ __forceinline__ void ph_attention(const __attribute__((address_space(4))) Args* ap, int l, LAS unsigned char* lds, const int rep) {
    volatile LAS int* slot = (volatile LAS int*)(lds + LDS_SLOT);
#if !defined(NO_ATT_A)
    for (;;) {
        asm volatile("" : "+s"(ap));
        unsigned char* ws = ap->ws;
        const bf16_t* QA = (const bf16_t*)(ws + WS_QA); const bf16_t* KA = (const bf16_t*)(ws + WS_KA);
        const bf16_t* VA = (const bf16_t*)(ws + WS_VA); bf16_t* Y = (bf16_t*)(ws + WS_XN); const f32x2* ra = (const f32x2*)(ws + WS_ROPEA);
        if (threadIdx.x == 0) *slot = (int)__hip_atomic_fetch_add((unsigned*)(ws + WS_CTL) + 64 * (1 + l + 4 * rep), 1u, __ATOMIC_RELAXED, __HIP_MEMORY_SCOPE_AGENT);
        __syncthreads(); const int u = __builtin_amdgcn_readfirstlane(*slot); __syncthreads();
        if (u >= 256) break;
        int tid = threadIdx.x; asm volatile("" : "+v"(tid));
        const int b = u >> 6, h = (u >> 4) & 3, qb = u & 15; const size_t row = (size_t)b * SEQ + qb * 256;
        att::attn_unit<192, false, 1>(QA + row * 768 + h * 192, 768, KA + (size_t)b * SEQ * 768 + h * 192, 768, VA + (size_t)b * SEQ * 512 + h * 128, 512,
                                      Y + row * DM + h * 128, DM, SEQ / 64, 0.07216878364870322f, (LAS char*)lds, ra, qb * 256, 0, tid, (u64*)(ws + WS_CTL + YSS_OFF) + ((size_t)l * T + row) * 4 + 0);
    }
#endif
    for (;;) {
        asm volatile("" : "+s"(ap));
        unsigned char* ws = ap->ws;
        const bf16_t* PROJ = (const bf16_t*)(ws + WS_BIG); bf16_t* Y = (bf16_t*)(ws + WS_XN);
        if (threadIdx.x == 0) *slot = (int)__hip_atomic_fetch_add((unsigned*)(ws + WS_CTL) + 64 * (3 + l + 4 * rep), 1u, __ATOMIC_RELAXED, __HIP_MEMORY_SCOPE_AGENT);
        __syncthreads(); const int v = __builtin_amdgcn_readfirstlane(*slot); __syncthreads();
        if (v >= 768) break;
        int tid = threadIdx.x; asm volatile("" : "+v"(tid));
#if !defined(NO_ATT_C)
        if (v < 384) { const int b = v / 96, h = (v >> 4) % 6, qb = v & 15, kvh = h / 3; const size_t row = (size_t)b * SEQ + qb * 256;
            att::attn_unit<128, false, 1>(PROJ + row * INP + PC_Q + h * 128, INP, PROJ + (size_t)b * SEQ * INP + PC_K + kvh * 128, INP, PROJ + (size_t)b * SEQ * INP + PC_V + kvh * 128, INP,
                                          Y + row * DM + 1280 + h * 128, DM, SEQ / 64, 0.08838834764831845f, (LAS char*)lds, nullptr, 0, 0, tid, (u64*)(ws + WS_CTL + YSS_OFF) + ((size_t)l * T + row) * 4 + 2);
        } else
#endif
#if !defined(NO_ATT_B)
        { const int w = v - 384, b = w / 96, h = (w >> 4) % 6, qb = w & 15; const size_t row = (size_t)b * SEQ + qb * 256;
            const int q0 = qb * 256, lo = q0 - 1024 < 0 ? 0 : q0 - 1024, hi_ = q0 + 1280 > SEQ ? SEQ : q0 + 1280;
            att::attn_unit<128, true, 1>(PROJ + row * INP + PB_Q + h * 128, INP, PROJ + ((size_t)b * SEQ + lo) * INP + PB_K + h * 128, INP, PROJ + ((size_t)b * SEQ + lo) * INP + PB_V + h * 128, INP,
                                         Y + row * DM + 512 + h * 128, DM, (hi_ - lo) / 64, 0.08838834764831845f, (LAS char*)lds, nullptr, 0, lo - q0, tid, (u64*)(ws + WS_CTL + YSS_OFF) + ((size_t)l * T + row) * 4 + 1);
        }
#endif
        {}
    }
    { const int it0 = (l == 0) ? TR_P0 : TR_P1, it1 = (l == 0) ? TR_P1 : 2 * I_LAYER, nun = (it1 - it0) / 8;
      for (;;) {
        asm volatile("" : "+s"(ap));
        unsigned char* ws = ap->ws;
        if (threadIdx.x == 0) *slot = (int)__hip_atomic_fetch_add((unsigned*)(ws + WS_CTL) + 64 * (9 + l + 2 * rep), 1u, __ATOMIC_RELAXED, __HIP_MEMORY_SCOPE_AGENT);
        __syncthreads(); const int c = __builtin_amdgcn_readfirstlane(*slot); __syncthreads();
        if (c >= nun) break;
        int tid = threadIdx.x; asm volatile("" : "+v"(tid));
        const int lane = tid & 63, wave = __builtin_amdgcn_readfirstlane(tid >> 6);
        const Args a = *ap;
        const TrJob j = tr_job(a, ws, it0 + 8 * c + wave);
        f32x4 v[8]; tr_load(j, lane, v);
        LAS float* scr = (LAS float*)(lds + wave * 16384);
        tr_write(scr, lane, v); tr_store(j, scr, lane);
      } }
}

#endif
#if defined(__HIP_DEVICE_COMPILE__)
typedef const __attribute__((address_space(4))) Args* ArgsP;
template <int PH, int REP = 0>
__device__ __forceinline__ void run_phase(ArgsP ap, LAS unsigned char* lds) {
    asm volatile("" : "+s"(ap));
    const Args a = *ap;
    int tid = threadIdx.x, bid = blockIdx.x, G = gridDim.x; asm volatile("" : "+v"(tid)); asm volatile("" : "+s"(bid), "+s"(G));
    const int lane = tid & 63, wave = __builtin_amdgcn_readfirstlane(tid >> 6);
    const int gw = bid * NWAVES + wave, NGW = G * NWAVES;
    unsigned char* ws = a.ws;
    bf16_t* XN = (bf16_t*)(ws + WS_XN); bf16_t* BIG = (bf16_t*)(ws + WS_BIG); bf16_t* XB2 = (bf16_t*)(ws + WS_QA); u64* rss = (u64*)(ws + WS_CTL + RSS_OFF);
    if constexpr (PH == 0) ph_prologue(a, lds, gw, NGW, lane, wave);
    else if constexpr (PH == NPH - 1) ph_final(XN, a.out, a.in[15], gw, NGW, lane);
    else {
        constexpr int l = (PH - 1) / 6, sp = (PH - 1) % 6; unsigned char* wl = ws + WS_W + (size_t)l * W_LAYER;
        bf16_t* R1 = (bf16_t*)a.out;
        u64* css = (u64*)(ws + WS_CTL + CSS_OFF) + (size_t)l * T * 2;
        if constexpr (sp == 0) { pg8::Gemm g{(l == 0) ? XN : R1, (const bf16_t*)(wl + W_IN), DM, DM}; pg8::StaticOrder S; S.init(T, INP, G, bid);
            pg8::EpiBf E{BIG, nullptr, INP, 0, rss + (2 * l) * T, 1, 1.f / 2048.f, css}; pg8::gemm_phase(lds, g, S, E, tid); }
        else if constexpr (sp == 1) {
            { pg8::Gemm g{BIG + PA_CQ, (const bf16_t*)(wl + W_UQ), INP, 512}; pg8::StaticOrder S; S.init(T, 768, G, bid);
              pg8::EpiBf E{(bf16_t*)(ws + WS_QA), nullptr, 768, 0, css, 2, 1.f / 512.f, nullptr}; pg8::gemm_phase(lds, g, S, E, tid); }
            { pg8::Gemm g{BIG + PA_CKV, (const bf16_t*)(wl + W_UKV), INP, 512}; pg8::StaticOrder S; S.init(T, 1024, G, bid);
              pg8::EpiBf E{(bf16_t*)(ws + WS_KA), (bf16_t*)(ws + WS_VA), 0, 1, css + 1, 2, 1.f / 512.f, nullptr}; pg8::gemm_phase(lds, g, S, E, tid); }
            ph_prep(a, l, gw, NGW, lane);
        }
        else if constexpr (sp == 2) ph_attention(ap, l, lds, REP);
        else if constexpr (sp == 3) { pg8::Gemm g{XN, (const bf16_t*)(wl + W_OUT), DM, DM}; pg8::StaticOrder S; S.init(T, DM, G, bid);
            pg8::EpiRes E{(l == 0) ? a.in[0] : nullptr, (l == 0) ? nullptr : R1, nullptr, XB2, DM, rss + (2 * l + 1) * T, (const u64*)(ws + WS_CTL + YSS_OFF) + (size_t)l * T * 4}; pg8::gemm_phase(lds, g, S, E, tid); }
        else if constexpr (sp == 4) { pg8::Gemm g{XB2, (const bf16_t*)(wl + W_GU), DM, DM}; pg8::StaticOrder S; S.init(T, 2 * DFF, G, bid);
            pg8::EpiBf E{BIG, nullptr, DFF, 2, rss + (2 * l + 1) * T, 1, 1.f / 2048.f, nullptr}; pg8::gemm_phase(lds, g, S, E, tid); }
        else { pg8::Gemm g{BIG, (const bf16_t*)(wl + W_DN), DFF, DFF}; pg8::StaticOrder S; S.init(T, DM, G, bid);
            pg8::EpiRes E{nullptr, XB2, nullptr, (l == 0) ? R1 : XN, DM, (l == 0) ? rss + 2 * T : nullptr, nullptr}; pg8::gemm_phase(lds, g, S, E, tid); }
    }
}

#endif
__global__ void __launch_bounds__(NWAVES * 64, 2) mega_fwd(Args a_unused) {
#if defined(__HIP_DEVICE_COMPILE__)
    extern __shared__ __attribute__((aligned(16))) unsigned char lds_raw[];
    LAS unsigned char* lds = (LAS unsigned char*)lds_raw;
    ArgsP ap = (ArgsP)__builtin_amdgcn_kernarg_segment_ptr();
    const int ph_lo = ap->ph_lo, ph_hi = ap->ph_hi;
    XcdBarrier xbar; xbar.bar = (unsigned*)(ap->ws + WS_CTL) + 4096; xbar.x = 0; xbar.st = (volatile LAS unsigned*)(lds + LDS_SLOT + 16);
    if (ph_hi - ph_lo > 1) {
        if (threadIdx.x < 2) xbar.st[threadIdx.x] = 0u;
        __syncthreads();
        xbar = xcd_barrier_post(xbar.bar, xbar.st);
    }
#define GRID_BAR() do { xcd_barrier(xbar); } while (0)
#define RUN_AGAIN(PH) do { if (ph_lo <= (PH) && (PH) + 1 < ph_hi) { run_phase<PH, 1>(ap, lds); GRID_BAR(); } } while (0)
#define RUN_PHASE(PH) do { if (ph_lo <= (PH) && (PH) < ph_hi) { run_phase<PH>(ap, lds); if ((PH) + 1 < ph_hi) { if ((PH) == 0) { __syncthreads(); cg::this_grid().sync(); } else GRID_BAR(); } } } while (0)
#define PA(PH) do { if (PROBE_ATT) RUN_AGAIN(PH); } while (0)
#define PG(PH) do { if (PROBE_GEMM) RUN_AGAIN(PH); } while (0)
#define PE(PH) do { if (PROBE_ELEM) RUN_AGAIN(PH); } while (0)
    RUN_PHASE(0); PE(0); RUN_PHASE(1); RUN_PHASE(2); RUN_PHASE(3); PA(3); RUN_PHASE(4); RUN_PHASE(5); PG(5); RUN_PHASE(6);
    RUN_PHASE(7); RUN_PHASE(8); RUN_PHASE(9); PA(9); RUN_PHASE(10); RUN_PHASE(11); PG(11); RUN_PHASE(12); RUN_PHASE(13);
#undef RUN_PHASE
#endif
}

extern "C" void kernel_launch(void* const* d_in, const int* in_sizes, int n_in, void* d_out, int out_size, void* d_ws, size_t ws_size, hipStream_t stream) {
    static int grid = 0;
    if (grid == 0) {
        if (n_in != 16 || out_size != T * DM || ws_size < WS_END) { fprintf(stderr, "kernel_launch: unexpected shapes n_in %d out %d ws %zu (need %zu)\n", n_in, out_size, ws_size, (size_t)WS_END); grid = -1; return; }
        int dev = 0, cus = 0, per_cu = 0;
        hipGetDevice(&dev); hipDeviceGetAttribute(&cus, hipDeviceAttributeMultiprocessorCount, dev);
        if (hipFuncSetAttribute((const void*)mega_fwd, hipFuncAttributeMaxDynamicSharedMemorySize, LDS_BYTES) != hipSuccess) { fprintf(stderr, "kernel_launch: hipFuncSetAttribute failed\n"); grid = -1; return; }
        hipOccupancyMaxActiveBlocksPerMultiprocessor(&per_cu, (const void*)mega_fwd, NWAVES * 64, LDS_BYTES);
        (void)hipGetLastError();
        if (per_cu < 1) per_cu = 1;
        grid = cus * 1;
    }
    if (grid < 0) return;
    hipMemsetAsync((char*)d_ws + WS_CTL, 0, 32768, stream);
    Args a{};
    for (int i = 0; i < 16; ++i) a.in[i] = (const float*)d_in[i];
    a.out = (float*)d_out; a.ws = (unsigned char*)d_ws;
#if MK_SINGLE
    a.ph_lo = 0; a.ph_hi = NPH;
    void* args[] = {&a};
    hipError_t e = hipLaunchCooperativeKernel((const void*)mega_fwd, dim3(grid), dim3(NWAVES * 64), args, LDS_BYTES, stream);
    if (e != hipSuccess) fprintf(stderr, "cooperative launch failed: %s (grid %d)\n", hipGetErrorString(e), grid);
#else
    for (int ph = 0; ph < NPH; ++ph) { a.ph_lo = ph; a.ph_hi = ph + 1;
        hipLaunchKernelGGL(mega_fwd, dim3(grid), dim3(NWAVES * 64), LDS_BYTES, stream, a); }
#endif
}
```

```cpp
#include <hip/hip_runtime.h>
#include <hip/hip_cooperative_groups.h>
#include <cstdio>
#include <cstdint>
namespace cg = cooperative_groups;

#ifndef PROBE_ATT
#define PROBE_ATT 0
#endif
#ifndef PROBE_GEMM
#define PROBE_GEMM 0
#endif
#ifndef PROBE_ELEM
#define PROBE_ELEM 0
#endif
#ifndef MK_SINGLE
#define MK_SINGLE 1
#endif

#define LAS __attribute__((address_space(3)))
typedef unsigned short bf16_t;
typedef short bf16x8 __attribute__((ext_vector_type(8)));
typedef short s16x4 __attribute__((ext_vector_type(4)));
typedef float f32x4 __attribute__((ext_vector_type(4)));
typedef float f32x2 __attribute__((ext_vector_type(2)));
typedef float f32x16 __attribute__((ext_vector_type(16)));
typedef unsigned u32x4 __attribute__((ext_vector_type(4)));
typedef unsigned u32x2 __attribute__((ext_vector_type(2)));
typedef unsigned long long u64;
constexpr float FXS = 1048576.f, FXI = 1.f / 1048576.f;
__device__ __forceinline__ void fx_add(u64* p, float v) { atomicAdd(p, (u64)(v * FXS + 0.5f)); }
__device__ __forceinline__ float fx_get(const u64* p) { return (float)(*p) * FXI; }

constexpr int NB = 4, SEQ = 4096, T = NB * SEQ, DM = 2048, INW = 4672, INP = 4864, DFF = 5632;
constexpr int NWAVES = 8;
constexpr int NPH = 14;
constexpr float EPS = 1e-6f;
constexpr int PA_CQ = 0, PA_CKV = 512, PA_KR = 1024, PB_Q = 1088, PB_K = 1856, PB_V = 2624, PC_Q = 3392, PC_K = 4160, PC_V = 4416;

constexpr size_t WS_CTL = 0, CTL_BYTES = 4u << 20;
constexpr size_t RSS_OFF = 512 * 1024;
constexpr size_t YSS_OFF = 1024 * 1024;
constexpr size_t CSS_OFF = 2048 * 1024;
constexpr size_t WS_ROPEA = WS_CTL + CTL_BYTES;
constexpr size_t WS_ROPE1 = WS_ROPEA + (size_t)4096 * 32 * 8;
constexpr size_t WS_W = WS_ROPE1 + (size_t)4096 * 64 * 8;
constexpr size_t W_IN = 0, W_UQ = W_IN + (size_t)INP * DM * 2, W_UKV = W_UQ + (size_t)768 * 512 * 2, W_OUT = W_UKV + (size_t)1024 * 512 * 2,
                 W_GU = W_OUT + (size_t)DM * DM * 2, W_DN = W_GU + (size_t)2 * DFF * DM * 2, W_LAYER = W_DN + (size_t)DM * DFF * 2;
constexpr size_t WS_XN = WS_W + 2 * W_LAYER;
constexpr size_t WS_BIG = WS_XN + (size_t)T * DM * 2;
constexpr size_t BIG_BYTES = (size_t)T * DFF * 2;
constexpr size_t WS_QA = WS_BIG + BIG_BYTES;
constexpr size_t WS_KA = WS_QA + (size_t)T * 768 * 2;
constexpr size_t WS_VA = WS_KA + (size_t)T * 768 * 2;
constexpr size_t WS_END = WS_VA + (size_t)T * 512 * 2;
static_assert((size_t)T * INP * 2 <= BIG_BYTES, "PROJ fits under FF");
static_assert(WS_END <= (size_t)536870912, "workspace map fits 512 MiB");

constexpr int LDS_SLOT = 139264;
constexpr int LDS_BYTES = LDS_SLOT + 256;

__device__ __forceinline__ unsigned cvt_pk_bf16(float lo, float hi) { unsigned r; asm volatile("v_cvt_pk_bf16_f32 %0, %1, %2" : "=v"(r) : "v"(lo), "v"(hi)); return r; }
__device__ __forceinline__ float bf2f(unsigned short b) { return __uint_as_float(((unsigned)b) << 16); }
__device__ __forceinline__ float bflo(unsigned w) { return __uint_as_float(w << 16); }
__device__ __forceinline__ float bfhi(unsigned w) { return __uint_as_float(w & 0xffff0000u); }
__device__ __forceinline__ unsigned short f2bf(float f) { return (unsigned short)(cvt_pk_bf16(f, f) & 0xffffu); }
__device__ __forceinline__ float wave_sum(float v, const int lane) {
#pragma unroll
    for (int o = 1; o < 64; o <<= 1) v += __builtin_bit_cast(float, __builtin_amdgcn_ds_bpermute((lane ^ o) << 2, __builtin_bit_cast(int, v)));
    return v;
}


#define XB_TMO      128
#define XB_XCNT(j)  (256  + 64 * (j))
#define XB_XSUB(j)  (1280 + 64 * (j))
#define XB_XGEN(j)  (2304 + 64 * (j))
#define XB_TOP      3328
#define XB_TOPGEN   3392
#define XCD_BAR_WORDS 3456
#define XB_SPIN_CAP (1u << 18)
__device__ __forceinline__ unsigned xb_ld(unsigned* p)              { return __hip_atomic_load(p, __ATOMIC_RELAXED, __HIP_MEMORY_SCOPE_AGENT); }
__device__ __forceinline__ unsigned xb_add(unsigned* p, unsigned v) { return __hip_atomic_fetch_add(p, v, __ATOMIC_RELAXED, __HIP_MEMORY_SCOPE_AGENT); }
__device__ __forceinline__ unsigned xb_xcc_id() { return (unsigned)__builtin_amdgcn_s_getreg((3 << 11) | 20) & 0xFu; }
#define XB_SPIN(cond, bar) do { unsigned _sp = 0; while (cond) { __builtin_amdgcn_s_sleep(1); \
    if ((++_sp & 255u) == 0u) { if (xb_ld(&(bar)[XB_TMO])) break; if (_sp > XB_SPIN_CAP) { atomicAdd(&(bar)[XB_TMO], 1u); break; } } } } while (0)
struct XcdBarrier { unsigned* bar; unsigned x; volatile LAS unsigned* st; };
__device__ __forceinline__ XcdBarrier xcd_barrier_post(unsigned* bar, volatile LAS unsigned* st) {
    XcdBarrier b; b.bar = bar; b.x = xb_xcc_id(); b.st = st;
    if (threadIdx.x == 0) (void)xb_add(&bar[XB_XCNT(b.x)], 1u);
    return b;
}
__device__ __forceinline__ void xcd_barrier_complete(unsigned* bar, unsigned x, unsigned& nloc, unsigned& nx) {
    const unsigned G = gridDim.x * gridDim.y * gridDim.z;
    unsigned sum, cnt, mine, sp = 0u;
    for (;;) {
        sum = 0u; cnt = 0u; mine = 0u;
#pragma unroll
        for (unsigned j = 0; j < 16; ++j) { const unsigned c = xb_ld(&bar[XB_XCNT(j)]); sum += c; cnt += (c > 0u) ? 1u : 0u; mine = (j == x) ? c : mine; }
        if (sum == G) break;
        __builtin_amdgcn_s_sleep(1);
        if ((++sp & 255u) == 0u) { if (xb_ld(&bar[XB_TMO])) break; if (sp > XB_SPIN_CAP) { atomicAdd(&bar[XB_TMO], 1u); break; } }
    }
    nloc = mine > 0u ? mine : 1u; nx = cnt > 0u ? cnt : 1u;
}
__device__ __forceinline__ void xcd_barrier(const XcdBarrier& b) {
    asm volatile("s_waitcnt vmcnt(0)" ::: "memory");
    __syncthreads();
    if (threadIdx.x == 0) {
        unsigned* bar = b.bar;
        __builtin_amdgcn_s_waitcnt(0);
        unsigned nloc = b.st[0], nx = b.st[1];
        if (nloc == 0u) { xcd_barrier_complete(bar, b.x, nloc, nx); b.st[0] = nloc; b.st[1] = nx; }
        const unsigned old = xb_add(&bar[XB_XSUB(b.x)], 1u);
        const unsigned gen = old / nloc;
        if (old + 1u == (gen + 1u) * nloc) {
            __builtin_amdgcn_fence(__ATOMIC_RELEASE, "agent");
            asm volatile("s_waitcnt vmcnt(0)" ::: "memory");
            const unsigned og = xb_add(&bar[XB_TOP], 1u);
            const unsigned tg = og / nx;
            if (og + 1u == (tg + 1u) * nx) xb_add(&bar[XB_TOPGEN], 1u);
            else XB_SPIN(xb_ld(&bar[XB_TOPGEN]) == tg, bar);
            __builtin_amdgcn_fence(__ATOMIC_ACQUIRE, "agent");
            xb_add(&bar[XB_XGEN(b.x)], 1u);
            asm volatile("s_waitcnt vmcnt(0)" ::: "memory");
        } else {
            XB_SPIN(xb_ld(&bar[XB_XGEN(b.x)]) == gen, bar);
            __builtin_amdgcn_fence(__ATOMIC_ACQUIRE, "agent");
            asm volatile("s_waitcnt vmcnt(0)" ::: "memory");
        }
    }
    __syncthreads();
}

namespace pg8 {
constexpr int BM = 256, BK = 64, HALF = 128, HTB = HALF * BK * 2, STAGE_BYTES = 8 * HTB, NXCD = 8, WGM = 8;
__host__ __device__ __forceinline__ int lds_byte(int r, int c) { const int st = (r >> 4) * 2 + (c >> 5), rr = r & 15, cc = c & 31, ob = rr * 64 + cc * 2; return st * 1024 + (ob ^ (((ob >> 9) & 1) << 5)); }
__host__ __device__ __forceinline__ void stage_rc(int b, int& R, int& C) { const int st = b / 1024, sb = b % 1024, swz = sb ^ (((sb >> 9) & 1) << 5); R = (st >> 1) * 16 + swz / 64; C = (st & 1) * 32 + (swz % 64) / 2; }
__host__ __device__ __forceinline__ int perm32(int rho) { const int n = rho >> 4, i = rho & 15; return 8 * (i >> 2) + 4 * n + (i & 3); }

struct Unit { int pm, pn; };
struct Gemm { const bf16_t* A; const bf16_t* Bt; int lda, K; };

struct StaticOrder {
    int nM, nN, nwg, G, c;
    __device__ void init(int M, int N, int G_, int c_) { nM = M / BM; nN = N / BM; nwg = nM * nN; G = G_; c = c_; }
    __device__ bool next(int i, Unit& u) const {
        const long L = (long)i * G + c; if (L >= nwg) return false;
        int wgid = (int)L; { const int q = nwg / NXCD, r = nwg % NXCD, xcd = wgid % NXCD, off = wgid / NXCD; wgid = (xcd < r ? xcd * (q + 1) : r * (q + 1) + (xcd - r) * q) + off; }
        const int nig = WGM * nN, gid = wgid / nig, fm = gid * WGM, gsz = (nM - fm) < WGM ? (nM - fm) : WGM;
        u.pm = fm + ((wgid % nig) % gsz); u.pn = (wgid % nig) / gsz; return true;
    }
};

struct EpiRes {
    static constexpr bool KSCALE = true;
    static constexpr bool PERM = true;
    const float* base32; const bf16_t* base16; float* out32; bf16_t* out16; int ldc; u64* rss; const u64* yss;
    __device__ __forceinline__ void kscale(f32x4 (&acc)[2][2][4][2], const Unit& u, int t, int tid_) const {
        asm volatile("" : "+v"(tid_)); const int row0 = u.pm * BM + (__builtin_amdgcn_readfirstlane(tid_ >> 6) >> 2) * 64 + (tid_ & 15);
#pragma unroll
        for (int ai = 0; ai < 2; ++ai)
#pragma unroll
            for (int m = 0; m < 4; ++m) { const u64* yq = yss + (size_t)(row0 + ai * HALF + m * 16) * 4 + (t == 8 ? 0 : 1);
                const float wp = (t == 8) ? (1.f / 512.f) : (1.f / 768.f);
                const float vp = fx_get(yq) * wp + 1e-6f, vn = fx_get(yq + 1) * (1.f / 768.f) + 1e-6f;
                const float sc = __builtin_amdgcn_sqrtf(vn * __builtin_amdgcn_rcpf(vp));
#pragma unroll
                for (int bj = 0; bj < 2; ++bj)
#pragma unroll
                    for (int n = 0; n < 2; ++n) acc[ai][bj][m][n] *= sc;
                asm volatile("" ::: "memory"); }
    }
    __device__ __forceinline__ void operator()(const f32x4 (&acc)[2][2][4][2], const Unit& u, int tid_) const {
        asm volatile("" : "+v"(tid_)); const int lane = tid_ & 63, wid_ = __builtin_amdgcn_readfirstlane(tid_ >> 6), wr = wid_ >> 2, wc = wid_ & 3, fr = lane & 15, fq = lane >> 4;
        const int row0 = u.pm * BM + wr * 64 + fr, col0 = u.pn * BM + wc * 32 + 8 * fq;
#pragma unroll
        for (int ai = 0; ai < 2; ++ai)
#pragma unroll
            for (int m = 0; m < 4; ++m) { const size_t off = (size_t)(row0 + ai * HALF + m * 16) * ldc + col0; float ss = 0.f;
                const float rc = yss ? 1.0f / sqrtf(fx_get(yss + (size_t)(row0 + ai * HALF + m * 16) * 4 + 2) * (1.f / 768.f) + 1e-6f) : 1.0f;
#pragma unroll
                for (int bj = 0; bj < 2; ++bj) { f32x4 b0, b1;
                    if (base16) { const u32x4 w = *(const u32x4*)(base16 + off + bj * HALF); b0 = (f32x4){bflo(w.x), bfhi(w.x), bflo(w.y), bfhi(w.y)}; b1 = (f32x4){bflo(w.z), bfhi(w.z), bflo(w.w), bfhi(w.w)}; }
                    else { b0 = *(const f32x4*)(base32 + off + bj * HALF); b1 = *(const f32x4*)(base32 + off + bj * HALF + 4); }
                    const f32x4 v0 = b0 + acc[ai][bj][m][0] * rc, v1 = b1 + acc[ai][bj][m][1] * rc;
                    if (out16) { u32x4 w; w.x = cvt_pk_bf16(v0[0], v0[1]); w.y = cvt_pk_bf16(v0[2], v0[3]); w.z = cvt_pk_bf16(v1[0], v1[1]); w.w = cvt_pk_bf16(v1[2], v1[3]); *(u32x4*)(out16 + off + bj * HALF) = w; }
                    if (out32) { *(f32x4*)(out32 + off + bj * HALF) = v0; *(f32x4*)(out32 + off + bj * HALF + 4) = v1; }
                    ss += (v0[0] * v0[0] + v0[1] * v0[1]) + (v0[2] * v0[2] + v0[3] * v0[3]) + (v1[0] * v1[0] + v1[1] * v1[1]) + (v1[2] * v1[2] + v1[3] * v1[3]); }
                if (rss) {
                    ss += __builtin_bit_cast(float, __builtin_amdgcn_ds_bpermute((lane ^ 16) << 2, __builtin_bit_cast(int, ss)));
                    ss += __builtin_bit_cast(float, __builtin_amdgcn_ds_bpermute((lane ^ 32) << 2, __builtin_bit_cast(int, ss)));
                    if (fq == 0) fx_add(rss + row0 + ai * HALF + m * 16, ss); } }
    }
};
struct EpiBf {
    static constexpr bool KSCALE = false;
    static constexpr bool PERM = true;
    bf16_t* O; bf16_t* O2; int ldc; int mode; const u64* rss; int rstride; float invw; u64* css;
    __device__ __forceinline__ void operator()(const f32x4 (&acc)[2][2][4][2], const Unit& u, int tid_) const {
        asm volatile("" : "+v"(tid_)); const int lane = tid_ & 63, wid_ = __builtin_amdgcn_readfirstlane(tid_ >> 6), wr = wid_ >> 2, wc = wid_ & 3, fr = lane & 15, fq = lane >> 4;
        const int row0 = u.pm * BM + wr * 64 + fr, cw = wc * 32 + 8 * fq;
        if (mode == 2) {
#pragma unroll
            for (int ai = 0; ai < 2; ++ai)
#pragma unroll
                for (int m = 0; m < 4; ++m) { const int r = row0 + ai * HALF + m * 16; bf16_t* rowp = O + (size_t)r * ldc + u.pn * HALF + cw;
                    const float rs = 1.0f / sqrtf(fx_get(rss + (size_t)r * rstride) * invw + 1e-6f);
                    float v[8];
#pragma unroll
                    for (int n = 0; n < 2; ++n)
#pragma unroll
                        for (int j = 0; j < 4; ++j) { const float g = acc[ai][0][m][n][j] * rs, up = acc[ai][1][m][n][j] * rs;
                            const float e = __builtin_amdgcn_exp2f(-g * 1.4426950408889634f); v[n * 4 + j] = g * __builtin_amdgcn_rcpf(1.0f + e) * up; }
                    u32x4 w; w.x = cvt_pk_bf16(v[0], v[1]); w.y = cvt_pk_bf16(v[2], v[3]); w.z = cvt_pk_bf16(v[4], v[5]); w.w = cvt_pk_bf16(v[6], v[7]);
                    *(u32x4*)rowp = w; }
        } else {
#pragma unroll
            for (int ai = 0; ai < 2; ++ai)
#pragma unroll
                for (int m = 0; m < 4; ++m) { const size_t r = (size_t)(row0 + ai * HALF + m * 16);
                    const float rs = rss ? 1.0f / sqrtf(fx_get(rss + r * rstride) * invw + 1e-6f) : 1.0f; float ss = 0.f;
#pragma unroll
                    for (int bj = 0; bj < 2; ++bj) { const f32x4 v0 = acc[ai][bj][m][0] * rs, v1 = acc[ai][bj][m][1] * rs;
                        ss += (v0[0] * v0[0] + v0[1] * v0[1]) + (v0[2] * v0[2] + v0[3] * v0[3]) + (v1[0] * v1[0] + v1[1] * v1[1]) + (v1[2] * v1[2] + v1[3] * v1[3]);
                        u32x4 w; w.x = cvt_pk_bf16(v0[0], v0[1]); w.y = cvt_pk_bf16(v0[2], v0[3]); w.z = cvt_pk_bf16(v1[0], v1[1]); w.w = cvt_pk_bf16(v1[2], v1[3]);
                        bf16_t* p;
                        if (mode == 0) p = O + r * ldc + u.pn * BM + bj * HALF + cw;
                        else p = (bj == 0) ? (O + r * 768 + u.pn * 192 + cw) : (O2 + r * 512 + u.pn * 128 + cw);
                        *(u32x4*)p = w; }
                    if (css != nullptr && u.pn < 4) {
                        ss += __builtin_bit_cast(float, __builtin_amdgcn_ds_bpermute((lane ^ 16) << 2, __builtin_bit_cast(int, ss)));
                        ss += __builtin_bit_cast(float, __builtin_amdgcn_ds_bpermute((lane ^ 32) << 2, __builtin_bit_cast(int, ss)));
                        if (fq == 0) fx_add(css + r * 2 + (u.pn >> 1), ss); } }
        }
    }
};

template <class Epi, class Sched, bool ALIGN_EPI = true, bool SP2 = true>
__device__ __forceinline__ void gemm_phase(LAS unsigned char* lds, const Gemm g, const Sched& S, const Epi& E, const int tid) {
    const int wid = __builtin_amdgcn_readfirstlane(tid >> 6), lane = tid & 63, wr = wid >> 2, wc = wid & 3, fr = lane & 15, fq = lane >> 4;
    const int K = g.K, nt = K / BK, lda = g.lda;
    unsigned voffA[2], voffB[2];
#pragma unroll
    for (int i = 0; i < 2; ++i) { int R, C; stage_rc(tid * 16 + i * 8192, R, C); const int Rb = Epi::PERM ? ((R & ~31) + perm32(R & 31)) : R;
        voffA[i] = (unsigned)(R * lda + C) * 2u; voffB[i] = (unsigned)(Rb * K + C) * 2u; }
    const size_t kstep = (size_t)(BK * 2);
    const size_t hstepA = (size_t)HALF * lda * 2, hstepB = (size_t)HALF * K * 2;
    const size_t tstepA = 2 * hstepA, tstepB = 2 * hstepB;
    const unsigned ldsw = (unsigned)wid * 1024u;
    const int aoff = lds_byte(wr * 64 + fr, fq * 8), boff = lds_byte(wc * 32 + fr, fq * 8);
#define PG8_SA(b, h) (((b) * 2 + (h)) * HTB)
#define PG8_SB(b, h) ((4 + (b) * 2 + (h)) * HTB)
#define PG8_STAGE(bufoff, gbase, voff) do { _Pragma("unroll") for (int _i = 0; _i < 2; ++_i) \
        __builtin_amdgcn_global_load_lds((const unsigned*)((const char*)(gbase) + (voff)[_i]), (LAS unsigned*)(lds + (bufoff) + ldsw + _i * 8192), 16, 0, 0); } while (0)
#define PG8_LDA(dst, b, h) do { _Pragma("unroll") for (int m = 0; m < 4; ++m) _Pragma("unroll") for (int k = 0; k < 2; ++k) dst[m][k] = *(const LAS bf16x8*)(lds + PG8_SA(b, h) + aoff + m * 2048 + k * 1024); } while (0)
#define PG8_LDB(dst, b, h) do { _Pragma("unroll") for (int n = 0; n < 2; ++n) _Pragma("unroll") for (int k = 0; k < 2; ++k) dst[n][k] = *(const LAS bf16x8*)(lds + PG8_SB(b, h) + boff + n * 2048 + k * 1024); } while (0)
#define PG8_MMA(ai, bj, At, Bt) do { __builtin_amdgcn_s_setprio(1); _Pragma("unroll") for (int m = 0; m < 4; ++m) _Pragma("unroll") for (int n = 0; n < 2; ++n) _Pragma("unroll") for (int k = 0; k < 2; ++k) \
        acc[ai][bj][m][n] = __builtin_amdgcn_mfma_f32_16x16x32_bf16(Bt[n][k], At[m][k], acc[ai][bj][m][n], 0, 0, 0); __builtin_amdgcn_s_setprio(0); } while (0)
#define PG8_WAIT_V(n) asm volatile("s_waitcnt vmcnt(" #n ")" ::: "memory")
#define PG8_WAIT_L(n) asm volatile("s_waitcnt lgkmcnt(" #n ")" ::: "memory")
#define PG8_BAR __builtin_amdgcn_s_barrier()
#define PG8_SCHED __builtin_amdgcn_sched_barrier(0)
    Unit cur, nxt; int ui = 0;
    if (!S.next(0, cur)) return;
    f32x4 acc[2][2][4][2];
#pragma unroll
    for (int a = 0; a < 2; ++a)
#pragma unroll
        for (int b = 0; b < 2; ++b)
#pragma unroll
            for (int m = 0; m < 4; ++m)
#pragma unroll
                for (int n = 0; n < 2; ++n) acc[a][b][m][n] = (f32x4){0.f, 0.f, 0.f, 0.f};
    bf16x8 At[4][2], B0[2][2], B1[2][2];
    const char* cA = (const char*)g.A + (size_t)cur.pm * tstepA; const char* cB = (const char*)g.Bt + (size_t)cur.pn * tstepB;
    if constexpr (SP2) {
        PG8_STAGE(PG8_SB(0, 0), cB, voffB); PG8_STAGE(PG8_SB(0, 1), cB + hstepB, voffB); PG8_STAGE(PG8_SA(0, 0), cA, voffA); PG8_STAGE(PG8_SA(0, 1), cA + hstepA, voffA);
        if (wr == 1) PG8_BAR;
        PG8_WAIT_V(2); PG8_BAR;
        PG8_STAGE(PG8_SB(1, 0), cB + kstep, voffB); PG8_STAGE(PG8_SA(1, 0), cA + kstep, voffA); PG8_STAGE(PG8_SB(1, 1), cB + hstepB + kstep, voffB);
        PG8_WAIT_V(6); PG8_BAR;
    } else {
        PG8_STAGE(PG8_SB(0, 0), cB, voffB); PG8_STAGE(PG8_SA(0, 0), cA, voffA); PG8_STAGE(PG8_SB(0, 1), cB + hstepB, voffB); PG8_STAGE(PG8_SA(0, 1), cA + hstepA, voffA);
        if (wr == 1) PG8_BAR;
        PG8_WAIT_V(4); PG8_BAR;
        PG8_STAGE(PG8_SB(1, 0), cB + kstep, voffB); PG8_STAGE(PG8_SA(1, 0), cA + kstep, voffA); PG8_STAGE(PG8_SB(1, 1), cB + hstepB + kstep, voffB);
        PG8_WAIT_V(6); PG8_BAR;
    }
    for (;;) {
        const bool has_next = S.next(ui + 1, nxt);
        const char* nA = has_next ? (const char*)g.A + (size_t)nxt.pm * tstepA : cA; const char* nB = has_next ? (const char*)g.Bt + (size_t)nxt.pn * tstepB : cB;
        for (int t = 0; t < nt; t += 2) {
            const bool last = (t == nt - 2);
            const char* a1 = cA + (size_t)(t + 1) * kstep;
            const char* a2 = last ? nA : cA + (size_t)(t + 2) * kstep; const char* b2 = last ? nB : cB + (size_t)(t + 2) * kstep;
            const char* a3 = a2 + kstep; const char* b3 = b2 + kstep;
            if constexpr (Epi::KSCALE) { if (E.yss != nullptr && (t == 8 || t == 20)) E.kscale(acc, cur, t, tid); }
            if constexpr (SP2) {
            PG8_LDB(B0, 0, 0); PG8_LDB(B1, 0, 1); PG8_SCHED; PG8_LDA(At, 0, 0); PG8_STAGE(PG8_SA(1, 1), a1 + hstepA, voffA);
            PG8_WAIT_V(8); PG8_WAIT_L(0); PG8_BAR; PG8_MMA(0, 0, At, B0); PG8_MMA(0, 1, At, B1); PG8_BAR; PG8_SCHED;
            PG8_LDA(At, 0, 1); PG8_STAGE(PG8_SB(0, 0), b2, voffB); PG8_STAGE(PG8_SB(0, 1), b2 + hstepB, voffB); PG8_STAGE(PG8_SA(0, 0), a2, voffA);
            PG8_WAIT_V(8); PG8_WAIT_L(0); PG8_BAR; PG8_MMA(1, 0, At, B0); PG8_MMA(1, 1, At, B1); PG8_BAR; PG8_SCHED;
            PG8_LDB(B0, 1, 0); PG8_LDB(B1, 1, 1); PG8_SCHED; PG8_LDA(At, 1, 0); PG8_STAGE(PG8_SA(0, 1), a2 + hstepA, voffA);
            PG8_WAIT_V(8); PG8_WAIT_L(0); PG8_BAR; PG8_MMA(0, 0, At, B0); PG8_MMA(0, 1, At, B1); PG8_BAR; PG8_SCHED;
            PG8_LDA(At, 1, 1); PG8_STAGE(PG8_SB(1, 0), b3, voffB); PG8_STAGE(PG8_SB(1, 1), b3 + hstepB, voffB); PG8_STAGE(PG8_SA(1, 0), a3, voffA);
            PG8_WAIT_V(8); PG8_WAIT_L(0); PG8_BAR; PG8_MMA(1, 0, At, B0); PG8_MMA(1, 1, At, B1); PG8_BAR; PG8_SCHED;
            } else {
            PG8_LDB(B0, 0, 0); PG8_SCHED; PG8_LDA(At, 0, 0); PG8_STAGE(PG8_SA(1, 1), a1 + hstepA, voffA);
            PG8_WAIT_L(8); PG8_BAR; PG8_WAIT_L(0); PG8_MMA(0, 0, At, B0); PG8_BAR; PG8_SCHED;
            PG8_LDB(B1, 0, 1); PG8_STAGE(PG8_SB(0, 0), b2, voffB);
            PG8_BAR; PG8_WAIT_L(0); PG8_MMA(0, 1, At, B1); PG8_BAR;
            PG8_LDA(At, 0, 1); PG8_STAGE(PG8_SA(0, 0), a2, voffA);
            PG8_BAR; PG8_WAIT_L(0); PG8_MMA(1, 0, At, B0); PG8_BAR; PG8_SCHED;
            PG8_STAGE(PG8_SB(0, 1), b2 + hstepB, voffB);
            PG8_WAIT_V(6); PG8_BAR; PG8_MMA(1, 1, At, B1); PG8_BAR;
            PG8_LDB(B0, 1, 0); PG8_SCHED; PG8_LDA(At, 1, 0); PG8_STAGE(PG8_SA(0, 1), a2 + hstepA, voffA);
            PG8_WAIT_L(8); PG8_BAR; PG8_WAIT_L(0); PG8_MMA(0, 0, At, B0); PG8_BAR; PG8_SCHED;
            PG8_LDB(B1, 1, 1); PG8_STAGE(PG8_SB(1, 0), b3, voffB);
            PG8_BAR; PG8_WAIT_L(0); PG8_MMA(0, 1, At, B1); PG8_BAR;
            PG8_LDA(At, 1, 1); PG8_STAGE(PG8_SA(1, 0), a3, voffA);
            PG8_BAR; PG8_WAIT_L(0); PG8_MMA(1, 0, At, B0); PG8_BAR; PG8_SCHED;
            PG8_STAGE(PG8_SB(1, 1), b3 + hstepB, voffB);
            PG8_WAIT_V(6); PG8_BAR; PG8_MMA(1, 1, At, B1); PG8_BAR;
            }
        }
        if constexpr (ALIGN_EPI) { if (wr == 0) PG8_BAR; }
        E(acc, cur, tid);
        if (!has_next) break;
#pragma unroll
        for (int a = 0; a < 2; ++a)
#pragma unroll
            for (int b = 0; b < 2; ++b)
#pragma unroll
                for (int m = 0; m < 4; ++m)
#pragma unroll
                    for (int n = 0; n < 2; ++n) acc[a][b][m][n] = (f32x4){0.f, 0.f, 0.f, 0.f};
        cur = nxt; cA = nA; cB = nB; ++ui;
        if constexpr (ALIGN_EPI) { if (wr == 1) PG8_BAR; }
    }
    PG8_WAIT_V(0);
    if constexpr (!ALIGN_EPI) { if (wr == 0) PG8_BAR; }
    PG8_BAR;
#undef PG8_SA
#undef PG8_SB
#undef PG8_STAGE
#undef PG8_LDA
#undef PG8_LDB
#undef PG8_MMA
#undef PG8_WAIT_V
#undef PG8_WAIT_L
#undef PG8_BAR
#undef PG8_SCHED
}
}

namespace att {
constexpr int KVBLK = 64, QBLK = 32;
constexpr float THR = 8.f;
#define SBAR() __builtin_amdgcn_sched_barrier(0)
__device__ __forceinline__ int crow(int r, int hi) { return (r & 3) + 8 * (r >> 2) + 4 * hi; }
__device__ __forceinline__ float dbias(int d) {
    const int ad = d < 0 ? -d : d;
    const int c = (ad <= 64 ? 1 : 0) + ((((d & 3) == 0) && ad <= 256) ? 1 : 0) + ((((d & 15) == 0) && ad <= 1024) ? 1 : 0);
    return c == 0 ? -__builtin_inff() : (c == 1 ? 0.f : (c == 2 ? 1.f : 1.5849625007211562f));
}
template <bool MASK>
__device__ __forceinline__ void partialSM(f32x16& p0, f32x16& p1, float& m_reg, float& mn, float& alpha, const float C, const float thr, const int dbase, const int dwave) {
    if constexpr (MASK) {
        if ((dwave - 31 > 256 && dwave + 63 <= 1024) || (dwave + 63 < -256 && dwave - 31 >= -1024)) {
            const int tl = dbase & 15; const float ninf = -__builtin_inff();
#pragma unroll
            for (int r = 0; r < 8; ++r) { const bool hit = tl == ((16 - ((r & 3) + 8 * (r >> 2))) & 15);
                p0[r] = hit ? p0[r] * C : ninf; p0[r + 8] = hit ? p0[r + 8] * C : ninf; p1[r] = hit ? p1[r] * C : ninf; p1[r + 8] = hit ? p1[r + 8] * C : ninf; }
        } else {
#pragma unroll
            for (int r = 0; r < 16; ++r) { const int d = dbase + (r & 3) + 8 * (r >> 2); p0[r] = fmaf(p0[r], C, dbias(d)); p1[r] = fmaf(p1[r], C, dbias(d + 32)); }
        }
        float pmax = p0[0];
#pragma unroll
        for (int r = 1; r < 16; ++r) pmax = fmaxf(pmax, p0[r]);
#pragma unroll
        for (int r = 0; r < 16; ++r) pmax = fmaxf(pmax, p1[r]);
        { auto rr = __builtin_amdgcn_permlane32_swap(__float_as_uint(pmax), __float_as_uint(pmax), false, false);
          pmax = fmaxf(__uint_as_float(rr[0]), __uint_as_float(rr[1])); }
        if (__builtin_expect(__all(pmax - m_reg <= thr), 1)) { mn = m_reg; alpha = 1.f; }
        else { mn = fmaxf(m_reg, pmax); alpha = __builtin_amdgcn_exp2f(m_reg - mn); m_reg = mn; }
#pragma unroll
        for (int r = 0; r < 16; ++r) { p0[r] = p0[r] - mn; p1[r] = p1[r] - mn; }
#pragma unroll
        for (int r = 0; r < 16; ++r) p0[r] = __builtin_amdgcn_exp2f(p0[r]);
    } else {
        float pmax = p0[0];
#pragma unroll
        for (int r = 1; r < 16; ++r) pmax = fmaxf(pmax, p0[r]);
#pragma unroll
        for (int r = 0; r < 16; ++r) pmax = fmaxf(pmax, p1[r]);
        { auto rr = __builtin_amdgcn_permlane32_swap(__float_as_uint(pmax), __float_as_uint(pmax), false, false);
          pmax = fmaxf(__uint_as_float(rr[0]), __uint_as_float(rr[1])); }
        if (__builtin_expect(__all(pmax - m_reg <= thr), 1)) { mn = m_reg; alpha = 1.f; }
        else { mn = fmaxf(m_reg, pmax); alpha = __builtin_amdgcn_exp2f((m_reg - mn) * C); m_reg = mn; }
        const float mnC = -mn * C;
#pragma unroll
        for (int r = 0; r < 16; ++r) p0[r] = fmaf(p0[r], C, mnC);
#pragma unroll
        for (int r = 0; r < 16; ++r) p1[r] = fmaf(p1[r], C, mnC);
#pragma unroll
        for (int r = 0; r < 16; ++r) p0[r] = __builtin_amdgcn_exp2f(p0[r]);
    }
}
__device__ __forceinline__ void finishSM(f32x16& p0, f32x16& p1, float alpha, float& l_reg, bf16x8& pa0, bf16x8& pa1, bf16x8& pa2, bf16x8& pa3) {
#pragma unroll
    for (int r = 0; r < 16; ++r) p1[r] = __builtin_amdgcn_exp2f(p1[r]);
    float ps = 0;
#pragma unroll
    for (int r = 0; r < 16; ++r) ps += p0[r];
#pragma unroll
    for (int r = 0; r < 16; ++r) ps += p1[r];
    { auto rr = __builtin_amdgcn_permlane32_swap(__float_as_uint(ps), __float_as_uint(ps), false, false);
      ps = __uint_as_float(rr[0]) + __uint_as_float(rr[1]); }
    l_reg = l_reg * alpha + ps;
#define PK4(P, BASE, OUT) do { unsigned a0 = cvt_pk_bf16(P[BASE + 0], P[BASE + 1]), a1 = cvt_pk_bf16(P[BASE + 2], P[BASE + 3]);   \
    unsigned b0 = cvt_pk_bf16(P[BASE + 4], P[BASE + 5]), b1 = cvt_pk_bf16(P[BASE + 6], P[BASE + 7]);                              \
    auto r0 = __builtin_amdgcn_permlane32_swap(a0, b0, false, false); auto r1 = __builtin_amdgcn_permlane32_swap(a1, b1, false, false); \
    u32x4 w = {r0[0], r1[0], r0[1], r1[1]}; OUT = __builtin_bit_cast(bf16x8, w); } while (0)
    PK4(p0, 0, pa0); PK4(p0, 8, pa1); PK4(p1, 0, pa2); PK4(p1, 8, pa3);
#undef PK4
}
template <int DK>
__device__ __forceinline__ void qkt(f32x16& p0, f32x16& p1, const LAS char* Ks, const bf16x8* qr, const int (&kb)[4], int hi, const LAS char* lds0, unsigned qoff) {
    constexpr int RB = DK * 2;
    p0 = f32x16{}; p1 = f32x16{};
    if constexpr (DK == 128) {
#pragma unroll
        for (int d0 = 0; d0 < 8; ++d0) {
            const bf16x8 b0 = *(const LAS bf16x8*)(Ks + kb[d0 & 3] + (d0 >> 2) * 128);
            const bf16x8 b1 = *(const LAS bf16x8*)(Ks + kb[d0 & 3] + (d0 >> 2) * 128 + 32 * RB);
            p0 = __builtin_amdgcn_mfma_f32_32x32x16_bf16(b0, qr[d0], p0, 0, 0, 0);
            p1 = __builtin_amdgcn_mfma_f32_32x32x16_bf16(b1, qr[d0], p1, 0, 0, 0); }
    } else {
        asm volatile("" : "+v"(qoff));
        bf16x8 b0[2][2], b1[2][2], q[2][2];
#define QK_LD(g, s) do { _Pragma("unroll") for (int e = 0; e < 2; ++e) { const int d0 = 2 * (g) + e; \
            b0[s][e] = *(const LAS bf16x8*)(Ks + kb[d0 & 3] + (d0 >> 2) * 128); b1[s][e] = *(const LAS bf16x8*)(Ks + kb[d0 & 3] + (d0 >> 2) * 128 + 32 * RB); \
            if (d0 >= 6) q[s][e] = *(const LAS bf16x8*)(lds0 + qoff + (d0 - 6) * 1024); } } while (0)
#define QK_MM(g, s) do { _Pragma("unroll") for (int e = 0; e < 2; ++e) { const int d0 = 2 * (g) + e; \
            if (d0 >= 6) { p0 = __builtin_amdgcn_mfma_f32_32x32x16_bf16(b0[s][e], q[s][e], p0, 0, 0, 0); p1 = __builtin_amdgcn_mfma_f32_32x32x16_bf16(b1[s][e], q[s][e], p1, 0, 0, 0); } \
            else { p0 = __builtin_amdgcn_mfma_f32_32x32x16_bf16(b0[s][e], qr[d0], p0, 0, 0, 0); p1 = __builtin_amdgcn_mfma_f32_32x32x16_bf16(b1[s][e], qr[d0], p1, 0, 0, 0); } } } while (0)
        QK_LD(0, 0); SBAR();
        QK_LD(1, 1); SBAR(); QK_MM(0, 0); SBAR();
        QK_LD(2, 0); SBAR(); QK_MM(1, 1); SBAR();
        QK_LD(3, 1); SBAR(); QK_MM(2, 0); SBAR();
        QK_LD(4, 0); SBAR(); QK_MM(3, 1); SBAR();
        QK_LD(5, 1); SBAR(); QK_MM(4, 0); SBAR();
        QK_MM(5, 1); SBAR();
#undef QK_LD
#undef QK_MM
    }
}
__device__ __forceinline__ int v_st(int k, int c) { const int kk = (k & ~0xC) | ((k & 4) << 1) | ((k & 8) >> 1); return ((kk >> 3) * 4 + (c >> 5)) * 512 + ((kk & 7) * 32 + (c & 31)) * 2; }
__device__ __forceinline__ int v_rd_base(int lane) { return ((lane & 3) << 3) | (((lane >> 2) & 3) << 6) | (((lane >> 4) & 1) << 5) | (((lane >> 5) & 1) << 8); }
constexpr int v_rd_off(int d0, int ks, int half) { return d0 * 512 + ks * 4096 + half * 2048; }
template <int OFF> __device__ __forceinline__ s16x4 tr_read(int vb) {
    s16x4 r; asm volatile("ds_read_b64_tr_b16 %0, %1 offset:%2" : "=&v"(r) : "v"(vb), "i"(OFF) : "memory"); return r;
}
template <int D0> __device__ __forceinline__ void pv_one(f32x16& od, int vb, bf16x8 pa0, bf16x8 pa1, bf16x8 pa2, bf16x8 pa3) {
    const s16x4 l0 = tr_read<v_rd_off(D0, 0, 0)>(vb), h0 = tr_read<v_rd_off(D0, 0, 1)>(vb), l1 = tr_read<v_rd_off(D0, 1, 0)>(vb), h1 = tr_read<v_rd_off(D0, 1, 1)>(vb);
    const s16x4 l2 = tr_read<v_rd_off(D0, 2, 0)>(vb), h2 = tr_read<v_rd_off(D0, 2, 1)>(vb), l3 = tr_read<v_rd_off(D0, 3, 0)>(vb), h3 = tr_read<v_rd_off(D0, 3, 1)>(vb);
    asm volatile("s_waitcnt lgkmcnt(0)" ::: "memory"); SBAR();
#define PKV(L, H) (bf16x8){L[0], L[1], L[2], L[3], H[0], H[1], H[2], H[3]}
    od = __builtin_amdgcn_mfma_f32_32x32x16_bf16(pa0, PKV(l0, h0), od, 0, 0, 0);
    od = __builtin_amdgcn_mfma_f32_32x32x16_bf16(pa1, PKV(l1, h1), od, 0, 0, 0);
    od = __builtin_amdgcn_mfma_f32_32x32x16_bf16(pa2, PKV(l2, h2), od, 0, 0, 0);
    od = __builtin_amdgcn_mfma_f32_32x32x16_bf16(pa3, PKV(l3, h3), od, 0, 0, 0);
#undef PKV
}
__device__ __forceinline__ void pv_d0(f32x16* o, int vb, bf16x8 pa0, bf16x8 pa1, bf16x8 pa2, bf16x8 pa3) {
    pv_one<0>(o[0], vb, pa0, pa1, pa2, pa3); pv_one<1>(o[1], vb, pa0, pa1, pa2, pa3); pv_one<2>(o[2], vb, pa0, pa1, pa2, pa3); pv_one<3>(o[3], vb, pa0, pa1, pa2, pa3);
}

template <int DK, bool MASK, int SDEPTH>
__device__ __forceinline__ void attn_unit(const bf16_t* __restrict__ Qb, const int ldq, const bf16_t* __restrict__ Kh, const int ldk, const bf16_t* __restrict__ Vh, const int ldv,
                                          bf16_t* __restrict__ Ob, const int ldo, const int NT, const float scale, LAS char* lds, const f32x2* __restrict__ ropeA, const int qpos0, const int dq0, const int tid, u64* __restrict__ yss) {
    constexpr int RB = DK * 2, SHM_V = KVBLK * 128 * 2, SHM_K = KVBLK * RB;
    const int wid = tid >> 6, lane = tid & 63, r32 = lane & 31, hi = lane >> 5;
    LAS char* V_lds = lds; LAS char* K_lds = lds + 2 * SHM_V;
    const float C = scale * 1.4426950408889634f;
    const float thr = MASK ? THR * 1.4426950408889634f : THR / scale;
    float m_reg = -1e30f, l_reg = 0; f32x16 o[4] = {}; bf16x8 qr[(DK == 192) ? 6 : 8];
    const unsigned qoff = 2 * SHM_V + 2 * SHM_K + 2048 + wid * 6144 + lane * 16;
    int kb[4];
#pragma unroll
    for (int k = 0; k < 4; ++k) kb[k] = r32 * RB + ((hi ^ (r32 & 1)) << 4) + ((k ^ ((r32 & 7) >> 1)) << 5);
    int tq = tid; asm volatile("" : "+v"(tq));
    const bf16_t* Qw = Qb + (size_t)(unsigned)(((tq >> 6) * QBLK + (tq & 31)) * ldq + ((tq >> 5) & 1) * 8);
    constexpr int NQR = (DK == 192) ? 6 : 8;
#pragma unroll
    for (int d0 = 0; d0 < NQR; ++d0) qr[d0] = *(const bf16x8*)(Qw + d0 * 16);
    if constexpr (DK == 192) {
        *(LAS bf16x8*)(lds + qoff) = *(const bf16x8*)(Qw + 6 * 16); *(LAS bf16x8*)(lds + qoff + 1024) = *(const bf16x8*)(Qw + 7 * 16);
        const f32x2* rp = ropeA + (size_t)(unsigned)((qpos0 + (tq >> 6) * QBLK + (tq & 31)) * 32 + ((tq >> 5) & 1) * 8);
#pragma unroll
        for (int dd = 0; dd < 2; ++dd) {
            bf16x8 x1 = *(const bf16x8*)(Qw + (8 + dd) * 16), x2 = *(const bf16x8*)(Qw + (10 + dd) * 16);
#pragma unroll
            for (int e = 0; e < 8; ++e) { const f32x2 cs = rp[dd * 16 + e]; const float a = bf2f((unsigned short)x1[e]), b = bf2f((unsigned short)x2[e]);
                x1[e] = (short)f2bf(a * cs.x - b * cs.y); x2[e] = (short)f2bf(b * cs.x + a * cs.y); }
            *(LAS bf16x8*)(lds + qoff + (2 + dd) * 1024) = x1; *(LAS bf16x8*)(lds + qoff + (4 + dd) * 1024) = x2;
        }
        asm volatile("s_waitcnt lgkmcnt(0)" ::: "memory");
    }
    const int sr = tid >> 4, sc = (tid & 15) * 8, vst0 = v_st(sr, sc); constexpr int vst1d = 8192;
    const int kst0 = sr * RB + ((sc * 2) ^ ((sr & 7) << 4));
    const int kr2 = tid >> 3, kc2 = 128 + (tid & 7) * 8, kst2 = kr2 * RB + ((kc2 * 2) ^ ((kr2 & 7) << 4));
    const int vb0 = (int)(uintptr_t)V_lds + v_rd_base(lane);
    bf16x8 vs0[SDEPTH], vs1[SDEPTH], ks0[SDEPTH], ks1[SDEPTH], ks2[SDEPTH];
    const unsigned voV0 = (unsigned)(sr * ldv + sc) * 2u, voK0 = (unsigned)(sr * ldk + sc) * 2u, voK2 = (unsigned)(kr2 * ldk + kc2) * 2u;
#define SLOAD(i, k0) do { const char* Vt = (const char*)Vh + (size_t)(k0) * (size_t)(ldv * 2); const char* Kt = (const char*)Kh + (size_t)(k0) * (size_t)(ldk * 2); \
    vs0[i] = *(const bf16x8*)(Vt + (size_t)voV0); vs1[i] = *(const bf16x8*)(Vt + (size_t)(ldv * 64) + (size_t)voV0); \
    ks0[i] = *(const bf16x8*)(Kt + (size_t)voK0); ks1[i] = *(const bf16x8*)(Kt + (size_t)(ldk * 64) + (size_t)voK0); \
    if constexpr (DK == 192) ks2[i] = *(const bf16x8*)(Kt + (size_t)voK2); } while (0)
#define SWRITE(b, i) do { *(LAS bf16x8*)(V_lds + (b) * SHM_V + vst0) = vs0[i]; *(LAS bf16x8*)(V_lds + (b) * SHM_V + vst1d + vst0) = vs1[i]; \
    *(LAS bf16x8*)(K_lds + (b) * SHM_K + kst0) = ks0[i]; *(LAS bf16x8*)(K_lds + (b) * SHM_K + 32 * RB + kst0) = ks1[i]; \
    if constexpr (DK == 192) *(LAS bf16x8*)(K_lds + (b) * SHM_K + kst2) = ks2[i]; } while (0)
#define SWAIT() do { if constexpr (SDEPTH == 2) { if constexpr (DK == 192) asm volatile("s_waitcnt vmcnt(5)" ::: "memory"); else asm volatile("s_waitcnt vmcnt(4)" ::: "memory"); } \
    else asm volatile("s_waitcnt vmcnt(0)" ::: "memory"); } while (0)
#define RESC(a) do { if (__any((a) < 1.f)) { int t3 = tid; asm volatile("" : "+v"(t3)); LAS float* al3 = (LAS float*)(lds + 2 * SHM_V + 2 * SHM_K) + (t3 >> 6) * 64 + 32; \
    if (((t3 >> 5) & 1) == 0) al3[t3 & 31] = (a); asm volatile("s_waitcnt lgkmcnt(0)" ::: "memory"); const LAS float* ar3 = al3 + 4 * ((t3 >> 5) & 1); \
    _Pragma("unroll") for (int d = 0; d < 4; ++d) _Pragma("unroll") for (int r = 0; r < 16; ++r) o[d][r] *= ar3[(r & 3) + 8 * (r >> 2)]; } } while (0)
    f32x16 pA0, pA1, pB0, pB1; float mnA, mnB, alA, alB; bf16x8 pa0, pa1, pa2, pa3;
    const int dw0 = dq0 - __builtin_amdgcn_readfirstlane(wid) * QBLK;
    const int db0 = dq0 + 4 * hi - (wid * QBLK + r32);
    constexpr int SE = 0, SO = SDEPTH - 1;
    SLOAD(SE, 0); asm volatile("s_waitcnt vmcnt(0)" ::: "memory"); SWRITE(0, SE); __syncthreads();
    qkt<DK>(pA0, pA1, K_lds, qr, kb, hi, lds, qoff); partialSM<MASK>(pA0, pA1, m_reg, mnA, alA, C, thr, db0, dw0);
    SLOAD(SO, KVBLK); if constexpr (SDEPTH == 2) { if (2 < NT) SLOAD(SE, 2 * KVBLK); }
    SWAIT(); SWRITE(1, SO); __syncthreads();
    for (int j = 1; j + 1 < NT; j += 2) {
        SBAR(); qkt<DK>(pB0, pB1, K_lds + SHM_K, qr, kb, hi, lds, qoff);
        finishSM(pA0, pA1, alA, l_reg, pa0, pa1, pa2, pa3); SBAR();
        SLOAD(SO, (j + SDEPTH) * KVBLK); SBAR();
        pv_d0(o, vb0, pa0, pa1, pa2, pa3); partialSM<MASK>(pB0, pB1, m_reg, mnB, alB, C, thr, db0 + j * KVBLK, dw0 + j * KVBLK);
        __syncthreads(); SWAIT(); SWRITE(0, SE);
        RESC(alB); __syncthreads();
        SBAR(); qkt<DK>(pA0, pA1, K_lds, qr, kb, hi, lds, qoff);
        finishSM(pB0, pB1, alB, l_reg, pa0, pa1, pa2, pa3); SBAR();
        if (SDEPTH == 1 || j + 3 < NT) SLOAD(SE, (j + 1 + SDEPTH) * KVBLK); SBAR();
        pv_d0(o, vb0 + SHM_V, pa0, pa1, pa2, pa3); partialSM<MASK>(pA0, pA1, m_reg, mnA, alA, C, thr, db0 + (j + 1) * KVBLK, dw0 + (j + 1) * KVBLK);
        __syncthreads(); SWAIT(); SWRITE(1, SO);
        RESC(alA); __syncthreads();
    }
    SBAR(); qkt<DK>(pB0, pB1, K_lds + SHM_K, qr, kb, hi, lds, qoff);
    finishSM(pA0, pA1, alA, l_reg, pa0, pa1, pa2, pa3); SBAR();
    pv_d0(o, vb0, pa0, pa1, pa2, pa3); partialSM<MASK>(pB0, pB1, m_reg, mnB, alB, C, thr, db0 + (NT - 1) * KVBLK, dw0 + (NT - 1) * KVBLK);
    __syncthreads(); RESC(alB);
    finishSM(pB0, pB1, alB, l_reg, pa0, pa1, pa2, pa3); SBAR();
    pv_d0(o, vb0 + SHM_V, pa0, pa1, pa2, pa3);
    int to = tid; asm volatile("" : "+v"(to));
    { LAS float* li3 = (LAS float*)(lds + 2 * SHM_V + 2 * SHM_K) + (to >> 6) * 64;
      if (((to >> 5) & 1) == 0) li3[to & 31] = l_reg; asm volatile("s_waitcnt lgkmcnt(0)" ::: "memory"); }
    float rli[16];
    { const LAS float* lr3 = (const LAS float*)(lds + 2 * SHM_V + 2 * SHM_K) + (to >> 6) * 64 + 4 * ((to >> 5) & 1);
#pragma unroll
      for (int r = 0; r < 16; ++r) rli[r] = __builtin_amdgcn_rcpf(lr3[(r & 3) + 8 * (r >> 2)]); }
    const unsigned ooff = (unsigned)((((to >> 6) * QBLK + 4 * ((to >> 5) & 1)) * ldo + (to & 31)) * 2);
    float sq[16];
#pragma unroll
    for (int r = 0; r < 16; ++r) { sq[r] = 0.f;
#pragma unroll
        for (int d0 = 0; d0 < 4; ++d0) { const float v = o[d0][r] * rli[r]; sq[r] += v * v;
            *(bf16_t*)((char*)Ob + (size_t)(ooff + (unsigned)((((r & 3) + 8 * (r >> 2)) * ldo + d0 * 32) * 2))) = f2bf(v); } }
#pragma unroll
    for (int r = 0; r < 16; ++r) {
#pragma unroll
        for (int x = 1; x < 32; x <<= 1) sq[r] += __builtin_bit_cast(float, __builtin_amdgcn_ds_bpermute(((to & 63) ^ x) << 2, __builtin_bit_cast(int, sq[r])));
        if ((to & 31) == r) fx_add(yss + (size_t)((to >> 6) * QBLK + 4 * ((to >> 5) & 1) + (r & 3) + 8 * (r >> 2)) * 4, sq[r]); }
#undef SLOAD
#undef SWRITE
#undef SWAIT
#undef RESC
}
}

struct TrJob { const float* W; bf16_t* WT; const float* gain; int N, Kd, mode, item; };
__device__ __forceinline__ void tr_load(const TrJob& j, int lane, f32x4 (&v)[8]) {
    const int nblk = j.N / 32, kb = j.item / nblk, nb = j.item % nblk, k0 = 64 * kb, n0 = 32 * nb;
    const float* p = j.W + (size_t)(k0 + (lane >> 3)) * j.N + n0 + 4 * (lane & 7);
#pragma unroll
    for (int i = 0; i < 8; ++i) v[i] = *(const f32x4*)(p + (size_t)(8 * i) * j.N);
}
__device__ __forceinline__ void tr_write(LAS float* scr, int lane, const f32x4 (&v)[8]) {
#pragma unroll
    for (int i = 0; i < 8; ++i) { LAS float* d = scr + (8 * i + (lane >> 3)) * 33 + 4 * (lane & 7); d[0] = v[i].x; d[1] = v[i].y; d[2] = v[i].z; d[3] = v[i].w; }
}
__device__ __forceinline__ void tr_store(const TrJob& j, LAS float* scr, int lane) {
    const int nblk = j.N / 32, kb = j.item / nblk, nb = j.item % nblk, k0 = 64 * kb, n0 = 32 * nb;
    const int rb = (j.mode == 0) ? n0 : (256 * (n0 >> 7) + (n0 & 127) + (j.mode == 2 ? 128 : 0));
    const int c = lane & 7;
    f32x4 g0 = {1.f, 1.f, 1.f, 1.f}, g1 = g0;
    if (j.gain) { g0 = *(const f32x4*)(j.gain + k0 + 8 * c); g1 = *(const f32x4*)(j.gain + k0 + 8 * c + 4); }
    asm volatile("s_waitcnt lgkmcnt(0)" ::: "memory");
#pragma unroll
    for (int jj = 0; jj < 4; ++jj) { const int n = (lane >> 3) + 8 * jj; const LAS float* s = scr + (8 * c) * 33 + n;
        u32x4 o; o.x = cvt_pk_bf16(s[0 * 33] * g0.x, s[1 * 33] * g0.y); o.y = cvt_pk_bf16(s[2 * 33] * g0.z, s[3 * 33] * g0.w);
        o.z = cvt_pk_bf16(s[4 * 33] * g1.x, s[5 * 33] * g1.y); o.w = cvt_pk_bf16(s[6 * 33] * g1.z, s[7 * 33] * g1.w);
        *(u32x4*)(j.WT + (size_t)(rb + n) * j.Kd + k0 + 8 * c) = o; }
    asm volatile("s_waitcnt lgkmcnt(0)" ::: "memory");
}

struct Args { const float* in[16]; float* out; unsigned char* ws; int ph_lo, ph_hi; };

constexpr int I_IN = 32 * 146, I_UQ = 8 * 24, I_UKV = 8 * 32, I_OUT = 32 * 64, I_G = 32 * 176, I_DN = 88 * 64;
constexpr int I_LAYER = I_IN + I_UQ + I_UKV + I_OUT + 2 * I_G + I_DN;
constexpr int TR_P0 = I_IN + I_UQ + I_UKV + I_OUT, TR_P1 = I_LAYER + I_IN + I_UQ + I_UKV;
template <class ArgsT>
__device__ __forceinline__ TrJob tr_job(const ArgsT& a, unsigned char* ws, int it) {
    const int l = it / I_LAYER; int r = it % I_LAYER; unsigned char* wl = ws + WS_W + (size_t)l * W_LAYER;
    const float* W; bf16_t* WT; const float* gain; int N, Kd, mode = 0;
    const float *p1 = a.in[1], *p2 = a.in[2], *p3 = a.in[3], *p4 = a.in[4], *p5 = a.in[5], *p6 = a.in[6], *p9 = a.in[9], *p10 = a.in[10], *p11 = a.in[11], *p12 = a.in[12], *p13 = a.in[13], *p14 = a.in[14];
    asm volatile("" : "+s"(p1), "+s"(p2), "+s"(p3), "+s"(p4), "+s"(p5), "+s"(p6)); asm volatile("" : "+s"(p9), "+s"(p10), "+s"(p11), "+s"(p12), "+s"(p13), "+s"(p14));
    if (r < I_IN) { W = p2 + (size_t)l * DM * INW; WT = (bf16_t*)(wl + W_IN); gain = p1 + l * DM; N = INW; Kd = DM; }
    else if ((r -= I_IN) < I_UQ) { W = p4 + (size_t)l * 512 * 768; WT = (bf16_t*)(wl + W_UQ); gain = p3 + l * 512; N = 768; Kd = 512; }
    else if ((r -= I_UQ) < I_UKV) { W = p6 + (size_t)l * 512 * 1024; WT = (bf16_t*)(wl + W_UKV); gain = p5 + l * 512; N = 1024; Kd = 512; }
    else if ((r -= I_UKV) < I_OUT) { W = p10 + (size_t)l * DM * DM; WT = (bf16_t*)(wl + W_OUT); gain = p9 + l * DM; N = DM; Kd = DM; }
    else if ((r -= I_OUT) < I_G) { W = p12 + (size_t)l * DM * DFF; WT = (bf16_t*)(wl + W_GU); gain = p11 + l * DM; N = DFF; Kd = DM; mode = 1; }
    else if ((r -= I_G) < I_G) { W = p13 + (size_t)l * DM * DFF; WT = (bf16_t*)(wl + W_GU); gain = p11 + l * DM; N = DFF; Kd = DM; mode = 2; }
    else { r -= I_G; W = p14 + (size_t)l * DFF * DM; WT = (bf16_t*)(wl + W_DN); gain = nullptr; N = DM; Kd = DFF; }
    TrJob j; j.W = W; j.WT = WT; j.gain = gain; j.N = N; j.Kd = Kd; j.mode = mode; j.item = r; return j;
}
__device__ __forceinline__ void ph_prologue(const Args& a, LAS unsigned char* lds, int gw, int NGW, int lane, int wave) {
    LAS float* scr = (LAS float*)(lds + wave * 16384);
    unsigned char* ws = a.ws;
    { f32x4 v[8]; int it = gw; TrJob cur = tr_job(a, ws, it < TR_P0 ? it : 0);
      if (it < TR_P0) tr_load(cur, lane, v);
      while (it < TR_P0) {
          const int nit = it + NGW;
          tr_write(scr, lane, v);
          TrJob nxt = cur;
          if (nit < TR_P0) { nxt = tr_job(a, ws, nit); tr_load(nxt, lane, v); }
          tr_store(cur, scr, lane);
          cur = nxt; it = nit;
      } }
    const int gt = gw * 64 + lane, NGT = NGW * 64;
    for (int l = 0; l < 2; ++l) { u32x4* z = (u32x4*)(ws + WS_W + (size_t)l * W_LAYER + W_IN + (size_t)INW * DM * 2);
        for (int i = gt; i < (INP - INW) * DM * 2 / 16; i += NGT) z[i] = (u32x4){0u, 0u, 0u, 0u}; }
    { u64* rss = (u64*)(ws + WS_CTL + RSS_OFF); bf16_t* XB = (bf16_t*)(ws + WS_XN);
      for (int i = gt; i < 3 * T; i += NGT) rss[T + i] = 0ull;
      { u64* yz = (u64*)(ws + WS_CTL + YSS_OFF); for (int i = gt; i < 2 * T * 4; i += NGT) yz[i] = 0ull; }
      { u64* cz = (u64*)(ws + WS_CTL + CSS_OFF); for (int i = gt; i < 2 * T * 2; i += NGT) cz[i] = 0ull; }
      for (int m = gw; m < T; m += NGW) {
          const f32x4* xr = (const f32x4*)(a.in[0] + (size_t)m * DM) + lane; u32x2* o = (u32x2*)(XB + (size_t)m * DM) + lane; float sq = 0.f;
#pragma unroll
          for (int j = 0; j < 8; ++j) { const f32x4 v = xr[64 * j]; sq += (v.x * v.x + v.y * v.y) + (v.z * v.z + v.w * v.w);
              u32x2 w; w.x = cvt_pk_bf16(v.x, v.y); w.y = cvt_pk_bf16(v.z, v.w); o[64 * j] = w; }
          sq = wave_sum(sq, lane); if (lane == 0) rss[m] = (u64)(sq * FXS + 0.5f); } }
    f32x2* ra = (f32x2*)(ws + WS_ROPEA); f32x2* r1 = (f32x2*)(ws + WS_ROPE1);
    for (int i = gt; i < 4096 * 32 + 4096 * 64; i += NGT) {
        int pos, fi; float inv; f32x2* dst;
        if (i < 4096 * 32) { pos = i >> 5; fi = i & 31; inv = __builtin_amdgcn_exp2f(-(float)(2 * fi) * (13.287712379549449f / 64.f)); dst = ra + i; }
        else { const int j = i - 4096 * 32; pos = j >> 6; fi = j & 63; inv = __builtin_amdgcn_exp2f(-(float)(2 * fi) * (13.287712379549449f / 128.f)); dst = r1 + j; }
        const float ang = (float)pos * inv;
        const double rev = (double)ang * 0.15915494309189535; const float fr = (float)(rev - __builtin_rint(rev));
        *dst = (f32x2){__builtin_amdgcn_cosf(fr), __builtin_amdgcn_sinf(fr)};
    }
}

__device__ __forceinline__ void ph_norm_bf16(const float* x, const float* g, bf16_t* out, int gw, int NGW, int lane) {
    for (int m = gw; m < T; m += NGW) {
        const f32x4* xr = (const f32x4*)(x + (size_t)m * DM) + lane; f32x4 v[8]; float s = 0.f;
#pragma unroll
        for (int j = 0; j < 8; ++j) { v[j] = xr[64 * j]; s += (v[j].x * v[j].x + v[j].y * v[j].y) + (v[j].z * v[j].z + v[j].w * v[j].w); }
        const float rs = 1.0f / sqrtf(wave_sum(s, lane) * (1.f / DM) + EPS);
        u32x2* o = (u32x2*)(out + (size_t)m * DM) + lane;
#pragma unroll
        for (int j = 0; j < 8; ++j) { const f32x4 gg = ((const f32x4*)g)[lane + 64 * j]; u32x2 w; w.x = cvt_pk_bf16(v[j].x * rs * gg.x, v[j].y * rs * gg.y); w.y = cvt_pk_bf16(v[j].z * rs * gg.z, v[j].w * rs * gg.w); o[64 * j] = w; }
    }
}
__device__ __forceinline__ void unpack8(const u32x4 w, float (&x)[8]) { x[0] = bflo(w.x); x[1] = bfhi(w.x); x[2] = bflo(w.y); x[3] = bfhi(w.y); x[4] = bflo(w.z); x[5] = bfhi(w.z); x[6] = bflo(w.w); x[7] = bfhi(w.w); }
__device__ __forceinline__ u32x4 pack8(const float (&x)[8]) { u32x4 o; o.x = cvt_pk_bf16(x[0], x[1]); o.y = cvt_pk_bf16(x[2], x[3]); o.z = cvt_pk_bf16(x[4], x[5]); o.w = cvt_pk_bf16(x[6], x[7]); return o; }
__device__ __forceinline__ void ph_final(const bf16_t* xb, float* out, const float* g, int gw, int NGW, int lane) {
    for (int m0 = gw; m0 < T; m0 += 2 * NGW) {
        float v[2][4][8]; float s[2] = {0.f, 0.f};
#pragma unroll
        for (int rr = 0; rr < 2; ++rr) { const int mr = (m0 + rr * NGW < T) ? m0 + rr * NGW : m0; const u32x4* xr = (const u32x4*)(xb + (size_t)mr * DM) + lane;
#pragma unroll
            for (int j = 0; j < 4; ++j) { unpack8(xr[64 * j], v[rr][j]);
#pragma unroll
                for (int e = 0; e < 8; ++e) s[rr] += v[rr][j][e] * v[rr][j][e]; } }
#pragma unroll
        for (int rr = 0; rr < 2; ++rr) { if (m0 + rr * NGW >= T) continue; f32x4* o = (f32x4*)(out + (size_t)(m0 + rr * NGW) * DM) + 2 * lane;
            const float rs = 1.0f / sqrtf(wave_sum(s[rr], lane) * (1.f / DM) + EPS);
#pragma unroll
            for (int j = 0; j < 4; ++j) { const f32x4 g0 = ((const f32x4*)g)[2 * (lane + 64 * j)], g1 = ((const f32x4*)g)[2 * (lane + 64 * j) + 1];
                o[128 * j] = (f32x4){v[rr][j][0] * rs * g0.x, v[rr][j][1] * rs * g0.y, v[rr][j][2] * rs * g0.z, v[rr][j][3] * rs * g0.w};
                o[128 * j + 1] = (f32x4){v[rr][j][4] * rs * g1.x, v[rr][j][5] * rs * g1.y, v[rr][j][6] * rs * g1.z, v[rr][j][7] * rs * g1.w}; } }
    }
}
__device__ __forceinline__ void ph_prep(const Args& a, int l, int gw, int NGW, int lane) {
    bf16_t* PROJ = (bf16_t*)(a.ws + WS_BIG); bf16_t* KA = (bf16_t*)(a.ws + WS_KA);
    const f32x2* ra = (const f32x2*)(a.ws + WS_ROPEA); const f32x2* r1 = (const f32x2*)(a.ws + WS_ROPE1);
    const float* gq = a.in[3] + l * 512; const float* gkv = a.in[5] + l * 512; const float* cqn = a.in[7] + l * 128; const float* ckn = a.in[8] + l * 128;
    const int j8 = lane & 7, hd = lane >> 3;
    for (int m0 = gw; m0 < T; m0 += 2 * NGW) {
#pragma unroll
      for (int rr = 0; rr < 2; ++rr) { const int m = m0 + rr * NGW; if (m >= T) continue;
        bf16_t* P = PROJ + (size_t)m * INP; const int s = m & (SEQ - 1);
        if (lane < 4) {
            float x1[8], x2[8]; unpack8(*(const u32x4*)(P + PA_KR + 8 * lane), x1); unpack8(*(const u32x4*)(P + PA_KR + 32 + 8 * lane), x2);
            const f32x4* cp = (const f32x4*)(ra + s * 32 + 8 * lane);
#pragma unroll
            for (int e2 = 0; e2 < 4; ++e2) { const f32x4 cs = cp[e2];
                const float a0 = x1[2 * e2], b0 = x2[2 * e2], a1 = x1[2 * e2 + 1], b1 = x2[2 * e2 + 1];
                x1[2 * e2] = a0 * cs.x - b0 * cs.y; x2[2 * e2] = b0 * cs.x + a0 * cs.y; x1[2 * e2 + 1] = a1 * cs.z - b1 * cs.w; x2[2 * e2 + 1] = b1 * cs.z + a1 * cs.w; }
            const u32x4 y1 = pack8(x1), y2 = pack8(x2); bf16_t* kp = KA + (size_t)m * 768 + 128 + 8 * lane;
#pragma unroll
            for (int h = 0; h < 4; ++h) { *(u32x4*)(kp + h * 192) = y1; *(u32x4*)(kp + h * 192 + 32) = y2; }
        }
        { const f32x4* cp = (const f32x4*)(r1 + s * 64 + 8 * j8); const f32x4 c0 = cp[0], c1 = cp[1], c2 = cp[2], c3 = cp[3];
#pragma unroll
          for (int pass = 0; pass < 2; ++pass) { const int head = 8 * pass + hd;
              if (head < 12) { bf16_t* hp = P + PB_Q + head * 128 + 8 * j8; float x1[8], x2[8]; unpack8(*(const u32x4*)hp, x1); unpack8(*(const u32x4*)(hp + 64), x2);
                  const float cc[8] = {c0.x, c0.z, c1.x, c1.z, c2.x, c2.z, c3.x, c3.z}, sn[8] = {c0.y, c0.w, c1.y, c1.w, c2.y, c2.w, c3.y, c3.w};
#pragma unroll
                  for (int e = 0; e < 8; ++e) { const float p = x1[e], q = x2[e]; x1[e] = p * cc[e] - q * sn[e]; x2[e] = q * cc[e] + p * sn[e]; }
                  *(u32x4*)hp = pack8(x1); *(u32x4*)(hp + 64) = pack8(x2); } } }
        { const int half = j8 >> 2, jj = j8 & 3; bf16_t* hp = P + PC_Q + hd * 128 + 64 * half + 8 * jj;
          float x1[8], x2[8]; unpack8(*(const u32x4*)hp, x1); unpack8(*(const u32x4*)(hp + 32), x2);
          const f32x4* cp = (const f32x4*)(ra + (half ? (s & 63) : (s >> 6)) * 32 + 8 * jj); const f32x4 c0 = cp[0], c1 = cp[1], c2 = cp[2], c3 = cp[3];
          const float* g = (hd < 6 ? cqn : ckn) + 64 * half + 8 * jj; const f32x4 ga = *(const f32x4*)g, gb = *(const f32x4*)(g + 4), gc = *(const f32x4*)(g + 32), gd = *(const f32x4*)(g + 36);
          float ss = 0.f;
#pragma unroll
          for (int e = 0; e < 8; ++e) ss += x1[e] * x1[e] + x2[e] * x2[e];
          ss += __builtin_bit_cast(float, __builtin_amdgcn_ds_bpermute((lane ^ 1) << 2, __builtin_bit_cast(int, ss)));
          ss += __builtin_bit_cast(float, __builtin_amdgcn_ds_bpermute((lane ^ 2) << 2, __builtin_bit_cast(int, ss)));
          ss += __builtin_bit_cast(float, __builtin_amdgcn_ds_bpermute((lane ^ 4) << 2, __builtin_bit_cast(int, ss)));
          const float rs = 1.0f / sqrtf(ss * (1.f / 128.f) + EPS);
          const float g1[8] = {ga.x, ga.y, ga.z, ga.w, gb.x, gb.y, gb.z, gb.w}, g2[8] = {gc.x, gc.y, gc.z, gc.w, gd.x, gd.y, gd.z, gd.w};
          const float cc[8] = {c0.x, c0.z, c1.x, c1.z, c2.x, c2.z, c3.x, c3.z}, sn[8] = {c0.y, c0.w, c1.y, c1.w, c2.y, c2.w, c3.y, c3.w};
#pragma unroll
          for (int e = 0; e < 8; ++e) { const float p = x1[e] * rs * g1[e], q = x2[e] * rs * g2[e]; x1[e] = p * cc[e] - q * sn[e]; x2[e] = q * cc[e] + p * sn[e]; }
          *(u32x4*)hp = pack8(x1); *(u32x4*)(hp + 32) = pack8(x2); }
      }
    }
}
__device__ __forceinline__ void ph_ynorm(bf16_t* Y, const float* g, int gw, int NGW, int lane) {
    for (int m = gw; m < T; m += NGW) {
        u32x4* p = (u32x4*)(Y + (size_t)m * DM) + lane; float x[4][8]; float sa = 0.f, sb = 0.f, sc = 0.f;
#pragma unroll
        for (int j = 0; j < 4; ++j) { const u32x4 w = p[64 * j];
            x[j][0] = bflo(w.x); x[j][1] = bfhi(w.x); x[j][2] = bflo(w.y); x[j][3] = bfhi(w.y); x[j][4] = bflo(w.z); x[j][5] = bfhi(w.z); x[j][6] = bflo(w.w); x[j][7] = bfhi(w.w);
            float ss = 0.f;
#pragma unroll
            for (int e = 0; e < 8; ++e) ss += x[j][e] * x[j][e];
            if (j == 0) sa += ss; else if (j == 1) sb += ss; else if (j == 2) { if (lane < 32) sb += ss; else sc += ss; } else sc += ss; }
        const float ra_ = 1.0f / sqrtf(wave_sum(sa, lane) * (1.f / 512.f) + EPS), rb_ = 1.0f / sqrtf(wave_sum(sb, lane) * (1.f / 768.f) + EPS), rc_ = 1.0f / sqrtf(wave_sum(sc, lane) * (1.f / 768.f) + EPS);
#pragma unroll
        for (int j = 0; j < 4; ++j) { const float rs = (j == 0) ? ra_ : (j == 1) ? rb_ : (j == 2) ? (lane < 32 ? rb_ : rc_) : rc_;
            const float* gp = g + (lane + 64 * j) * 8; const f32x4 g0 = *(const f32x4*)gp, g1 = *(const f32x4*)(gp + 4);
            u32x4 o; o.x = cvt_pk_bf16(x[j][0] * rs * g0.x, x[j][1] * rs * g0.y); o.y = cvt_pk_bf16(x[j][2] * rs * g0.z, x[j][3] * rs * g0.w);
            o.z = cvt_pk_bf16(x[j][4] * rs * g1.x, x[j][5] * rs * g1.y); o.w = cvt_pk_bf16(x[j][6] * rs * g1.z, x[j][7] * rs * g1.w);
            p[64 * j] = o; }
    }
}

#if defined(__HIP_DEVICE_COMPILE__)
__device__ __forceinline__ void ph_attention(const __attribute__((address_space(4))) Args* ap, int l, LAS unsigned char* lds, const int rep) {
    volatile LAS int* slot = (volatile LAS int*)(lds + LDS_SLOT);
#if !defined(NO_ATT_A)
    for (;;) {
        asm volatile("" : "+s"(ap));
        unsigned char* ws = ap->ws;
        const bf16_t* QA = (const bf16_t*)(ws + WS_QA); const bf16_t* KA = (const bf16_t*)(ws + WS_KA);
        const bf16_t* VA = (const bf16_t*)(ws + WS_VA); bf16_t* Y = (bf16_t*)(ws + WS_XN); const f32x2* ra = (const f32x2*)(ws + WS_ROPEA);
        if (threadIdx.x == 0) *slot = (int)__hip_atomic_fetch_add((unsigned*)(ws + WS_CTL) + 64 * (1 + l + 4 * rep), 1u, __ATOMIC_RELAXED, __HIP_MEMORY_SCOPE_AGENT);
        __syncthreads(); const int u = __builtin_amdgcn_readfirstlane(*slot); __syncthreads();
        if (u >= 256) break;
        int tid = threadIdx.x; asm volatile("" : "+v"(tid));
        const int b = u >> 6, h = (u >> 4) & 3, qb = u & 15; const size_t row = (size_t)b * SEQ + qb * 256;
        att::attn_unit<192, false, 1>(QA + row * 768 + h * 192, 768, KA + (size_t)b * SEQ * 768 + h * 192, 768, VA + (size_t)b * SEQ * 512 + h * 128, 512,
                                      Y + row * DM + h * 128, DM, SEQ / 64, 0.07216878364870322f, (LAS char*)lds, ra, qb * 256, 0, tid, (u64*)(ws + WS_CTL + YSS_OFF) + ((size_t)l * T + row) * 4 + 0);
    }
#endif
    for (;;) {
        asm volatile("" : "+s"(ap));
        unsigned char* ws = ap->ws;
        const bf16_t* PROJ = (const bf16_t*)(ws + WS_BIG); bf16_t* Y = (bf16_t*)(ws + WS_XN);
        if (threadIdx.x == 0) *slot = (int)__hip_atomic_fetch_add((unsigned*)(ws + WS_CTL) + 64 * (3 + l + 4 * rep), 1u, __ATOMIC_RELAXED, __HIP_MEMORY_SCOPE_AGENT);
        __syncthreads(); const int v = __builtin_amdgcn_readfirstlane(*slot); __syncthreads();
        if (v >= 768) break;
        int tid = threadIdx.x; asm volatile("" : "+v"(tid));
#if !defined(NO_ATT_C)
        if (v < 384) { const int b = v / 96, h = (v >> 4) % 6, qb = v & 15, kvh = h / 3; const size_t row = (size_t)b * SEQ + qb * 256;
            att::attn_unit<128, false, 1>(PROJ + row * INP + PC_Q + h * 128, INP, PROJ + (size_t)b * SEQ * INP + PC_K + kvh * 128, INP, PROJ + (size_t)b * SEQ * INP + PC_V + kvh * 128, INP,
                                          Y + row * DM + 1280 + h * 128, DM, SEQ / 64, 0.08838834764831845f, (LAS char*)lds, nullptr, 0, 0, tid, (u64*)(ws + WS_CTL + YSS_OFF) + ((size_t)l * T + row) * 4 + 2);
        } else
#endif
#if !defined(NO_ATT_B)
        { const int w = v - 384, b = w / 96, h = (w >> 4) % 6, qb = w & 15; const size_t row = (size_t)b * SEQ + qb * 256;
            const int q0 = qb * 256, lo = q0 - 1024 < 0 ? 0 : q0 - 1024, hi_ = q0 + 1280 > SEQ ? SEQ : q0 + 1280;
            att::attn_unit<128, true, 1>(PROJ + row * INP + PB_Q + h * 128, INP, PROJ + ((size_t)b * SEQ + lo) * INP + PB_K + h * 128, INP, PROJ + ((size_t)b * SEQ + lo) * INP + PB_V + h * 128, INP,
                                         Y + row * DM + 512 + h * 128, DM, (hi_ - lo) / 64, 0.08838834764831845f, (LAS char*)lds, nullptr, 0, lo - q0, tid, (u64*)(ws + WS_CTL + YSS_OFF) + ((size_t)l * T + row) * 4 + 1);
        }
#endif
        {}
    }
    { const int it0 = (l == 0) ? TR_P0 : TR_P1, it1 = (l == 0) ? TR_P1 : 2 * I_LAYER, nun = (it1 - it0) / 16;
      for (;;) {
        asm volatile("" : "+s"(ap));
        unsigned char* ws = ap->ws;
        if (threadIdx.x == 0) *slot = (int)__hip_atomic_fetch_add((unsigned*)(ws + WS_CTL) + 64 * (9 + l + 2 * rep), 1u, __ATOMIC_RELAXED, __HIP_MEMORY_SCOPE_AGENT);
        __syncthreads(); const int c = __builtin_amdgcn_readfirstlane(*slot); __syncthreads();
        if (c >= nun) break;
        int tid = threadIdx.x; asm volatile("" : "+v"(tid));
        const int lane = tid & 63, wave = __builtin_amdgcn_readfirstlane(tid >> 6);
        const Args a = *ap;
        const TrJob j0 = tr_job(a, ws, it0 + 16 * c + wave), j1 = tr_job(a, ws, it0 + 16 * c + 8 + wave);
        f32x4 v0[8], v1[8]; tr_load(j0, lane, v0); tr_load(j1, lane, v1);
        LAS float* scr = (LAS float*)(lds + wave * 16384);
        tr_write(scr, lane, v0); tr_store(j0, scr, lane);
        tr_write(scr, lane, v1); tr_store(j1, scr, lane);
      } }
}
#endif
#if defined(__HIP_DEVICE_COMPILE__)
typedef const __attribute__((address_space(4))) Args* ArgsP;
template <int PH, int REP = 0>
__device__ __forceinline__ void run_phase(ArgsP ap, LAS unsigned char* lds) {
    asm volatile("" : "+s"(ap));
    const Args a = *ap;
    int tid = threadIdx.x, bid = blockIdx.x, G = gridDim.x; asm volatile("" : "+v"(tid)); asm volatile("" : "+s"(bid), "+s"(G));
    const int lane = tid & 63, wave = __builtin_amdgcn_readfirstlane(tid >> 6);
    const int gw = bid * NWAVES + wave, NGW = G * NWAVES;
    unsigned char* ws = a.ws;
    bf16_t* XN = (bf16_t*)(ws + WS_XN); bf16_t* BIG = (bf16_t*)(ws + WS_BIG); bf16_t* XB2 = (bf16_t*)(ws + WS_QA); u64* rss = (u64*)(ws + WS_CTL + RSS_OFF);
    if constexpr (PH == 0) ph_prologue(a, lds, gw, NGW, lane, wave);
    else if constexpr (PH == NPH - 1) ph_final(XN, a.out, a.in[15], gw, NGW, lane);
    else {
        constexpr int l = (PH - 1) / 6, sp = (PH - 1) % 6; unsigned char* wl = ws + WS_W + (size_t)l * W_LAYER;
        bf16_t* R1 = (bf16_t*)a.out;
        u64* css = (u64*)(ws + WS_CTL + CSS_OFF) + (size_t)l * T * 2;
        if constexpr (sp == 0) { pg8::Gemm g{(l == 0) ? XN : R1, (const bf16_t*)(wl + W_IN), DM, DM}; pg8::StaticOrder S; S.init(T, INP, G, bid);
            pg8::EpiBf E{BIG, nullptr, INP, 0, rss + (2 * l) * T, 1, 1.f / 2048.f, css}; pg8::gemm_phase(lds, g, S, E, tid); }
        else if constexpr (sp == 1) {
            { pg8::Gemm g{BIG + PA_CQ, (const bf16_t*)(wl + W_UQ), INP, 512}; pg8::StaticOrder S; S.init(T, 768, G, bid);
              pg8::EpiBf E{(bf16_t*)(ws + WS_QA), nullptr, 768, 0, css, 2, 1.f / 512.f, nullptr}; pg8::gemm_phase(lds, g, S, E, tid); }
            { pg8::Gemm g{BIG + PA_CKV, (const bf16_t*)(wl + W_UKV), INP, 512}; pg8::StaticOrder S; S.init(T, 1024, G, bid);
              pg8::EpiBf E{(bf16_t*)(ws + WS_KA), (bf16_t*)(ws + WS_VA), 0, 1, css + 1, 2, 1.f / 512.f, nullptr}; pg8::gemm_phase(lds, g, S, E, tid); }
            ph_prep(a, l, gw, NGW, lane);
        }
        else if constexpr (sp == 2) ph_attention(ap, l, lds, REP);
        else if constexpr (sp == 3) { pg8::Gemm g{XN, (const bf16_t*)(wl + W_OUT), DM, DM}; pg8::StaticOrder S; S.init(T, DM, G, bid);
            pg8::EpiRes E{(l == 0) ? a.in[0] : nullptr, (l == 0) ? nullptr : R1, nullptr, XB2, DM, rss + (2 * l + 1) * T, (const u64*)(ws + WS_CTL + YSS_OFF) + (size_t)l * T * 4}; pg8::gemm_phase(lds, g, S, E, tid); }
        else if constexpr (sp == 4) { pg8::Gemm g{XB2, (const bf16_t*)(wl + W_GU), DM, DM}; pg8::StaticOrder S; S.init(T, 2 * DFF, G, bid);
            pg8::EpiBf E{BIG, nullptr, DFF, 2, rss + (2 * l + 1) * T, 1, 1.f / 2048.f, nullptr}; pg8::gemm_phase(lds, g, S, E, tid); }
        else { pg8::Gemm g{BIG, (const bf16_t*)(wl + W_DN), DFF, DFF}; pg8::StaticOrder S; S.init(T, DM, G, bid);
            pg8::EpiRes E{nullptr, XB2, nullptr, (l == 0) ? R1 : XN, DM, (l == 0) ? rss + 2 * T : nullptr, nullptr}; pg8::gemm_phase(lds, g, S, E, tid); }
    }
}

#endif
__global__ void __launch_bounds__(NWAVES * 64, 2) mega_fwd(Args a_unused) {
#if defined(__HIP_DEVICE_COMPILE__)
    extern __shared__ __attribute__((aligned(16))) unsigned char lds_raw[];
    LAS unsigned char* lds = (LAS unsigned char*)lds_raw;
    ArgsP ap = (ArgsP)__builtin_amdgcn_kernarg_segment_ptr();
    const int ph_lo = ap->ph_lo, ph_hi = ap->ph_hi;
    XcdBarrier xbar; xbar.bar = (unsigned*)(ap->ws + WS_CTL) + 4096; xbar.x = 0; xbar.st = (volatile LAS unsigned*)(lds + LDS_SLOT + 16);
    if (ph_hi - ph_lo > 1) {
        if (threadIdx.x < 2) xbar.st[threadIdx.x] = 0u;
        __syncthreads();
        xbar = xcd_barrier_post(xbar.bar, xbar.st);
    }
#define GRID_BAR() do { xcd_barrier(xbar); } while (0)
#define RUN_AGAIN(PH) do { if (ph_lo <= (PH) && (PH) + 1 < ph_hi) { run_phase<PH, 1>(ap, lds); GRID_BAR(); } } while (0)
#define RUN_PHASE(PH) do { if (ph_lo <= (PH) && (PH) < ph_hi) { run_phase<PH>(ap, lds); if ((PH) + 1 < ph_hi) { if ((PH) == 0) { __syncthreads(); cg::this_grid().sync(); } else GRID_BAR(); } } } while (0)
#define PA(PH) do { if (PROBE_ATT) RUN_AGAIN(PH); } while (0)
#define PG(PH) do { if (PROBE_GEMM) RUN_AGAIN(PH); } while (0)
#define PE(PH) do { if (PROBE_ELEM) RUN_AGAIN(PH); } while (0)
    RUN_PHASE(0); PE(0); RUN_PHASE(1); RUN_PHASE(2); RUN_PHASE(3); PA(3); RUN_PHASE(4); RUN_PHASE(5); PG(5); RUN_PHASE(6);
    RUN_PHASE(7); RUN_PHASE(8); RUN_PHASE(9); PA(9); RUN_PHASE(10); RUN_PHASE(11); PG(11); RUN_PHASE(12); RUN_PHASE(13);
#undef RUN_PHASE
#endif
}

extern "C" void kernel_launch(void* const* d_in, const int* in_sizes, int n_in, void* d_out, int out_size, void* d_ws, size_t ws_size, hipStream_t stream) {
    static int grid = 0;
    if (grid == 0) {
        if (n_in != 16 || out_size != T * DM || ws_size < WS_END) { fprintf(stderr, "kernel_launch: unexpected shapes n_in %d out %d ws %zu (need %zu)\n", n_in, out_size, ws_size, (size_t)WS_END); grid = -1; return; }
        int dev = 0, cus = 0, per_cu = 0;
        hipGetDevice(&dev); hipDeviceGetAttribute(&cus, hipDeviceAttributeMultiprocessorCount, dev);
        if (hipFuncSetAttribute((const void*)mega_fwd, hipFuncAttributeMaxDynamicSharedMemorySize, LDS_BYTES) != hipSuccess) { fprintf(stderr, "kernel_launch: hipFuncSetAttribute failed\n"); grid = -1; return; }
        hipOccupancyMaxActiveBlocksPerMultiprocessor(&per_cu, (const void*)mega_fwd, NWAVES * 64, LDS_BYTES);
        (void)hipGetLastError();
        if (per_cu < 1) per_cu = 1;
        grid = cus * 1;
    }
    if (grid < 0) return;
    hipMemsetAsync((char*)d_ws + WS_CTL, 0, 32768, stream);
    Args a{};
    for (int i = 0; i < 16; ++i) a.in[i] = (const float*)d_in[i];
    a.out = (float*)d_out; a.ws = (unsigned char*)d_ws;
#if MK_SINGLE
    a.ph_lo = 0; a.ph_hi = NPH;
    void* args[] = {&a};
    hipError_t e = hipLaunchCooperativeKernel((const void*)mega_fwd, dim3(grid), dim3(NWAVES * 64), args, LDS_BYTES, stream);
    if (e != hipSuccess) fprintf(stderr, "cooperative launch failed: %s (grid %d)\n", hipGetErrorString(e), grid);
#else
    for (int ph = 0; ph < NPH; ++ph) { a.ph_lo = ph; a.ph_hi = ph + 1;
        hipLaunchKernelGGL(mega_fwd, dim3(grid), dim3(NWAVES * 64), LDS_BYTES, stream, a); }
#endif
}
```

```cpp
#include <hip/hip_runtime.h>
#include <hip/hip_cooperative_groups.h>
#include <cstdio>
#include <cstdint>
namespace cg = cooperative_groups;

#ifndef PROBE_ATT
#define PROBE_ATT 0
#endif
#ifndef PROBE_GEMM
#define PROBE_GEMM 0
#endif
#ifndef PROBE_ELEM
#define PROBE_ELEM 0
#endif
#ifndef MK_SINGLE
#define MK_SINGLE 1
#endif

#define LAS __attribute__((address_space(3)))
typedef unsigned short bf16_t;
typedef short bf16x8 __attribute__((ext_vector_type(8)));
typedef short s16x4 __attribute__((ext_vector_type(4)));
typedef float f32x4 __attribute__((ext_vector_type(4)));
typedef float f32x2 __attribute__((ext_vector_type(2)));
typedef float f32x16 __attribute__((ext_vector_type(16)));
typedef unsigned u32x4 __attribute__((ext_vector_type(4)));
typedef unsigned u32x2 __attribute__((ext_vector_type(2)));
typedef unsigned long long u64;
constexpr float FXS = 1048576.f, FXI = 1.f / 1048576.f;
__device__ __forceinline__ void fx_add(u64* p, float v) { atomicAdd(p, (u64)(v * FXS + 0.5f)); }
__device__ __forceinline__ float fx_get(const u64* p) { return (float)(*p) * FXI; }

constexpr int NB = 4, SEQ = 4096, T = NB * SEQ, DM = 2048, INW = 4672, INP = 4864, DFF = 5632;
constexpr int NWAVES = 8;
constexpr int NPH = 14;
constexpr float EPS = 1e-6f;
constexpr int PA_CQ = 0, PA_CKV = 512, PA_KR = 1024, PB_Q = 1088, PB_K = 1856, PB_V = 2624, PC_Q = 3392, PC_K = 4160, PC_V = 4416;

constexpr size_t WS_CTL = 0, CTL_BYTES = 4u << 20;
constexpr size_t RSS_OFF = 512 * 1024;
constexpr size_t YSS_OFF = 1024 * 1024;
constexpr size_t CSS_OFF = 2048 * 1024;
constexpr size_t WS_ROPEA = WS_CTL + CTL_BYTES;
constexpr size_t WS_ROPE1 = WS_ROPEA + (size_t)4096 * 32 * 8;
constexpr size_t WS_W = WS_ROPE1 + (size_t)4096 * 64 * 8;
constexpr size_t W_IN = 0, W_UQ = W_IN + (size_t)INP * DM * 2, W_UKV = W_UQ + (size_t)768 * 512 * 2, W_OUT = W_UKV + (size_t)1024 * 512 * 2,
                 W_GU = W_OUT + (size_t)DM * DM * 2, W_DN = W_GU + (size_t)2 * DFF * DM * 2, W_LAYER = W_DN + (size_t)DM * DFF * 2;
constexpr size_t WS_XN = WS_W + 2 * W_LAYER;
constexpr size_t WS_BIG = WS_XN + (size_t)T * DM * 2;
constexpr size_t BIG_BYTES = (size_t)T * DFF * 2;
constexpr size_t WS_QA = WS_BIG + BIG_BYTES;
constexpr size_t WS_KA = WS_QA + (size_t)T * 768 * 2;
constexpr size_t WS_VA = WS_KA + (size_t)T * 768 * 2;
constexpr size_t WS_END = WS_VA + (size_t)T * 512 * 2;
static_assert((size_t)T * INP * 2 <= BIG_BYTES, "PROJ fits under FF");
static_assert(WS_END <= (size_t)536870912, "workspace map fits 512 MiB");

constexpr int LDS_SLOT = 139264;
constexpr int LDS_BYTES = LDS_SLOT + 256;

__device__ __forceinline__ unsigned cvt_pk_bf16(float lo, float hi) { unsigned r; asm volatile("v_cvt_pk_bf16_f32 %0, %1, %2" : "=v"(r) : "v"(lo), "v"(hi)); return r; }
__device__ __forceinline__ float bf2f(unsigned short b) { return __uint_as_float(((unsigned)b) << 16); }
__device__ __forceinline__ float bflo(unsigned w) { return __uint_as_float(w << 16); }
__device__ __forceinline__ float bfhi(unsigned w) { return __uint_as_float(w & 0xffff0000u); }
__device__ __forceinline__ unsigned short f2bf(float f) { return (unsigned short)(cvt_pk_bf16(f, f) & 0xffffu); }
__device__ __forceinline__ float wave_sum(float v, const int lane) {
#pragma unroll
    for (int o = 1; o < 64; o <<= 1) v += __builtin_bit_cast(float, __builtin_amdgcn_ds_bpermute((lane ^ o) << 2, __builtin_bit_cast(int, v)));
    return v;
}


#define XB_TMO      128
#define XB_XCNT(j)  (256  + 64 * (j))
#define XB_XSUB(j)  (1280 + 64 * (j))
#define XB_XGEN(j)  (2304 + 64 * (j))
#define XB_TOP      3328
#define XB_TOPGEN   3392
#define XCD_BAR_WORDS 3456
#define XB_SPIN_CAP (1u << 18)
__device__ __forceinline__ unsigned xb_ld(unsigned* p)              { return __hip_atomic_load(p, __ATOMIC_RELAXED, __HIP_MEMORY_SCOPE_AGENT); }
__device__ __forceinline__ unsigned xb_add(unsigned* p, unsigned v) { return __hip_atomic_fetch_add(p, v, __ATOMIC_RELAXED, __HIP_MEMORY_SCOPE_AGENT); }
__device__ __forceinline__ unsigned xb_xcc_id() { return (unsigned)__builtin_amdgcn_s_getreg((3 << 11) | 20) & 0xFu; }
#define XB_SPIN(cond, bar) do { unsigned _sp = 0; while (cond) { __builtin_amdgcn_s_sleep(1); \
    if ((++_sp & 255u) == 0u) { if (xb_ld(&(bar)[XB_TMO])) break; if (_sp > XB_SPIN_CAP) { atomicAdd(&(bar)[XB_TMO], 1u); break; } } } } while (0)
struct XcdBarrier { unsigned* bar; unsigned x; volatile LAS unsigned* st; };
__device__ __forceinline__ XcdBarrier xcd_barrier_post(unsigned* bar, volatile LAS unsigned* st) {
    XcdBarrier b; b.bar = bar; b.x = xb_xcc_id(); b.st = st;
    if (threadIdx.x == 0) (void)xb_add(&bar[XB_XCNT(b.x)], 1u);
    return b;
}
__device__ __forceinline__ void xcd_barrier_complete(unsigned* bar, unsigned x, unsigned& nloc, unsigned& nx) {
    const unsigned G = gridDim.x * gridDim.y * gridDim.z;
    unsigned sum, cnt, mine, sp = 0u;
    for (;;) {
        sum = 0u; cnt = 0u; mine = 0u;
#pragma unroll
        for (unsigned j = 0; j < 16; ++j) { const unsigned c = xb_ld(&bar[XB_XCNT(j)]); sum += c; cnt += (c > 0u) ? 1u : 0u; mine = (j == x) ? c : mine; }
        if (sum == G) break;
        __builtin_amdgcn_s_sleep(1);
        if ((++sp & 255u) == 0u) { if (xb_ld(&bar[XB_TMO])) break; if (sp > XB_SPIN_CAP) { atomicAdd(&bar[XB_TMO], 1u); break; } }
    }
    nloc = mine > 0u ? mine : 1u; nx = cnt > 0u ? cnt : 1u;
}
__device__ __forceinline__ void xcd_barrier(const XcdBarrier& b) {
    asm volatile("s_waitcnt vmcnt(0)" ::: "memory");
    __syncthreads();
    if (threadIdx.x == 0) {
        unsigned* bar = b.bar;
        __builtin_amdgcn_s_waitcnt(0);
        unsigned nloc = b.st[0], nx = b.st[1];
        if (nloc == 0u) { xcd_barrier_complete(bar, b.x, nloc, nx); b.st[0] = nloc; b.st[1] = nx; }
        const unsigned old = xb_add(&bar[XB_XSUB(b.x)], 1u);
        const unsigned gen = old / nloc;
        if (old + 1u == (gen + 1u) * nloc) {
            __builtin_amdgcn_fence(__ATOMIC_RELEASE, "agent");
            asm volatile("s_waitcnt vmcnt(0)" ::: "memory");
            const unsigned og = xb_add(&bar[XB_TOP], 1u);
            const unsigned tg = og / nx;
            if (og + 1u == (tg + 1u) * nx) xb_add(&bar[XB_TOPGEN], 1u);
            else XB_SPIN(xb_ld(&bar[XB_TOPGEN]) == tg, bar);
            __builtin_amdgcn_fence(__ATOMIC_ACQUIRE, "agent");
            xb_add(&bar[XB_XGEN(b.x)], 1u);
            asm volatile("s_waitcnt vmcnt(0)" ::: "memory");
        } else {
            XB_SPIN(xb_ld(&bar[XB_XGEN(b.x)]) == gen, bar);
            __builtin_amdgcn_fence(__ATOMIC_ACQUIRE, "agent");
            asm volatile("s_waitcnt vmcnt(0)" ::: "memory");
        }
    }
    __syncthreads();
}

namespace pg8 {
constexpr int BM = 256, BK = 64, HALF = 128, HTB = HALF * BK * 2, STAGE_BYTES = 8 * HTB, NXCD = 8, WGM = 8;
__host__ __device__ __forceinline__ int lds_byte(int r, int c) { const int st = (r >> 4) * 2 + (c >> 5), rr = r & 15, cc = c & 31, ob = rr * 64 + cc * 2; return st * 1024 + (ob ^ (((ob >> 9) & 1) << 5)); }
__host__ __device__ __forceinline__ void stage_rc(int b, int& R, int& C) { const int st = b / 1024, sb = b % 1024, swz = sb ^ (((sb >> 9) & 1) << 5); R = (st >> 1) * 16 + swz / 64; C = (st & 1) * 32 + (swz % 64) / 2; }
__host__ __device__ __forceinline__ int perm32(int rho) { const int n = rho >> 4, i = rho & 15; return 8 * (i >> 2) + 4 * n + (i & 3); }

struct Unit { int pm, pn; };
struct Gemm { const bf16_t* A; const bf16_t* Bt; int lda, K; };

struct StaticOrder {
    int nM, nN, nwg, G, c;
    __device__ void init(int M, int N, int G_, int c_) { nM = M / BM; nN = N / BM; nwg = nM * nN; G = G_; c = c_; }
    __device__ bool next(int i, Unit& u) const {
        const long L = (long)i * G + c; if (L >= nwg) return false;
        int wgid = (int)L; { const int q = nwg / NXCD, r = nwg % NXCD, xcd = wgid % NXCD, off = wgid / NXCD; wgid = (xcd < r ? xcd * (q + 1) : r * (q + 1) + (xcd - r) * q) + off; }
        const int nig = WGM * nN, gid = wgid / nig, fm = gid * WGM, gsz = (nM - fm) < WGM ? (nM - fm) : WGM;
        u.pm = fm + ((wgid % nig) % gsz); u.pn = (wgid % nig) / gsz; return true;
    }
};

struct EpiRes {
    static constexpr bool KSCALE = true;
    static constexpr bool PERM = true;
    const float* base32; const bf16_t* base16; float* out32; bf16_t* out16; int ldc; u64* rss; const u64* yss;
    __device__ __forceinline__ void kscale(f32x4 (&acc)[2][2][4][2], const Unit& u, int t, int tid_) const {
        asm volatile("" : "+v"(tid_)); const int row0 = u.pm * BM + (__builtin_amdgcn_readfirstlane(tid_ >> 6) >> 2) * 64 + (tid_ & 15);
#pragma unroll
        for (int ai = 0; ai < 2; ++ai)
#pragma unroll
            for (int m = 0; m < 4; ++m) { const u64* yq = yss + (size_t)(row0 + ai * HALF + m * 16) * 4 + (t == 8 ? 0 : 1);
                const float wp = (t == 8) ? (1.f / 512.f) : (1.f / 768.f);
                const float vp = fx_get(yq) * wp + 1e-6f, vn = fx_get(yq + 1) * (1.f / 768.f) + 1e-6f;
                const float sc = __builtin_amdgcn_sqrtf(vn * __builtin_amdgcn_rcpf(vp));
#pragma unroll
                for (int bj = 0; bj < 2; ++bj)
#pragma unroll
                    for (int n = 0; n < 2; ++n) acc[ai][bj][m][n] *= sc;
                asm volatile("" ::: "memory"); }
    }
    __device__ __forceinline__ void operator()(const f32x4 (&acc)[2][2][4][2], const Unit& u, int tid_) const {
        asm volatile("" : "+v"(tid_)); const int lane = tid_ & 63, wid_ = __builtin_amdgcn_readfirstlane(tid_ >> 6), wr = wid_ >> 2, wc = wid_ & 3, fr = lane & 15, fq = lane >> 4;
        const int row0 = u.pm * BM + wr * 64 + fr, col0 = u.pn * BM + wc * 32 + 8 * fq;
#pragma unroll
        for (int ai = 0; ai < 2; ++ai)
#pragma unroll
            for (int m = 0; m < 4; ++m) { const size_t off = (size_t)(row0 + ai * HALF + m * 16) * ldc + col0; float ss = 0.f;
                const float rc = yss ? 1.0f / sqrtf(fx_get(yss + (size_t)(row0 + ai * HALF + m * 16) * 4 + 2) * (1.f / 768.f) + 1e-6f) : 1.0f;
#pragma unroll
                for (int bj = 0; bj < 2; ++bj) { f32x4 b0, b1;
                    if (base16) { const u32x4 w = *(const u32x4*)(base16 + off + bj * HALF); b0 = (f32x4){bflo(w.x), bfhi(w.x), bflo(w.y), bfhi(w.y)}; b1 = (f32x4){bflo(w.z), bfhi(w.z), bflo(w.w), bfhi(w.w)}; }
                    else { b0 = *(const f32x4*)(base32 + off + bj * HALF); b1 = *(const f32x4*)(base32 + off + bj * HALF + 4); }
                    const f32x4 v0 = b0 + acc[ai][bj][m][0] * rc, v1 = b1 + acc[ai][bj][m][1] * rc;
                    if (out16) { u32x4 w; w.x = cvt_pk_bf16(v0[0], v0[1]); w.y = cvt_pk_bf16(v0[2], v0[3]); w.z = cvt_pk_bf16(v1[0], v1[1]); w.w = cvt_pk_bf16(v1[2], v1[3]); *(u32x4*)(out16 + off + bj * HALF) = w; }
                    if (out32) { *(f32x4*)(out32 + off + bj * HALF) = v0; *(f32x4*)(out32 + off + bj * HALF + 4) = v1; }
                    ss += (v0[0] * v0[0] + v0[1] * v0[1]) + (v0[2] * v0[2] + v0[3] * v0[3]) + (v1[0] * v1[0] + v1[1] * v1[1]) + (v1[2] * v1[2] + v1[3] * v1[3]); }
                if (rss) {
                    ss += __builtin_bit_cast(float, __builtin_amdgcn_ds_bpermute((lane ^ 16) << 2, __builtin_bit_cast(int, ss)));
                    ss += __builtin_bit_cast(float, __builtin_amdgcn_ds_bpermute((lane ^ 32) << 2, __builtin_bit_cast(int, ss)));
                    if (fq == 0) fx_add(rss + row0 + ai * HALF + m * 16, ss); } }
    }
};
struct EpiBf {
    static constexpr bool KSCALE = false;
    static constexpr bool PERM = true;
    bf16_t* O; bf16_t* O2; int ldc; int mode; const u64* rss; int rstride; float invw; u64* css;
    __device__ __forceinline__ void operator()(const f32x4 (&acc)[2][2][4][2], const Unit& u, int tid_) const {
        asm volatile("" : "+v"(tid_)); const int lane = tid_ & 63, wid_ = __builtin_amdgcn_readfirstlane(tid_ >> 6), wr = wid_ >> 2, wc = wid_ & 3, fr = lane & 15, fq = lane >> 4;
        const int row0 = u.pm * BM + wr * 64 + fr, cw = wc * 32 + 8 * fq;
        if (mode == 2) {
#pragma unroll
            for (int ai = 0; ai < 2; ++ai)
#pragma unroll
                for (int m = 0; m < 4; ++m) { const int r = row0 + ai * HALF + m * 16; bf16_t* rowp = O + (size_t)r * ldc + u.pn * HALF + cw;
                    const float rs = 1.0f / sqrtf(fx_get(rss + (size_t)r * rstride) * invw + 1e-6f);
                    float v[8];
#pragma unroll
                    for (int n = 0; n < 2; ++n)
#pragma unroll
                        for (int j = 0; j < 4; ++j) { const float g = acc[ai][0][m][n][j] * rs, up = acc[ai][1][m][n][j] * rs;
                            const float e = __builtin_amdgcn_exp2f(-g * 1.4426950408889634f); v[n * 4 + j] = g * __builtin_amdgcn_rcpf(1.0f + e) * up; }
                    u32x4 w; w.x = cvt_pk_bf16(v[0], v[1]); w.y = cvt_pk_bf16(v[2], v[3]); w.z = cvt_pk_bf16(v[4], v[5]); w.w = cvt_pk_bf16(v[6], v[7]);
                    *(u32x4*)rowp = w; }
        } else {
#pragma unroll
            for (int ai = 0; ai < 2; ++ai)
#pragma unroll
                for (int m = 0; m < 4; ++m) { const size_t r = (size_t)(row0 + ai * HALF + m * 16);
                    const float rs = rss ? 1.0f / sqrtf(fx_get(rss + r * rstride) * invw + 1e-6f) : 1.0f; float ss = 0.f;
#pragma unroll
                    for (int bj = 0; bj < 2; ++bj) { const f32x4 v0 = acc[ai][bj][m][0] * rs, v1 = acc[ai][bj][m][1] * rs;
                        ss += (v0[0] * v0[0] + v0[1] * v0[1]) + (v0[2] * v0[2] + v0[3] * v0[3]) + (v1[0] * v1[0] + v1[1] * v1[1]) + (v1[2] * v1[2] + v1[3] * v1[3]);
                        u32x4 w; w.x = cvt_pk_bf16(v0[0], v0[1]); w.y = cvt_pk_bf16(v0[2], v0[3]); w.z = cvt_pk_bf16(v1[0], v1[1]); w.w = cvt_pk_bf16(v1[2], v1[3]);
                        bf16_t* p;
                        if (mode == 0) p = O + r * ldc + u.pn * BM + bj * HALF + cw;
                        else p = (bj == 0) ? (O + r * 768 + u.pn * 192 + cw) : (O2 + r * 512 + u.pn * 128 + cw);
                        *(u32x4*)p = w; }
                    if (css != nullptr && u.pn < 4) {
                        ss += __builtin_bit_cast(float, __builtin_amdgcn_ds_bpermute((lane ^ 16) << 2, __builtin_bit_cast(int, ss)));
                        ss += __builtin_bit_cast(float, __builtin_amdgcn_ds_bpermute((lane ^ 32) << 2, __builtin_bit_cast(int, ss)));
                        if (fq == 0) fx_add(css + r * 2 + (u.pn >> 1), ss); } }
        }
    }
};

template <class Epi, class Sched, bool ALIGN_EPI = true, bool SP2 = true>
__device__ __forceinline__ void gemm_phase(LAS unsigned char* lds, const Gemm g, const Sched& S, const Epi& E, const int tid) {
    const int wid = __builtin_amdgcn_readfirstlane(tid >> 6), lane = tid & 63, wr = wid >> 2, wc = wid & 3, fr = lane & 15, fq = lane >> 4;
    const int K = g.K, nt = K / BK, lda = g.lda;
    unsigned voffA[2], voffB[2];
#pragma unroll
    for (int i = 0; i < 2; ++i) { int R, C; stage_rc(tid * 16 + i * 8192, R, C); const int Rb = Epi::PERM ? ((R & ~31) + perm32(R & 31)) : R;
        voffA[i] = (unsigned)(R * lda + C) * 2u; voffB[i] = (unsigned)(Rb * K + C) * 2u; }
    const size_t kstep = (size_t)(BK * 2);
    const size_t hstepA = (size_t)HALF * lda * 2, hstepB = (size_t)HALF * K * 2;
    const size_t tstepA = 2 * hstepA, tstepB = 2 * hstepB;
    const unsigned ldsw = (unsigned)wid * 1024u;
    const int aoff = lds_byte(wr * 64 + fr, fq * 8), boff = lds_byte(wc * 32 + fr, fq * 8);
#define PG8_SA(b, h) (((b) * 2 + (h)) * HTB)
#define PG8_SB(b, h) ((4 + (b) * 2 + (h)) * HTB)
#define PG8_STAGE(bufoff, gbase, voff) do { _Pragma("unroll") for (int _i = 0; _i < 2; ++_i) \
        __builtin_amdgcn_global_load_lds((const unsigned*)((const char*)(gbase) + (voff)[_i]), (LAS unsigned*)(lds + (bufoff) + ldsw + _i * 8192), 16, 0, 0); } while (0)
#define PG8_LDA(dst, b, h) do { _Pragma("unroll") for (int m = 0; m < 4; ++m) _Pragma("unroll") for (int k = 0; k < 2; ++k) dst[m][k] = *(const LAS bf16x8*)(lds + PG8_SA(b, h) + aoff + m * 2048 + k * 1024); } while (0)
#define PG8_LDB(dst, b, h) do { _Pragma("unroll") for (int n = 0; n < 2; ++n) _Pragma("unroll") for (int k = 0; k < 2; ++k) dst[n][k] = *(const LAS bf16x8*)(lds + PG8_SB(b, h) + boff + n * 2048 + k * 1024); } while (0)
#define PG8_MMA(ai, bj, At, Bt) do { __builtin_amdgcn_s_setprio(1); _Pragma("unroll") for (int m = 0; m < 4; ++m) _Pragma("unroll") for (int n = 0; n < 2; ++n) _Pragma("unroll") for (int k = 0; k < 2; ++k) \
        acc[ai][bj][m][n] = __builtin_amdgcn_mfma_f32_16x16x32_bf16(Bt[n][k], At[m][k], acc[ai][bj][m][n], 0, 0, 0); __builtin_amdgcn_s_setprio(0); } while (0)
#define PG8_WAIT_V(n) asm volatile("s_waitcnt vmcnt(" #n ")" ::: "memory")
#define PG8_WAIT_L(n) asm volatile("s_waitcnt lgkmcnt(" #n ")" ::: "memory")
#define PG8_BAR __builtin_amdgcn_s_barrier()
#define PG8_SCHED __builtin_amdgcn_sched_barrier(0)
    Unit cur, nxt; int ui = 0;
    if (!S.next(0, cur)) return;
    f32x4 acc[2][2][4][2];
#pragma unroll
    for (int a = 0; a < 2; ++a)
#pragma unroll
        for (int b = 0; b < 2; ++b)
#pragma unroll
            for (int m = 0; m < 4; ++m)
#pragma unroll
                for (int n = 0; n < 2; ++n) acc[a][b][m][n] = (f32x4){0.f, 0.f, 0.f, 0.f};
    bf16x8 At[4][2], B0[2][2], B1[2][2];
    const char* cA = (const char*)g.A + (size_t)cur.pm * tstepA; const char* cB = (const char*)g.Bt + (size_t)cur.pn * tstepB;
    if constexpr (SP2) {
        PG8_STAGE(PG8_SB(0, 0), cB, voffB); PG8_STAGE(PG8_SB(0, 1), cB + hstepB, voffB); PG8_STAGE(PG8_SA(0, 0), cA, voffA); PG8_STAGE(PG8_SA(0, 1), cA + hstepA, voffA);
        if (wr == 1) PG8_BAR;
        PG8_WAIT_V(2); PG8_BAR;
        PG8_STAGE(PG8_SB(1, 0), cB + kstep, voffB); PG8_STAGE(PG8_SA(1, 0), cA + kstep, voffA); PG8_STAGE(PG8_SB(1, 1), cB + hstepB + kstep, voffB);
        PG8_WAIT_V(6); PG8_BAR;
    } else {
        PG8_STAGE(PG8_SB(0, 0), cB, voffB); PG8_STAGE(PG8_SA(0, 0), cA, voffA); PG8_STAGE(PG8_SB(0, 1), cB + hstepB, voffB); PG8_STAGE(PG8_SA(0, 1), cA + hstepA, voffA);
        if (wr == 1) PG8_BAR;
        PG8_WAIT_V(4); PG8_BAR;
        PG8_STAGE(PG8_SB(1, 0), cB + kstep, voffB); PG8_STAGE(PG8_SA(1, 0), cA + kstep, voffA); PG8_STAGE(PG8_SB(1, 1), cB + hstepB + kstep, voffB);
        PG8_WAIT_V(6); PG8_BAR;
    }
    for (;;) {
        const bool has_next = S.next(ui + 1, nxt);
        const char* nA = has_next ? (const char*)g.A + (size_t)nxt.pm * tstepA : cA; const char* nB = has_next ? (const char*)g.Bt + (size_t)nxt.pn * tstepB : cB;
        for (int t = 0; t < nt; t += 2) {
            const bool last = (t == nt - 2);
            const char* a1 = cA + (size_t)(t + 1) * kstep;
            const char* a2 = last ? nA : cA + (size_t)(t + 2) * kstep; const char* b2 = last ? nB : cB + (size_t)(t + 2) * kstep;
            const char* a3 = a2 + kstep; const char* b3 = b2 + kstep;
            if constexpr (Epi::KSCALE) { if (E.yss != nullptr && (t == 8 || t == 20)) E.kscale(acc, cur, t, tid); }
            if constexpr (SP2) {
            PG8_LDB(B0, 0, 0); PG8_LDB(B1, 0, 1); PG8_SCHED; PG8_LDA(At, 0, 0); PG8_STAGE(PG8_SA(1, 1), a1 + hstepA, voffA);
            PG8_WAIT_V(8); PG8_WAIT_L(0); PG8_BAR; PG8_MMA(0, 0, At, B0); PG8_MMA(0, 1, At, B1); PG8_BAR; PG8_SCHED;
            PG8_LDA(At, 0, 1); PG8_STAGE(PG8_SB(0, 0), b2, voffB); PG8_STAGE(PG8_SB(0, 1), b2 + hstepB, voffB); PG8_STAGE(PG8_SA(0, 0), a2, voffA);
            PG8_WAIT_V(8); PG8_WAIT_L(0); PG8_BAR; PG8_MMA(1, 0, At, B0); PG8_MMA(1, 1, At, B1); PG8_BAR; PG8_SCHED;
            PG8_LDB(B0, 1, 0); PG8_LDB(B1, 1, 1); PG8_SCHED; PG8_LDA(At, 1, 0); PG8_STAGE(PG8_SA(0, 1), a2 + hstepA, voffA);
            PG8_WAIT_V(8); PG8_WAIT_L(0); PG8_BAR; PG8_MMA(0, 0, At, B0); PG8_MMA(0, 1, At, B1); PG8_BAR; PG8_SCHED;
            PG8_LDA(At, 1, 1); PG8_STAGE(PG8_SB(1, 0), b3, voffB); PG8_STAGE(PG8_SB(1, 1), b3 + hstepB, voffB); PG8_STAGE(PG8_SA(1, 0), a3, voffA);
            PG8_WAIT_V(8); PG8_WAIT_L(0); PG8_BAR; PG8_MMA(1, 0, At, B0); PG8_MMA(1, 1, At, B1); PG8_BAR; PG8_SCHED;
            } else {
            PG8_LDB(B0, 0, 0); PG8_SCHED; PG8_LDA(At, 0, 0); PG8_STAGE(PG8_SA(1, 1), a1 + hstepA, voffA);
            PG8_WAIT_L(8); PG8_BAR; PG8_WAIT_L(0); PG8_MMA(0, 0, At, B0); PG8_BAR; PG8_SCHED;
            PG8_LDB(B1, 0, 1); PG8_STAGE(PG8_SB(0, 0), b2, voffB);
            PG8_BAR; PG8_WAIT_L(0); PG8_MMA(0, 1, At, B1); PG8_BAR;
            PG8_LDA(At, 0, 1); PG8_STAGE(PG8_SA(0, 0), a2, voffA);
            PG8_BAR; PG8_WAIT_L(0); PG8_MMA(1, 0, At, B0); PG8_BAR; PG8_SCHED;
            PG8_STAGE(PG8_SB(0, 1), b2 + hstepB, voffB);
            PG8_WAIT_V(6); PG8_BAR; PG8_MMA(1, 1, At, B1); PG8_BAR;
            PG8_LDB(B0, 1, 0); PG8_SCHED; PG8_LDA(At, 1, 0); PG8_STAGE(PG8_SA(0, 1), a2 + hstepA, voffA);
            PG8_WAIT_L(8); PG8_BAR; PG8_WAIT_L(0); PG8_MMA(0, 0, At, B0); PG8_BAR; PG8_SCHED;
            PG8_LDB(B1, 1, 1); PG8_STAGE(PG8_SB(1, 0), b3, voffB);
            PG8_BAR; PG8_WAIT_L(0); PG8_MMA(0, 1, At, B1); PG8_BAR;
            PG8_LDA(At, 1, 1); PG8_STAGE(PG8_SA(1, 0), a3, voffA);
            PG8_BAR; PG8_WAIT_L(0); PG8_MMA(1, 0, At, B0); PG8_BAR; PG8_SCHED;
            PG8_STAGE(PG8_SB(1, 1), b3 + hstepB, voffB);
            PG8_WAIT_V(6); PG8_BAR; PG8_MMA(1, 1, At, B1); PG8_BAR;
            }
        }
        if constexpr (ALIGN_EPI) { if (wr == 0) PG8_BAR; }
        E(acc, cur, tid);
        if (!has_next) break;
#pragma unroll
        for (int a = 0; a < 2; ++a)
#pragma unroll
            for (int b = 0; b < 2; ++b)
#pragma unroll
                for (int m = 0; m < 4; ++m)
#pragma unroll
                    for (int n = 0; n < 2; ++n) acc[a][b][m][n] = (f32x4){0.f, 0.f, 0.f, 0.f};
        cur = nxt; cA = nA; cB = nB; ++ui;
        if constexpr (ALIGN_EPI) { if (wr == 1) PG8_BAR; }
    }
    PG8_WAIT_V(0);
    if constexpr (!ALIGN_EPI) { if (wr == 0) PG8_BAR; }
    PG8_BAR;
#undef PG8_SA
#undef PG8_SB
#undef PG8_STAGE
#undef PG8_LDA
#undef PG8_LDB
#undef PG8_MMA
#undef PG8_WAIT_V
#undef PG8_WAIT_L
#undef PG8_BAR
#undef PG8_SCHED
}
}

namespace att {
constexpr int KVBLK = 64, QBLK = 32;
constexpr float THR = 8.f;
#define SBAR() __builtin_amdgcn_sched_barrier(0)
__device__ __forceinline__ int crow(int r, int hi) { return (r & 3) + 8 * (r >> 2) + 4 * hi; }
__device__ __forceinline__ float dbias(int d) {
    const int ad = d < 0 ? -d : d;
    const int c = (ad <= 64 ? 1 : 0) + ((((d & 3) == 0) && ad <= 256) ? 1 : 0) + ((((d & 15) == 0) && ad <= 1024) ? 1 : 0);
    return c == 0 ? -__builtin_inff() : (c == 1 ? 0.f : (c == 2 ? 1.f : 1.5849625007211562f));
}
template <bool MASK>
__device__ __forceinline__ void partialSM(f32x16& p0, f32x16& p1, float& m_reg, float& mn, float& alpha, const float C, const float thr, const int dbase, const int dwave) {
    if constexpr (MASK) {
        if ((dwave - 31 > 256 && dwave + 63 <= 1024) || (dwave + 63 < -256 && dwave - 31 >= -1024)) {
            const int tl = dbase & 15; const float ninf = -__builtin_inff();
#pragma unroll
            for (int r = 0; r < 8; ++r) { const bool hit = tl == ((16 - ((r & 3) + 8 * (r >> 2))) & 15);
                p0[r] = hit ? p0[r] * C : ninf; p0[r + 8] = hit ? p0[r + 8] * C : ninf; p1[r] = hit ? p1[r] * C : ninf; p1[r + 8] = hit ? p1[r + 8] * C : ninf; }
        } else {
#pragma unroll
            for (int r = 0; r < 16; ++r) { const int d = dbase + (r & 3) + 8 * (r >> 2); p0[r] = fmaf(p0[r], C, dbias(d)); p1[r] = fmaf(p1[r], C, dbias(d + 32)); }
        }
        float pmax = p0[0];
#pragma unroll
        for (int r = 1; r < 16; ++r) pmax = fmaxf(pmax, p0[r]);
#pragma unroll
        for (int r = 0; r < 16; ++r) pmax = fmaxf(pmax, p1[r]);
        { auto rr = __builtin_amdgcn_permlane32_swap(__float_as_uint(pmax), __float_as_uint(pmax), false, false);
          pmax = fmaxf(__uint_as_float(rr[0]), __uint_as_float(rr[1])); }
        if (__builtin_expect(__all(pmax - m_reg <= thr), 1)) { mn = m_reg; alpha = 1.f; }
        else { mn = fmaxf(m_reg, pmax); alpha = __builtin_amdgcn_exp2f(m_reg - mn); m_reg = mn; }
#pragma unroll
        for (int r = 0; r < 16; ++r) { p0[r] = p0[r] - mn; p1[r] = p1[r] - mn; }
#pragma unroll
        for (int r = 0; r < 16; ++r) p0[r] = __builtin_amdgcn_exp2f(p0[r]);
    } else {
        float pmax = p0[0];
#pragma unroll
        for (int r = 1; r < 16; ++r) pmax = fmaxf(pmax, p0[r]);
#pragma unroll
        for (int r = 0; r < 16; ++r) pmax = fmaxf(pmax, p1[r]);
        { auto rr = __builtin_amdgcn_permlane32_swap(__float_as_uint(pmax), __float_as_uint(pmax), false, false);
          pmax = fmaxf(__uint_as_float(rr[0]), __uint_as_float(rr[1])); }
        if (__builtin_expect(__all(pmax - m_reg <= thr), 1)) { mn = m_reg; alpha = 1.f; }
        else { mn = fmaxf(m_reg, pmax); alpha = __builtin_amdgcn_exp2f((m_reg - mn) * C); m_reg = mn; }
        const float mnC = -mn * C;
#pragma unroll
        for (int r = 0; r < 16; ++r) p0[r] = fmaf(p0[r], C, mnC);
#pragma unroll
        for (int r = 0; r < 16; ++r) p1[r] = fmaf(p1[r], C, mnC);
#pragma unroll
        for (int r = 0; r < 16; ++r) p0[r] = __builtin_amdgcn_exp2f(p0[r]);
    }
}
__device__ __forceinline__ void finishSM(f32x16& p0, f32x16& p1, float alpha, float& l_reg, bf16x8& pa0, bf16x8& pa1, bf16x8& pa2, bf16x8& pa3) {
#pragma unroll
    for (int r = 0; r < 16; ++r) p1[r] = __builtin_amdgcn_exp2f(p1[r]);
    float ps = 0;
#pragma unroll
    for (int r = 0; r < 16; ++r) ps += p0[r];
#pragma unroll
    for (int r = 0; r < 16; ++r) ps += p1[r];
    { auto rr = __builtin_amdgcn_permlane32_swap(__float_as_uint(ps), __float_as_uint(ps), false, false);
      ps = __uint_as_float(rr[0]) + __uint_as_float(rr[1]); }
    l_reg = l_reg * alpha + ps;
#define PK4(P, BASE, OUT) do { unsigned a0 = cvt_pk_bf16(P[BASE + 0], P[BASE + 1]), a1 = cvt_pk_bf16(P[BASE + 2], P[BASE + 3]);   \
    unsigned b0 = cvt_pk_bf16(P[BASE + 4], P[BASE + 5]), b1 = cvt_pk_bf16(P[BASE + 6], P[BASE + 7]);                              \
    auto r0 = __builtin_amdgcn_permlane32_swap(a0, b0, false, false); auto r1 = __builtin_amdgcn_permlane32_swap(a1, b1, false, false); \
    u32x4 w = {r0[0], r1[0], r0[1], r1[1]}; OUT = __builtin_bit_cast(bf16x8, w); } while (0)
    PK4(p0, 0, pa0); PK4(p0, 8, pa1); PK4(p1, 0, pa2); PK4(p1, 8, pa3);
#undef PK4
}
template <int DK>
__device__ __forceinline__ void qkt(f32x16& p0, f32x16& p1, const LAS char* Ks, const bf16x8* qr, const int (&kb)[4], int hi, const LAS char* lds0, unsigned qoff) {
    constexpr int RB = DK * 2;
    p0 = f32x16{}; p1 = f32x16{};
    if constexpr (DK == 128) {
#pragma unroll
        for (int d0 = 0; d0 < 8; ++d0) {
            const bf16x8 b0 = *(const LAS bf16x8*)(Ks + kb[d0 & 3] + (d0 >> 2) * 128);
            const bf16x8 b1 = *(const LAS bf16x8*)(Ks + kb[d0 & 3] + (d0 >> 2) * 128 + 32 * RB);
            p0 = __builtin_amdgcn_mfma_f32_32x32x16_bf16(b0, qr[d0], p0, 0, 0, 0);
            p1 = __builtin_amdgcn_mfma_f32_32x32x16_bf16(b1, qr[d0], p1, 0, 0, 0); }
    } else {
        asm volatile("" : "+v"(qoff));
        bf16x8 b0[2][2], b1[2][2], q[2][2];
#define QK_LD(g, s) do { _Pragma("unroll") for (int e = 0; e < 2; ++e) { const int d0 = 2 * (g) + e; \
            b0[s][e] = *(const LAS bf16x8*)(Ks + kb[d0 & 3] + (d0 >> 2) * 128); b1[s][e] = *(const LAS bf16x8*)(Ks + kb[d0 & 3] + (d0 >> 2) * 128 + 32 * RB); \
            if (d0 >= 6) q[s][e] = *(const LAS bf16x8*)(lds0 + qoff + (d0 - 6) * 1024); } } while (0)
#define QK_MM(g, s) do { _Pragma("unroll") for (int e = 0; e < 2; ++e) { const int d0 = 2 * (g) + e; \
            if (d0 >= 6) { p0 = __builtin_amdgcn_mfma_f32_32x32x16_bf16(b0[s][e], q[s][e], p0, 0, 0, 0); p1 = __builtin_amdgcn_mfma_f32_32x32x16_bf16(b1[s][e], q[s][e], p1, 0, 0, 0); } \
            else { p0 = __builtin_amdgcn_mfma_f32_32x32x16_bf16(b0[s][e], qr[d0], p0, 0, 0, 0); p1 = __builtin_amdgcn_mfma_f32_32x32x16_bf16(b1[s][e], qr[d0], p1, 0, 0, 0); } } } while (0)
        QK_LD(0, 0); SBAR();
        QK_LD(1, 1); SBAR(); QK_MM(0, 0); SBAR();
        QK_LD(2, 0); SBAR(); QK_MM(1, 1); SBAR();
        QK_LD(3, 1); SBAR(); QK_MM(2, 0); SBAR();
        QK_LD(4, 0); SBAR(); QK_MM(3, 1); SBAR();
        QK_LD(5, 1); SBAR(); QK_MM(4, 0); SBAR();
        QK_MM(5, 1); SBAR();
#undef QK_LD
#undef QK_MM
    }
}
__device__ __forceinline__ int v_st(int k, int c) { const int kk = (k & ~0xC) | ((k & 4) << 1) | ((k & 8) >> 1); return ((kk >> 3) * 4 + (c >> 5)) * 512 + ((kk & 7) * 32 + (c & 31)) * 2; }
__device__ __forceinline__ int v_rd_base(int lane) { return ((lane & 3) << 3) | (((lane >> 2) & 3) << 6) | (((lane >> 4) & 1) << 5) | (((lane >> 5) & 1) << 8); }
constexpr int v_rd_off(int d0, int ks, int half) { return d0 * 512 + ks * 4096 + half * 2048; }
template <int OFF> __device__ __forceinline__ s16x4 tr_read(int vb) {
    s16x4 r; asm volatile("ds_read_b64_tr_b16 %0, %1 offset:%2" : "=&v"(r) : "v"(vb), "i"(OFF) : "memory"); return r;
}
template <int D0> __device__ __forceinline__ void pv_one(f32x16& od, int vb, bf16x8 pa0, bf16x8 pa1, bf16x8 pa2, bf16x8 pa3) {
    const s16x4 l0 = tr_read<v_rd_off(D0, 0, 0)>(vb), h0 = tr_read<v_rd_off(D0, 0, 1)>(vb), l1 = tr_read<v_rd_off(D0, 1, 0)>(vb), h1 = tr_read<v_rd_off(D0, 1, 1)>(vb);
    const s16x4 l2 = tr_read<v_rd_off(D0, 2, 0)>(vb), h2 = tr_read<v_rd_off(D0, 2, 1)>(vb), l3 = tr_read<v_rd_off(D0, 3, 0)>(vb), h3 = tr_read<v_rd_off(D0, 3, 1)>(vb);
    asm volatile("s_waitcnt lgkmcnt(0)" ::: "memory"); SBAR();
#define PKV(L, H) (bf16x8){L[0], L[1], L[2], L[3], H[0], H[1], H[2], H[3]}
    od = __builtin_amdgcn_mfma_f32_32x32x16_bf16(pa0, PKV(l0, h0), od, 0, 0, 0);
    od = __builtin_amdgcn_mfma_f32_32x32x16_bf16(pa1, PKV(l1, h1), od, 0, 0, 0);
    od = __builtin_amdgcn_mfma_f32_32x32x16_bf16(pa2, PKV(l2, h2), od, 0, 0, 0);
    od = __builtin_amdgcn_mfma_f32_32x32x16_bf16(pa3, PKV(l3, h3), od, 0, 0, 0);
#undef PKV
}
__device__ __forceinline__ void pv_d0(f32x16* o, int vb, bf16x8 pa0, bf16x8 pa1, bf16x8 pa2, bf16x8 pa3) {
    pv_one<0>(o[0], vb, pa0, pa1, pa2, pa3); pv_one<1>(o[1], vb, pa0, pa1, pa2, pa3); pv_one<2>(o[2], vb, pa0, pa1, pa2, pa3); pv_one<3>(o[3], vb, pa0, pa1, pa2, pa3);
}

template <int DK, bool MASK, int SDEPTH>
__device__ __forceinline__ void attn_unit(const bf16_t* __restrict__ Qb, const int ldq, const bf16_t* __restrict__ Kh, const int ldk, const bf16_t* __restrict__ Vh, const int ldv,
                                          bf16_t* __restrict__ Ob, const int ldo, const int NT, const float scale, LAS char* lds, const f32x2* __restrict__ ropeA, const int qpos0, const int dq0, const int tid, u64* __restrict__ yss) {
    constexpr int RB = DK * 2, SHM_V = KVBLK * 128 * 2, SHM_K = KVBLK * RB;
    const int wid = tid >> 6, lane = tid & 63, r32 = lane & 31, hi = lane >> 5;
    LAS char* V_lds = lds; LAS char* K_lds = lds + 2 * SHM_V;
    const float C = scale * 1.4426950408889634f;
    const float thr = MASK ? THR * 1.4426950408889634f : THR / scale;
    float m_reg = -1e30f, l_reg = 0; f32x16 o[4] = {}; bf16x8 qr[(DK == 192) ? 6 : 8];
    const unsigned qoff = 2 * SHM_V + 2 * SHM_K + 2048 + wid * 6144 + lane * 16;
    int kb[4];
#pragma unroll
    for (int k = 0; k < 4; ++k) kb[k] = r32 * RB + ((hi ^ (r32 & 1)) << 4) + ((k ^ ((r32 & 7) >> 1)) << 5);
    int tq = tid; asm volatile("" : "+v"(tq));
    const bf16_t* Qw = Qb + (size_t)(unsigned)(((tq >> 6) * QBLK + (tq & 31)) * ldq + ((tq >> 5) & 1) * 8);
    constexpr int NQR = (DK == 192) ? 6 : 8;
#pragma unroll
    for (int d0 = 0; d0 < NQR; ++d0) qr[d0] = *(const bf16x8*)(Qw + d0 * 16);
    if constexpr (DK == 192) {
        *(LAS bf16x8*)(lds + qoff) = *(const bf16x8*)(Qw + 6 * 16); *(LAS bf16x8*)(lds + qoff + 1024) = *(const bf16x8*)(Qw + 7 * 16);
        const f32x2* rp = ropeA + (size_t)(unsigned)((qpos0 + (tq >> 6) * QBLK + (tq & 31)) * 32 + ((tq >> 5) & 1) * 8);
#pragma unroll
        for (int dd = 0; dd < 2; ++dd) {
            bf16x8 x1 = *(const bf16x8*)(Qw + (8 + dd) * 16), x2 = *(const bf16x8*)(Qw + (10 + dd) * 16);
#pragma unroll
            for (int e = 0; e < 8; ++e) { const f32x2 cs = rp[dd * 16 + e]; const float a = bf2f((unsigned short)x1[e]), b = bf2f((unsigned short)x2[e]);
                x1[e] = (short)f2bf(a * cs.x - b * cs.y); x2[e] = (short)f2bf(b * cs.x + a * cs.y); }
            *(LAS bf16x8*)(lds + qoff + (2 + dd) * 1024) = x1; *(LAS bf16x8*)(lds + qoff + (4 + dd) * 1024) = x2;
        }
        asm volatile("s_waitcnt lgkmcnt(0)" ::: "memory");
    }
    const int sr = tid >> 4, sc = (tid & 15) * 8, vst0 = v_st(sr, sc); constexpr int vst1d = 8192;
    const int kst0 = sr * RB + ((sc * 2) ^ ((sr & 7) << 4));
    const int kr2 = tid >> 3, kc2 = 128 + (tid & 7) * 8, kst2 = kr2 * RB + ((kc2 * 2) ^ ((kr2 & 7) << 4));
    const int vb0 = (int)(uintptr_t)V_lds + v_rd_base(lane);
    bf16x8 vs0[SDEPTH], vs1[SDEPTH], ks0[SDEPTH], ks1[SDEPTH], ks2[SDEPTH];
    const unsigned voV0 = (unsigned)(sr * ldv + sc) * 2u, voK0 = (unsigned)(sr * ldk + sc) * 2u, voK2 = (unsigned)(kr2 * ldk + kc2) * 2u;
#define SLOAD(i, k0) do { const char* Vt = (const char*)Vh + (size_t)(k0) * (size_t)(ldv * 2); const char* Kt = (const char*)Kh + (size_t)(k0) * (size_t)(ldk * 2); \
    vs0[i] = *(const bf16x8*)(Vt + (size_t)voV0); vs1[i] = *(const bf16x8*)(Vt + (size_t)(ldv * 64) + (size_t)voV0); \
    ks0[i] = *(const bf16x8*)(Kt + (size_t)voK0); ks1[i] = *(const bf16x8*)(Kt + (size_t)(ldk * 64) + (size_t)voK0); \
    if constexpr (DK == 192) ks2[i] = *(const bf16x8*)(Kt + (size_t)voK2); } while (0)
#define SWRITE(b, i) do { *(LAS bf16x8*)(V_lds + (b) * SHM_V + vst0) = vs0[i]; *(LAS bf16x8*)(V_lds + (b) * SHM_V + vst1d + vst0) = vs1[i]; \
    *(LAS bf16x8*)(K_lds + (b) * SHM_K + kst0) = ks0[i]; *(LAS bf16x8*)(K_lds + (b) * SHM_K + 32 * RB + kst0) = ks1[i]; \
    if constexpr (DK == 192) *(LAS bf16x8*)(K_lds + (b) * SHM_K + kst2) = ks2[i]; } while (0)
#define SWAIT() do { if constexpr (SDEPTH == 2) { if constexpr (DK == 192) asm volatile("s_waitcnt vmcnt(5)" ::: "memory"); else asm volatile("s_waitcnt vmcnt(4)" ::: "memory"); } \
    else asm volatile("s_waitcnt vmcnt(0)" ::: "memory"); } while (0)
#define RESC(a) do { if (__any((a) < 1.f)) { int t3 = tid; asm volatile("" : "+v"(t3)); LAS float* al3 = (LAS float*)(lds + 2 * SHM_V + 2 * SHM_K) + (t3 >> 6) * 64 + 32; \
    if (((t3 >> 5) & 1) == 0) al3[t3 & 31] = (a); asm volatile("s_waitcnt lgkmcnt(0)" ::: "memory"); const LAS float* ar3 = al3 + 4 * ((t3 >> 5) & 1); \
    _Pragma("unroll") for (int d = 0; d < 4; ++d) _Pragma("unroll") for (int r = 0; r < 16; ++r) o[d][r] *= ar3[(r & 3) + 8 * (r >> 2)]; } } while (0)
    f32x16 pA0, pA1, pB0, pB1; float mnA, mnB, alA, alB; bf16x8 pa0, pa1, pa2, pa3;
    const int dw0 = dq0 - __builtin_amdgcn_readfirstlane(wid) * QBLK;
    const int db0 = dq0 + 4 * hi - (wid * QBLK + r32);
    constexpr int SE = 0, SO = SDEPTH - 1;
    SLOAD(SE, 0); asm volatile("s_waitcnt vmcnt(0)" ::: "memory"); SWRITE(0, SE); __syncthreads();
    qkt<DK>(pA0, pA1, K_lds, qr, kb, hi, lds, qoff); partialSM<MASK>(pA0, pA1, m_reg, mnA, alA, C, thr, db0, dw0);
    SLOAD(SO, KVBLK); if constexpr (SDEPTH == 2) { if (2 < NT) SLOAD(SE, 2 * KVBLK); }
    SWAIT(); SWRITE(1, SO); __syncthreads();
    for (int j = 1; j + 1 < NT; j += 2) {
        SBAR(); qkt<DK>(pB0, pB1, K_lds + SHM_K, qr, kb, hi, lds, qoff);
        finishSM(pA0, pA1, alA, l_reg, pa0, pa1, pa2, pa3); SBAR();
        SLOAD(SO, (j + SDEPTH) * KVBLK); SBAR();
        pv_d0(o, vb0, pa0, pa1, pa2, pa3); partialSM<MASK>(pB0, pB1, m_reg, mnB, alB, C, thr, db0 + j * KVBLK, dw0 + j * KVBLK);
        __syncthreads(); SWAIT(); SWRITE(0, SE);
        RESC(alB); __syncthreads();
        SBAR(); qkt<DK>(pA0, pA1, K_lds, qr, kb, hi, lds, qoff);
        finishSM(pB0, pB1, alB, l_reg, pa0, pa1, pa2, pa3); SBAR();
        if (SDEPTH == 1 || j + 3 < NT) SLOAD(SE, (j + 1 + SDEPTH) * KVBLK); SBAR();
        pv_d0(o, vb0 + SHM_V, pa0, pa1, pa2, pa3); partialSM<MASK>(pA0, pA1, m_reg, mnA, alA, C, thr, db0 + (j + 1) * KVBLK, dw0 + (j + 1) * KVBLK);
        __syncthreads(); SWAIT(); SWRITE(1, SO);
        RESC(alA); __syncthreads();
    }
    SBAR(); qkt<DK>(pB0, pB1, K_lds + SHM_K, qr, kb, hi, lds, qoff);
    finishSM(pA0, pA1, alA, l_reg, pa0, pa1, pa2, pa3); SBAR();
    pv_d0(o, vb0, pa0, pa1, pa2, pa3); partialSM<MASK>(pB0, pB1, m_reg, mnB, alB, C, thr, db0 + (NT - 1) * KVBLK, dw0 + (NT - 1) * KVBLK);
    __syncthreads(); RESC(alB);
    finishSM(pB0, pB1, alB, l_reg, pa0, pa1, pa2, pa3); SBAR();
    pv_d0(o, vb0 + SHM_V, pa0, pa1, pa2, pa3);
    int to = tid; asm volatile("" : "+v"(to));
    { LAS float* li3 = (LAS float*)(lds + 2 * SHM_V + 2 * SHM_K) + (to >> 6) * 64;
      if (((to >> 5) & 1) == 0) li3[to & 31] = l_reg; asm volatile("s_waitcnt lgkmcnt(0)" ::: "memory"); }
    float rli[16];
    { const LAS float* lr3 = (const LAS float*)(lds + 2 * SHM_V + 2 * SHM_K) + (to >> 6) * 64 + 4 * ((to >> 5) & 1);
#pragma unroll
      for (int r = 0; r < 16; ++r) rli[r] = __builtin_amdgcn_rcpf(lr3[(r & 3) + 8 * (r >> 2)]); }
    const unsigned ooff = (unsigned)((((to >> 6) * QBLK + 4 * ((to >> 5) & 1)) * ldo + (to & 31)) * 2);
    float sq[16];
#pragma unroll
    for (int r = 0; r < 16; ++r) { sq[r] = 0.f;
#pragma unroll
        for (int d0 = 0; d0 < 4; ++d0) { const float v = o[d0][r] * rli[r]; sq[r] += v * v;
            *(bf16_t*)((char*)Ob + (size_t)(ooff + (unsigned)((((r & 3) + 8 * (r >> 2)) * ldo + d0 * 32) * 2))) = f2bf(v); } }
#pragma unroll
    for (int r = 0; r < 16; ++r) {
#pragma unroll
        for (int x = 1; x < 32; x <<= 1) sq[r] += __builtin_bit_cast(float, __builtin_amdgcn_ds_bpermute(((to & 63) ^ x) << 2, __builtin_bit_cast(int, sq[r])));
        if ((to & 31) == r) fx_add(yss + (size_t)((to >> 6) * QBLK + 4 * ((to >> 5) & 1) + (r & 3) + 8 * (r >> 2)) * 4, sq[r]); }
#undef SLOAD
#undef SWRITE
#undef SWAIT
#undef RESC
}
}

struct TrJob { const float* W; bf16_t* WT; const float* gain; int N, Kd, mode, item; };
__device__ __forceinline__ void tr_load(const TrJob& j, int lane, f32x4 (&v)[8]) {
    const int nblk = j.N / 32, kb = j.item / nblk, nb = j.item % nblk, k0 = 64 * kb, n0 = 32 * nb;
    const float* p = j.W + (size_t)(k0 + (lane >> 3)) * j.N + n0 + 4 * (lane & 7);
#pragma unroll
    for (int i = 0; i < 8; ++i) v[i] = *(const f32x4*)(p + (size_t)(8 * i) * j.N);
}
__device__ __forceinline__ void tr_write(LAS float* scr, int lane, const f32x4 (&v)[8]) {
#pragma unroll
    for (int i = 0; i < 8; ++i) { LAS float* d = scr + (8 * i + (lane >> 3)) * 33 + 4 * (lane & 7); d[0] = v[i].x; d[1] = v[i].y; d[2] = v[i].z; d[3] = v[i].w; }
}
__device__ __forceinline__ void tr_store(const TrJob& j, LAS float* scr, int lane) {
    const int nblk = j.N / 32, kb = j.item / nblk, nb = j.item % nblk, k0 = 64 * kb, n0 = 32 * nb;
    const int rb = (j.mode == 0) ? n0 : (256 * (n0 >> 7) + (n0 & 127) + (j.mode == 2 ? 128 : 0));
    const int c = lane & 7;
    f32x4 g0 = {1.f, 1.f, 1.f, 1.f}, g1 = g0;
    if (j.gain) { g0 = *(const f32x4*)(j.gain + k0 + 8 * c); g1 = *(const f32x4*)(j.gain + k0 + 8 * c + 4); }
    asm volatile("s_waitcnt lgkmcnt(0)" ::: "memory");
#pragma unroll
    for (int jj = 0; jj < 4; ++jj) { const int n = (lane >> 3) + 8 * jj; const LAS float* s = scr + (8 * c) * 33 + n;
        u32x4 o; o.x = cvt_pk_bf16(s[0 * 33] * g0.x, s[1 * 33] * g0.y); o.y = cvt_pk_bf16(s[2 * 33] * g0.z, s[3 * 33] * g0.w);
        o.z = cvt_pk_bf16(s[4 * 33] * g1.x, s[5 * 33] * g1.y); o.w = cvt_pk_bf16(s[6 * 33] * g1.z, s[7 * 33] * g1.w);
        *(u32x4*)(j.WT + (size_t)(rb + n) * j.Kd + k0 + 8 * c) = o; }
    asm volatile("s_waitcnt lgkmcnt(0)" ::: "memory");
}

struct Args { const float* in[16]; float* out; unsigned char* ws; int ph_lo, ph_hi; };

constexpr int I_IN = 32 * 146, I_UQ = 8 * 24, I_UKV = 8 * 32, I_OUT = 32 * 64, I_G = 32 * 176, I_DN = 88 * 64;
constexpr int I_LAYER = I_IN + I_UQ + I_UKV + I_OUT + 2 * I_G + I_DN;
constexpr int TR_P0 = I_IN + I_UQ + I_UKV, TR_P1 = I_LAYER + I_IN + I_UQ + I_UKV;
static_assert((TR_P1 - TR_P0) % 16 == 0 && (2 * I_LAYER - TR_P1) % 16 == 0, "filler ranges are whole queue entries");
template <class ArgsT>
__device__ __forceinline__ TrJob tr_job(const ArgsT& a, unsigned char* ws, int it) {
    const int l = it / I_LAYER; int r = it % I_LAYER; unsigned char* wl = ws + WS_W + (size_t)l * W_LAYER;
    const float* W; bf16_t* WT; const float* gain; int N, Kd, mode = 0;
    const float *p1 = a.in[1], *p2 = a.in[2], *p3 = a.in[3], *p4 = a.in[4], *p5 = a.in[5], *p6 = a.in[6], *p9 = a.in[9], *p10 = a.in[10], *p11 = a.in[11], *p12 = a.in[12], *p13 = a.in[13], *p14 = a.in[14];
    asm volatile("" : "+s"(p1), "+s"(p2), "+s"(p3), "+s"(p4), "+s"(p5), "+s"(p6)); asm volatile("" : "+s"(p9), "+s"(p10), "+s"(p11), "+s"(p12), "+s"(p13), "+s"(p14));
    if (r < I_IN) { W = p2 + (size_t)l * DM * INW; WT = (bf16_t*)(wl + W_IN); gain = p1 + l * DM; N = INW; Kd = DM; }
    else if ((r -= I_IN) < I_UQ) { W = p4 + (size_t)l * 512 * 768; WT = (bf16_t*)(wl + W_UQ); gain = p3 + l * 512; N = 768; Kd = 512; }
    else if ((r -= I_UQ) < I_UKV) { W = p6 + (size_t)l * 512 * 1024; WT = (bf16_t*)(wl + W_UKV); gain = p5 + l * 512; N = 1024; Kd = 512; }
    else if ((r -= I_UKV) < I_OUT) { W = p10 + (size_t)l * DM * DM; WT = (bf16_t*)(wl + W_OUT); gain = p9 + l * DM; N = DM; Kd = DM; }
    else if ((r -= I_OUT) < I_G) { W = p12 + (size_t)l * DM * DFF; WT = (bf16_t*)(wl + W_GU); gain = p11 + l * DM; N = DFF; Kd = DM; mode = 1; }
    else if ((r -= I_G) < I_G) { W = p13 + (size_t)l * DM * DFF; WT = (bf16_t*)(wl + W_GU); gain = p11 + l * DM; N = DFF; Kd = DM; mode = 2; }
    else { r -= I_G; W = p14 + (size_t)l * DFF * DM; WT = (bf16_t*)(wl + W_DN); gain = nullptr; N = DM; Kd = DFF; }
    TrJob j; j.W = W; j.WT = WT; j.gain = gain; j.N = N; j.Kd = Kd; j.mode = mode; j.item = r; return j;
}
__device__ __forceinline__ void ph_prologue(const Args& a, LAS unsigned char* lds, int gw, int NGW, int lane, int wave) {
    LAS float* scr = (LAS float*)(lds + wave * 16384);
    unsigned char* ws = a.ws;
    { f32x4 v[8]; int it = gw; TrJob cur = tr_job(a, ws, it < TR_P0 ? it : 0);
      if (it < TR_P0) tr_load(cur, lane, v);
      while (it < TR_P0) {
          const int nit = it + NGW;
          tr_write(scr, lane, v);
          TrJob nxt = cur;
          if (nit < TR_P0) { nxt = tr_job(a, ws, nit); tr_load(nxt, lane, v); }
          tr_store(cur, scr, lane);
          cur = nxt; it = nit;
      } }
    const int gt = gw * 64 + lane, NGT = NGW * 64;
    for (int l = 0; l < 2; ++l) { u32x4* z = (u32x4*)(ws + WS_W + (size_t)l * W_LAYER + W_IN + (size_t)INW * DM * 2);
        for (int i = gt; i < (INP - INW) * DM * 2 / 16; i += NGT) z[i] = (u32x4){0u, 0u, 0u, 0u}; }
    { u64* rss = (u64*)(ws + WS_CTL + RSS_OFF); bf16_t* XB = (bf16_t*)(ws + WS_XN);
      for (int i = gt; i < 3 * T; i += NGT) rss[T + i] = 0ull;
      { u64* yz = (u64*)(ws + WS_CTL + YSS_OFF); for (int i = gt; i < 2 * T * 4; i += NGT) yz[i] = 0ull; }
      { u64* cz = (u64*)(ws + WS_CTL + CSS_OFF); for (int i = gt; i < 2 * T * 2; i += NGT) cz[i] = 0ull; }
      for (int m = gw; m < T; m += NGW) {
          const f32x4* xr = (const f32x4*)(a.in[0] + (size_t)m * DM) + lane; u32x2* o = (u32x2*)(XB + (size_t)m * DM) + lane; float sq = 0.f;
#pragma unroll
          for (int j = 0; j < 8; ++j) { const f32x4 v = xr[64 * j]; sq += (v.x * v.x + v.y * v.y) + (v.z * v.z + v.w * v.w);
              u32x2 w; w.x = cvt_pk_bf16(v.x, v.y); w.y = cvt_pk_bf16(v.z, v.w); o[64 * j] = w; }
          sq = wave_sum(sq, lane); if (lane == 0) rss[m] = (u64)(sq * FXS + 0.5f); } }
    f32x2* ra = (f32x2*)(ws + WS_ROPEA); f32x2* r1 = (f32x2*)(ws + WS_ROPE1);
    for (int i = gt; i < 4096 * 32 + 4096 * 64; i += NGT) {
        int pos, fi; float inv; f32x2* dst;
        if (i < 4096 * 32) { pos = i >> 5; fi = i & 31; inv = __builtin_amdgcn_exp2f(-(float)(2 * fi) * (13.287712379549449f / 64.f)); dst = ra + i; }
        else { const int j = i - 4096 * 32; pos = j >> 6; fi = j & 63; inv = __builtin_amdgcn_exp2f(-(float)(2 * fi) * (13.287712379549449f / 128.f)); dst = r1 + j; }
        const float ang = (float)pos * inv;
        const double rev = (double)ang * 0.15915494309189535; const float fr = (float)(rev - __builtin_rint(rev));
        *dst = (f32x2){__builtin_amdgcn_cosf(fr), __builtin_amdgcn_sinf(fr)};
    }
}

__device__ __forceinline__ void ph_norm_bf16(const float* x, const float* g, bf16_t* out, int gw, int NGW, int lane) {
    for (int m = gw; m < T; m += NGW) {
        const f32x4* xr = (const f32x4*)(x + (size_t)m * DM) + lane; f32x4 v[8]; float s = 0.f;
#pragma unroll
        for (int j = 0; j < 8; ++j) { v[j] = xr[64 * j]; s += (v[j].x * v[j].x + v[j].y * v[j].y) + (v[j].z * v[j].z + v[j].w * v[j].w); }
        const float rs = 1.0f / sqrtf(wave_sum(s, lane) * (1.f / DM) + EPS);
        u32x2* o = (u32x2*)(out + (size_t)m * DM) + lane;
#pragma unroll
        for (int j = 0; j < 8; ++j) { const f32x4 gg = ((const f32x4*)g)[lane + 64 * j]; u32x2 w; w.x = cvt_pk_bf16(v[j].x * rs * gg.x, v[j].y * rs * gg.y); w.y = cvt_pk_bf16(v[j].z * rs * gg.z, v[j].w * rs * gg.w); o[64 * j] = w; }
    }
}
__device__ __forceinline__ void unpack8(const u32x4 w, float (&x)[8]) { x[0] = bflo(w.x); x[1] = bfhi(w.x); x[2] = bflo(w.y); x[3] = bfhi(w.y); x[4] = bflo(w.z); x[5] = bfhi(w.z); x[6] = bflo(w.w); x[7] = bfhi(w.w); }
__device__ __forceinline__ u32x4 pack8(const float (&x)[8]) { u32x4 o; o.x = cvt_pk_bf16(x[0], x[1]); o.y = cvt_pk_bf16(x[2], x[3]); o.z = cvt_pk_bf16(x[4], x[5]); o.w = cvt_pk_bf16(x[6], x[7]); return o; }
__device__ __forceinline__ void ph_final(const bf16_t* xb, float* out, const float* g, int gw, int NGW, int lane) {
    for (int m0 = gw; m0 < T; m0 += 2 * NGW) {
        float v[2][4][8]; float s[2] = {0.f, 0.f};
#pragma unroll
        for (int rr = 0; rr < 2; ++rr) { const int mr = (m0 + rr * NGW < T) ? m0 + rr * NGW : m0; const u32x4* xr = (const u32x4*)(xb + (size_t)mr * DM) + lane;
#pragma unroll
            for (int j = 0; j < 4; ++j) { unpack8(xr[64 * j], v[rr][j]);
#pragma unroll
                for (int e = 0; e < 8; ++e) s[rr] += v[rr][j][e] * v[rr][j][e]; } }
#pragma unroll
        for (int rr = 0; rr < 2; ++rr) { if (m0 + rr * NGW >= T) continue; f32x4* o = (f32x4*)(out + (size_t)(m0 + rr * NGW) * DM) + 2 * lane;
            const float rs = 1.0f / sqrtf(wave_sum(s[rr], lane) * (1.f / DM) + EPS);
#pragma unroll
            for (int j = 0; j < 4; ++j) { const f32x4 g0 = ((const f32x4*)g)[2 * (lane + 64 * j)], g1 = ((const f32x4*)g)[2 * (lane + 64 * j) + 1];
                o[128 * j] = (f32x4){v[rr][j][0] * rs * g0.x, v[rr][j][1] * rs * g0.y, v[rr][j][2] * rs * g0.z, v[rr][j][3] * rs * g0.w};
                o[128 * j + 1] = (f32x4){v[rr][j][4] * rs * g1.x, v[rr][j][5] * rs * g1.y, v[rr][j][6] * rs * g1.z, v[rr][j][7] * rs * g1.w}; } }
    }
}
__device__ __forceinline__ void ph_prep(const Args& a, int l, int gw, int NGW, int lane) {
    bf16_t* PROJ = (bf16_t*)(a.ws + WS_BIG); bf16_t* KA = (bf16_t*)(a.ws + WS_KA);
    const f32x2* ra = (const f32x2*)(a.ws + WS_ROPEA); const f32x2* r1 = (const f32x2*)(a.ws + WS_ROPE1);
    const float* gq = a.in[3] + l * 512; const float* gkv = a.in[5] + l * 512; const float* cqn = a.in[7] + l * 128; const float* ckn = a.in[8] + l * 128;
    const int j8 = lane & 7, hd = lane >> 3;
    for (int m0 = gw; m0 < T; m0 += 2 * NGW) {
#pragma unroll
      for (int rr = 0; rr < 2; ++rr) { const int m = m0 + rr * NGW; if (m >= T) continue;
        bf16_t* P = PROJ + (size_t)m * INP; const int s = m & (SEQ - 1);
        if (lane < 4) {
            float x1[8], x2[8]; unpack8(*(const u32x4*)(P + PA_KR + 8 * lane), x1); unpack8(*(const u32x4*)(P + PA_KR + 32 + 8 * lane), x2);
            const f32x4* cp = (const f32x4*)(ra + s * 32 + 8 * lane);
#pragma unroll
            for (int e2 = 0; e2 < 4; ++e2) { const f32x4 cs = cp[e2];
                const float a0 = x1[2 * e2], b0 = x2[2 * e2], a1 = x1[2 * e2 + 1], b1 = x2[2 * e2 + 1];
                x1[2 * e2] = a0 * cs.x - b0 * cs.y; x2[2 * e2] = b0 * cs.x + a0 * cs.y; x1[2 * e2 + 1] = a1 * cs.z - b1 * cs.w; x2[2 * e2 + 1] = b1 * cs.z + a1 * cs.w; }
            const u32x4 y1 = pack8(x1), y2 = pack8(x2); bf16_t* kp = KA + (size_t)m * 768 + 128 + 8 * lane;
#pragma unroll
            for (int h = 0; h < 4; ++h) { *(u32x4*)(kp + h * 192) = y1; *(u32x4*)(kp + h * 192 + 32) = y2; }
        }
        { const f32x4* cp = (const f32x4*)(r1 + s * 64 + 8 * j8); const f32x4 c0 = cp[0], c1 = cp[1], c2 = cp[2], c3 = cp[3];
#pragma unroll
          for (int pass = 0; pass < 2; ++pass) { const int head = 8 * pass + hd;
              if (head < 12) { bf16_t* hp = P + PB_Q + head * 128 + 8 * j8; float x1[8], x2[8]; unpack8(*(const u32x4*)hp, x1); unpack8(*(const u32x4*)(hp + 64), x2);
                  const float cc[8] = {c0.x, c0.z, c1.x, c1.z, c2.x, c2.z, c3.x, c3.z}, sn[8] = {c0.y, c0.w, c1.y, c1.w, c2.y, c2.w, c3.y, c3.w};
#pragma unroll
                  for (int e = 0; e < 8; ++e) { const float p = x1[e], q = x2[e]; x1[e] = p * cc[e] - q * sn[e]; x2[e] = q * cc[e] + p * sn[e]; }
                  *(u32x4*)hp = pack8(x1); *(u32x4*)(hp + 64) = pack8(x2); } } }
        { const int half = j8 >> 2, jj = j8 & 3; bf16_t* hp = P + PC_Q + hd * 128 + 64 * half + 8 * jj;
          float x1[8], x2[8]; unpack8(*(const u32x4*)hp, x1); unpack8(*(const u32x4*)(hp + 32), x2);
          const f32x4* cp = (const f32x4*)(ra + (half ? (s & 63) : (s >> 6)) * 32 + 8 * jj); const f32x4 c0 = cp[0], c1 = cp[1], c2 = cp[2], c3 = cp[3];
          const float* g = (hd < 6 ? cqn : ckn) + 64 * half + 8 * jj; const f32x4 ga = *(const f32x4*)g, gb = *(const f32x4*)(g + 4), gc = *(const f32x4*)(g + 32), gd = *(const f32x4*)(g + 36);
          float ss = 0.f;
#pragma unroll
          for (int e = 0; e < 8; ++e) ss += x1[e] * x1[e] + x2[e] * x2[e];
          ss += __builtin_bit_cast(float, __builtin_amdgcn_ds_bpermute((lane ^ 1) << 2, __builtin_bit_cast(int, ss)));
          ss += __builtin_bit_cast(float, __builtin_amdgcn_ds_bpermute((lane ^ 2) << 2, __builtin_bit_cast(int, ss)));
          ss += __builtin_bit_cast(float, __builtin_amdgcn_ds_bpermute((lane ^ 4) << 2, __builtin_bit_cast(int, ss)));
          const float rs = 1.0f / sqrtf(ss * (1.f / 128.f) + EPS);
          const float g1[8] = {ga.x, ga.y, ga.z, ga.w, gb.x, gb.y, gb.z, gb.w}, g2[8] = {gc.x, gc.y, gc.z, gc.w, gd.x, gd.y, gd.z, gd.w};
          const float cc[8] = {c0.x, c0.z, c1.x, c1.z, c2.x, c2.z, c3.x, c3.z}, sn[8] = {c0.y, c0.w, c1.y, c1.w, c2.y, c2.w, c3.y, c3.w};
#pragma unroll
          for (int e = 0; e < 8; ++e) { const float p = x1[e] * rs * g1[e], q = x2[e] * rs * g2[e]; x1[e] = p * cc[e] - q * sn[e]; x2[e] = q * cc[e] + p * sn[e]; }
          *(u32x4*)hp = pack8(x1); *(u32x4*)(hp + 32) = pack8(x2); }
      }
    }
}
__device__ __forceinline__ void ph_ynorm(bf16_t* Y, const float* g, int gw, int NGW, int lane) {
    for (int m = gw; m < T; m += NGW) {
        u32x4* p = (u32x4*)(Y + (size_t)m * DM) + lane; float x[4][8]; float sa = 0.f, sb = 0.f, sc = 0.f;
#pragma unroll
        for (int j = 0; j < 4; ++j) { const u32x4 w = p[64 * j];
            x[j][0] = bflo(w.x); x[j][1] = bfhi(w.x); x[j][2] = bflo(w.y); x[j][3] = bfhi(w.y); x[j][4] = bflo(w.z); x[j][5] = bfhi(w.z); x[j][6] = bflo(w.w); x[j][7] = bfhi(w.w);
            float ss = 0.f;
#pragma unroll
            for (int e = 0; e < 8; ++e) ss += x[j][e] * x[j][e];
            if (j == 0) sa += ss; else if (j == 1) sb += ss; else if (j == 2) { if (lane < 32) sb += ss; else sc += ss; } else sc += ss; }
        const float ra_ = 1.0f / sqrtf(wave_sum(sa, lane) * (1.f / 512.f) + EPS), rb_ = 1.0f / sqrtf(wave_sum(sb, lane) * (1.f / 768.f) + EPS), rc_ = 1.0f / sqrtf(wave_sum(sc, lane) * (1.f / 768.f) + EPS);
#pragma unroll
        for (int j = 0; j < 4; ++j) { const float rs = (j == 0) ? ra_ : (j == 1) ? rb_ : (j == 2) ? (lane < 32 ? rb_ : rc_) : rc_;
            const float* gp = g + (lane + 64 * j) * 8; const f32x4 g0 = *(const f32x4*)gp, g1 = *(const f32x4*)(gp + 4);
            u32x4 o; o.x = cvt_pk_bf16(x[j][0] * rs * g0.x, x[j][1] * rs * g0.y); o.y = cvt_pk_bf16(x[j][2] * rs * g0.z, x[j][3] * rs * g0.w);
            o.z = cvt_pk_bf16(x[j][4] * rs * g1.x, x[j][5] * rs * g1.y); o.w = cvt_pk_bf16(x[j][6] * rs * g1.z, x[j][7] * rs * g1.w);
            p[64 * j] = o; }
    }
}

#if defined(__HIP_DEVICE_COMPILE__)
__device__ __forceinline__ void ph_attention(const __attribute__((address_space(4))) Args* ap, int l, LAS unsigned char* lds, const int rep) {
    volatile LAS int* slot = (volatile LAS int*)(lds + LDS_SLOT);
#if !defined(NO_ATT_A)
    for (;;) {
        asm volatile("" : "+s"(ap));
        unsigned char* ws = ap->ws;
        const bf16_t* QA = (const bf16_t*)(ws + WS_QA); const bf16_t* KA = (const bf16_t*)(ws + WS_KA);
        const bf16_t* VA = (const bf16_t*)(ws + WS_VA); bf16_t* Y = (bf16_t*)(ws + WS_XN); const f32x2* ra = (const f32x2*)(ws + WS_ROPEA);
        if (threadIdx.x == 0) *slot = (int)__hip_atomic_fetch_add((unsigned*)(ws + WS_CTL) + 64 * (1 + l + 4 * rep), 1u, __ATOMIC_RELAXED, __HIP_MEMORY_SCOPE_AGENT);
        __syncthreads(); const int u = __builtin_amdgcn_readfirstlane(*slot); __syncthreads();
        if (u >= 256) break;
        int tid = threadIdx.x; asm volatile("" : "+v"(tid));
        const int b = u >> 6, h = (u >> 4) & 3, qb = u & 15; const size_t row = (size_t)b * SEQ + qb * 256;
        att::attn_unit<192, false, 1>(QA + row * 768 + h * 192, 768, KA + (size_t)b * SEQ * 768 + h * 192, 768, VA + (size_t)b * SEQ * 512 + h * 128, 512,
                                      Y + row * DM + h * 128, DM, SEQ / 64, 0.07216878364870322f, (LAS char*)lds, ra, qb * 256, 0, tid, (u64*)(ws + WS_CTL + YSS_OFF) + ((size_t)l * T + row) * 4 + 0);
    }
#endif
    for (;;) {
        asm volatile("" : "+s"(ap));
        unsigned char* ws = ap->ws;
        const bf16_t* PROJ = (const bf16_t*)(ws + WS_BIG); bf16_t* Y = (bf16_t*)(ws + WS_XN);
        if (threadIdx.x == 0) *slot = (int)__hip_atomic_fetch_add((unsigned*)(ws + WS_CTL) + 64 * (3 + l + 4 * rep), 1u, __ATOMIC_RELAXED, __HIP_MEMORY_SCOPE_AGENT);
        __syncthreads(); const int v = __builtin_amdgcn_readfirstlane(*slot); __syncthreads();
        if (v >= 768) break;
        int tid = threadIdx.x; asm volatile("" : "+v"(tid));
#if !defined(NO_ATT_C)
        if (v < 384) { const int b = v / 96, h = (v >> 4) % 6, qb = v & 15, kvh = h / 3; const size_t row = (size_t)b * SEQ + qb * 256;
            att::attn_unit<128, false, 1>(PROJ + row * INP + PC_Q + h * 128, INP, PROJ + (size_t)b * SEQ * INP + PC_K + kvh * 128, INP, PROJ + (size_t)b * SEQ * INP + PC_V + kvh * 128, INP,
                                          Y + row * DM + 1280 + h * 128, DM, SEQ / 64, 0.08838834764831845f, (LAS char*)lds, nullptr, 0, 0, tid, (u64*)(ws + WS_CTL + YSS_OFF) + ((size_t)l * T + row) * 4 + 2);
        } else
#endif
#if !defined(NO_ATT_B)
        { const int w = v - 384, b = w / 96, h = (w >> 4) % 6, qb = w & 15; const size_t row = (size_t)b * SEQ + qb * 256;
            const int q0 = qb * 256, lo = q0 - 1024 < 0 ? 0 : q0 - 1024, hi_ = q0 + 1280 > SEQ ? SEQ : q0 + 1280;
            att::attn_unit<128, true, 1>(PROJ + row * INP + PB_Q + h * 128, INP, PROJ + ((size_t)b * SEQ + lo) * INP + PB_K + h * 128, INP, PROJ + ((size_t)b * SEQ + lo) * INP + PB_V + h * 128, INP,
                                         Y + row * DM + 512 + h * 128, DM, (hi_ - lo) / 64, 0.08838834764831845f, (LAS char*)lds, nullptr, 0, lo - q0, tid, (u64*)(ws + WS_CTL + YSS_OFF) + ((size_t)l * T + row) * 4 + 1);
        }
#endif
        {}
    }
    { const int it0 = (l == 0) ? TR_P0 : TR_P1, it1 = (l == 0) ? TR_P1 : 2 * I_LAYER, nun = (it1 - it0) / 16;
      for (;;) {
        asm volatile("" : "+s"(ap));
        unsigned char* ws = ap->ws;
        if (threadIdx.x == 0) *slot = (int)__hip_atomic_fetch_add((unsigned*)(ws + WS_CTL) + 64 * (9 + l + 2 * rep), 1u, __ATOMIC_RELAXED, __HIP_MEMORY_SCOPE_AGENT);
        __syncthreads(); const int c = __builtin_amdgcn_readfirstlane(*slot); __syncthreads();
        if (c >= nun) break;
        int tid = threadIdx.x; asm volatile("" : "+v"(tid));
        const int lane = tid & 63, wave = __builtin_amdgcn_readfirstlane(tid >> 6);
        const Args a = *ap;
        const TrJob j0 = tr_job(a, ws, it0 + 16 * c + wave), j1 = tr_job(a, ws, it0 + 16 * c + 8 + wave);
        f32x4 v0[8], v1[8]; tr_load(j0, lane, v0); tr_load(j1, lane, v1);
        LAS float* scr = (LAS float*)(lds + wave * 16384);
        tr_write(scr, lane, v0); tr_store(j0, scr, lane);
        tr_write(scr, lane, v1); tr_store(j1, scr, lane);
      } }
}
#endif
#if defined(__HIP_DEVICE_COMPILE__)
typedef const __attribute__((address_space(4))) Args* ArgsP;
template <int PH, int REP = 0>
__device__ __forceinline__ void run_phase(ArgsP ap, LAS unsigned char* lds) {
    asm volatile("" : "+s"(ap));
    const Args a = *ap;
    int tid = threadIdx.x, bid = blockIdx.x, G = gridDim.x; asm volatile("" : "+v"(tid)); asm volatile("" : "+s"(bid), "+s"(G));
    const int lane = tid & 63, wave = __builtin_amdgcn_readfirstlane(tid >> 6);
    const int gw = bid * NWAVES + wave, NGW = G * NWAVES;
    unsigned char* ws = a.ws;
    bf16_t* XN = (bf16_t*)(ws + WS_XN); bf16_t* BIG = (bf16_t*)(ws + WS_BIG); bf16_t* XB2 = (bf16_t*)(ws + WS_QA); u64* rss = (u64*)(ws + WS_CTL + RSS_OFF);
    if constexpr (PH == 0) ph_prologue(a, lds, gw, NGW, lane, wave);
    else if constexpr (PH == NPH - 1) ph_final(XN, a.out, a.in[15], gw, NGW, lane);
    else {
        constexpr int l = (PH - 1) / 6, sp = (PH - 1) % 6; unsigned char* wl = ws + WS_W + (size_t)l * W_LAYER;
        bf16_t* R1 = (bf16_t*)a.out;
        u64* css = (u64*)(ws + WS_CTL + CSS_OFF) + (size_t)l * T * 2;
        if constexpr (sp == 0) { pg8::Gemm g{(l == 0) ? XN : R1, (const bf16_t*)(wl + W_IN), DM, DM}; pg8::StaticOrder S; S.init(T, INP, G, bid);
            pg8::EpiBf E{BIG, nullptr, INP, 0, rss + (2 * l) * T, 1, 1.f / 2048.f, css}; pg8::gemm_phase(lds, g, S, E, tid); }
        else if constexpr (sp == 1) {
            { pg8::Gemm g{BIG + PA_CQ, (const bf16_t*)(wl + W_UQ), INP, 512}; pg8::StaticOrder S; S.init(T, 768, G, bid);
              pg8::EpiBf E{(bf16_t*)(ws + WS_QA), nullptr, 768, 0, css, 2, 1.f / 512.f, nullptr}; pg8::gemm_phase(lds, g, S, E, tid); }
            { pg8::Gemm g{BIG + PA_CKV, (const bf16_t*)(wl + W_UKV), INP, 512}; pg8::StaticOrder S; S.init(T, 1024, G, bid);
              pg8::EpiBf E{(bf16_t*)(ws + WS_KA), (bf16_t*)(ws + WS_VA), 0, 1, css + 1, 2, 1.f / 512.f, nullptr}; pg8::gemm_phase(lds, g, S, E, tid); }
            ph_prep(a, l, gw, NGW, lane);
        }
        else if constexpr (sp == 2) ph_attention(ap, l, lds, REP);
        else if constexpr (sp == 3) { pg8::Gemm g{XN, (const bf16_t*)(wl + W_OUT), DM, DM}; pg8::StaticOrder S; S.init(T, DM, G, bid);
            pg8::EpiRes E{(l == 0) ? a.in[0] : nullptr, (l == 0) ? nullptr : R1, nullptr, XB2, DM, rss + (2 * l + 1) * T, (const u64*)(ws + WS_CTL + YSS_OFF) + (size_t)l * T * 4}; pg8::gemm_phase(lds, g, S, E, tid); }
        else if constexpr (sp == 4) { pg8::Gemm g{XB2, (const bf16_t*)(wl + W_GU), DM, DM}; pg8::StaticOrder S; S.init(T, 2 * DFF, G, bid);
            pg8::EpiBf E{BIG, nullptr, DFF, 2, rss + (2 * l + 1) * T, 1, 1.f / 2048.f, nullptr}; pg8::gemm_phase(lds, g, S, E, tid); }
        else { pg8::Gemm g{BIG, (const bf16_t*)(wl + W_DN), DFF, DFF}; pg8::StaticOrder S; S.init(T, DM, G, bid);
            pg8::EpiRes E{nullptr, XB2, nullptr, (l == 0) ? R1 : XN, DM, (l == 0) ? rss + 2 * T : nullptr, nullptr}; pg8::gemm_phase(lds, g, S, E, tid); }
    }
}

#endif
__global__ void __launch_bounds__(NWAVES * 64, 2) mega_fwd(Args a_unused) {
#if defined(__HIP_DEVICE_COMPILE__)
    extern __shared__ __attribute__((aligned(16))) unsigned char lds_raw[];
    LAS unsigned char* lds = (LAS unsigned char*)lds_raw;
    ArgsP ap = (ArgsP)__builtin_amdgcn_kernarg_segment_ptr();
    const int ph_lo = ap->ph_lo, ph_hi = ap->ph_hi;
    XcdBarrier xbar; xbar.bar = (unsigned*)(ap->ws + WS_CTL) + 4096; xbar.x = 0; xbar.st = (volatile LAS unsigned*)(lds + LDS_SLOT + 16);
    if (ph_hi - ph_lo > 1) {
        if (threadIdx.x < 2) xbar.st[threadIdx.x] = 0u;
        __syncthreads();
        xbar = xcd_barrier_post(xbar.bar, xbar.st);
    }
#define GRID_BAR() do { xcd_barrier(xbar); } while (0)
#define RUN_AGAIN(PH) do { if (ph_lo <= (PH) && (PH) + 1 < ph_hi) { run_phase<PH, 1>(ap, lds); GRID_BAR(); } } while (0)
#define RUN_PHASE(PH) do { if (ph_lo <= (PH) && (PH) < ph_hi) { run_phase<PH>(ap, lds); if ((PH) + 1 < ph_hi) { if ((PH) == 0) { __syncthreads(); cg::this_grid().sync(); } else GRID_BAR(); } } } while (0)
#define PA(PH) do { if (PROBE_ATT) RUN_AGAIN(PH); } while (0)
#define PG(PH) do { if (PROBE_GEMM) RUN_AGAIN(PH); } while (0)
#define PE(PH) do { if (PROBE_ELEM) RUN_AGAIN(PH); } while (0)
    RUN_PHASE(0); PE(0); RUN_PHASE(1); RUN_PHASE(2); RUN_PHASE(3); PA(3); RUN_PHASE(4); RUN_PHASE(5); PG(5); RUN_PHASE(6);
    RUN_PHASE(7); RUN_PHASE(8); RUN_PHASE(9); PA(9); RUN_PHASE(10); RUN_PHASE(11); PG(11); RUN_PHASE(12); RUN_PHASE(13);
#undef RUN_PHASE
#endif
}

extern "C" void kernel_launch(void* const* d_in, const int* in_sizes, int n_in, void* d_out, int out_size, void* d_ws, size_t ws_size, hipStream_t stream) {
    static int grid = 0;
    if (grid == 0) {
        if (n_in != 16 || out_size != T * DM || ws_size < WS_END) { fprintf(stderr, "kernel_launch: unexpected shapes n_in %d out %d ws %zu (need %zu)\n", n_in, out_size, ws_size, (size_t)WS_END); grid = -1; return; }
        int dev = 0, cus = 0, per_cu = 0;
        hipGetDevice(&dev); hipDeviceGetAttribute(&cus, hipDeviceAttributeMultiprocessorCount, dev);
        if (hipFuncSetAttribute((const void*)mega_fwd, hipFuncAttributeMaxDynamicSharedMemorySize, LDS_BYTES) != hipSuccess) { fprintf(stderr, "kernel_launch: hipFuncSetAttribute failed\n"); grid = -1; return; }
        hipOccupancyMaxActiveBlocksPerMultiprocessor(&per_cu, (const void*)mega_fwd, NWAVES * 64, LDS_BYTES);
        (void)hipGetLastError();
        if (per_cu < 1) per_cu = 1;
        grid = cus * 1;
    }
    if (grid < 0) return;
    hipMemsetAsync((char*)d_ws + WS_CTL, 0, 32768, stream);
    Args a{};
    for (int i = 0; i < 16; ++i) a.in[i] = (const float*)d_in[i];
    a.out = (float*)d_out; a.ws = (unsigned char*)d_ws;
#if MK_SINGLE
    a.ph_lo = 0; a.ph_hi = NPH;
    void* args[] = {&a};
    hipError_t e = hipLaunchCooperativeKernel((const void*)mega_fwd, dim3(grid), dim3(NWAVES * 64), args, LDS_BYTES, stream);
    if (e != hipSuccess) fprintf(stderr, "cooperative launch failed: %s (grid %d)\n", hipGetErrorString(e), grid);
#else
    for (int ph = 0; ph < NPH; ++ph) { a.ph_lo = ph; a.ph_hi = ph + 1;
        hipLaunchKernelGGL(mega_fwd, dim3(grid), dim3(NWAVES * 64), LDS_BYTES, stream, a); }
#endif
}
```

```cpp
#include <hip/hip_runtime.h>
#include <hip/hip_cooperative_groups.h>
#include <cstdio>
#include <cstdint>
namespace cg = cooperative_groups;

#ifndef PROBE_ATT
#define PROBE_ATT 0
#endif
#ifndef PROBE_GEMM
#define PROBE_GEMM 0
#endif
#ifndef PROBE_ELEM
#define PROBE_ELEM 0
#endif
#ifndef MK_SINGLE
#define MK_SINGLE 1
#endif

#define LAS __attribute__((address_space(3)))
typedef unsigned short bf16_t;
typedef short bf16x8 __attribute__((ext_vector_type(8)));
typedef short s16x4 __attribute__((ext_vector_type(4)));
typedef float f32x4 __attribute__((ext_vector_type(4)));
typedef float f32x2 __attribute__((ext_vector_type(2)));
typedef float f32x16 __attribute__((ext_vector_type(16)));
typedef unsigned u32x4 __attribute__((ext_vector_type(4)));
typedef unsigned u32x2 __attribute__((ext_vector_type(2)));
typedef unsigned long long u64;
constexpr float FXS = 1048576.f, FXI = 1.f / 1048576.f;
__device__ __forceinline__ void fx_add(u64* p, float v) { atomicAdd(p, (u64)(v * FXS + 0.5f)); }
__device__ __forceinline__ float fx_get(const u64* p) { return (float)(*p) * FXI; }

constexpr int NB = 4, SEQ = 4096, T = NB * SEQ, DM = 2048, INW = 4672, INP = 4864, DFF = 5632;
constexpr int NWAVES = 8;
constexpr int NPH = 14;
constexpr float EPS = 1e-6f;
constexpr int PA_CQ = 0, PA_CKV = 512, PA_KR = 1024, PB_Q = 1088, PB_K = 1856, PB_V = 2624, PC_Q = 3392, PC_K = 4160, PC_V = 4416;

constexpr size_t WS_CTL = 0, CTL_BYTES = 4u << 20;
constexpr size_t RSS_OFF = 512 * 1024;
constexpr size_t YSS_OFF = 1024 * 1024;
constexpr size_t CSS_OFF = 2048 * 1024;
constexpr size_t WS_ROPEA = WS_CTL + CTL_BYTES;
constexpr size_t WS_ROPE1 = WS_ROPEA + (size_t)4096 * 32 * 8;
constexpr size_t WS_W = WS_ROPE1 + (size_t)4096 * 64 * 8;
constexpr size_t W_IN = 0, W_UQ = W_IN + (size_t)INP * DM * 2, W_UKV = W_UQ + (size_t)768 * 512 * 2, W_OUT = W_UKV + (size_t)1024 * 512 * 2,
                 W_GU = W_OUT + (size_t)DM * DM * 2, W_DN = W_GU + (size_t)2 * DFF * DM * 2, W_LAYER = W_DN + (size_t)DM * DFF * 2;
constexpr size_t WS_XN = WS_W + 2 * W_LAYER;
constexpr size_t WS_BIG = WS_XN + (size_t)T * DM * 2;
constexpr size_t BIG_BYTES = (size_t)T * DFF * 2;
constexpr size_t WS_QA = WS_BIG + BIG_BYTES;
constexpr size_t WS_KA = WS_QA + (size_t)T * 768 * 2;
constexpr size_t WS_VA = WS_KA + (size_t)T * 768 * 2;
constexpr size_t WS_END = WS_VA + (size_t)T * 512 * 2;
static_assert((size_t)T * INP * 2 <= BIG_BYTES, "PROJ fits under FF");
static_assert(WS_END <= (size_t)536870912, "workspace map fits 512 MiB");

constexpr int LDS_SLOT = 139264;
constexpr int LDS_BYTES = LDS_SLOT + 256;

__device__ __forceinline__ unsigned cvt_pk_bf16(float lo, float hi) { unsigned r; asm volatile("v_cvt_pk_bf16_f32 %0, %1, %2" : "=v"(r) : "v"(lo), "v"(hi)); return r; }
__device__ __forceinline__ float bf2f(unsigned short b) { return __uint_as_float(((unsigned)b) << 16); }
__device__ __forceinline__ float bflo(unsigned w) { return __uint_as_float(w << 16); }
__device__ __forceinline__ float bfhi(unsigned w) { return __uint_as_float(w & 0xffff0000u); }
__device__ __forceinline__ unsigned short f2bf(float f) { return (unsigned short)(cvt_pk_bf16(f, f) & 0xffffu); }
__device__ __forceinline__ float wave_sum(float v, const int lane) {
#pragma unroll
    for (int o = 1; o < 64; o <<= 1) v += __builtin_bit_cast(float, __builtin_amdgcn_ds_bpermute((lane ^ o) << 2, __builtin_bit_cast(int, v)));
    return v;
}


#define XB_TMO      128
#define XB_XCNT(j)  (256  + 64 * (j))
#define XB_XSUB(j)  (1280 + 64 * (j))
#define XB_XGEN(j)  (2304 + 64 * (j))
#define XB_TOP      3328
#define XB_TOPGEN   3392
#define XCD_BAR_WORDS 3456
#define XB_SPIN_CAP (1u << 18)
__device__ __forceinline__ unsigned xb_ld(unsigned* p)              { return __hip_atomic_load(p, __ATOMIC_RELAXED, __HIP_MEMORY_SCOPE_AGENT); }
__device__ __forceinline__ unsigned xb_add(unsigned* p, unsigned v) { return __hip_atomic_fetch_add(p, v, __ATOMIC_RELAXED, __HIP_MEMORY_SCOPE_AGENT); }
__device__ __forceinline__ unsigned xb_xcc_id() { return (unsigned)__builtin_amdgcn_s_getreg((3 << 11) | 20) & 0xFu; }
#define XB_SPIN(cond, bar) do { unsigned _sp = 0; while (cond) { __builtin_amdgcn_s_sleep(1); \
    if ((++_sp & 255u) == 0u) { if (xb_ld(&(bar)[XB_TMO])) break; if (_sp > XB_SPIN_CAP) { atomicAdd(&(bar)[XB_TMO], 1u); break; } } } } while (0)
struct XcdBarrier { unsigned* bar; unsigned x; volatile LAS unsigned* st; };
__device__ __forceinline__ XcdBarrier xcd_barrier_post(unsigned* bar, volatile LAS unsigned* st) {
    XcdBarrier b; b.bar = bar; b.x = xb_xcc_id(); b.st = st;
    if (threadIdx.x == 0) (void)xb_add(&bar[XB_XCNT(b.x)], 1u);
    return b;
}
__device__ __forceinline__ void xcd_barrier_complete(unsigned* bar, unsigned x, unsigned& nloc, unsigned& nx) {
    const unsigned G = gridDim.x * gridDim.y * gridDim.z;
    unsigned sum, cnt, mine, sp = 0u;
    for (;;) {
        sum = 0u; cnt = 0u; mine = 0u;
#pragma unroll
        for (unsigned j = 0; j < 16; ++j) { const unsigned c = xb_ld(&bar[XB_XCNT(j)]); sum += c; cnt += (c > 0u) ? 1u : 0u; mine = (j == x) ? c : mine; }
        if (sum == G) break;
        __builtin_amdgcn_s_sleep(1);
        if ((++sp & 255u) == 0u) { if (xb_ld(&bar[XB_TMO])) break; if (sp > XB_SPIN_CAP) { atomicAdd(&bar[XB_TMO], 1u); break; } }
    }
    nloc = mine > 0u ? mine : 1u; nx = cnt > 0u ? cnt : 1u;
}
__device__ __forceinline__ void xcd_barrier(const XcdBarrier& b) {
    asm volatile("s_waitcnt vmcnt(0)" ::: "memory");
    __syncthreads();
    if (threadIdx.x == 0) {
        unsigned* bar = b.bar;
        __builtin_amdgcn_s_waitcnt(0);
        unsigned nloc = b.st[0], nx = b.st[1];
        if (nloc == 0u) { xcd_barrier_complete(bar, b.x, nloc, nx); b.st[0] = nloc; b.st[1] = nx; }
        const unsigned old = xb_add(&bar[XB_XSUB(b.x)], 1u);
        const unsigned gen = old / nloc;
        if (old + 1u == (gen + 1u) * nloc) {
            __builtin_amdgcn_fence(__ATOMIC_RELEASE, "agent");
            asm volatile("s_waitcnt vmcnt(0)" ::: "memory");
            const unsigned og = xb_add(&bar[XB_TOP], 1u);
            const unsigned tg = og / nx;
            if (og + 1u == (tg + 1u) * nx) xb_add(&bar[XB_TOPGEN], 1u);
            else XB_SPIN(xb_ld(&bar[XB_TOPGEN]) == tg, bar);
            __builtin_amdgcn_fence(__ATOMIC_ACQUIRE, "agent");
            xb_add(&bar[XB_XGEN(b.x)], 1u);
            asm volatile("s_waitcnt vmcnt(0)" ::: "memory");
        } else {
            XB_SPIN(xb_ld(&bar[XB_XGEN(b.x)]) == gen, bar);
            __builtin_amdgcn_fence(__ATOMIC_ACQUIRE, "agent");
            asm volatile("s_waitcnt vmcnt(0)" ::: "memory");
        }
    }
    __syncthreads();
}

namespace pg8 {
constexpr int BM = 256, BK = 64, HALF = 128, HTB = HALF * BK * 2, STAGE_BYTES = 8 * HTB, NXCD = 8, WGM = 8;
__host__ __device__ __forceinline__ int lds_byte(int r, int c) { const int st = (r >> 4) * 2 + (c >> 5), rr = r & 15, cc = c & 31, ob = rr * 64 + cc * 2; return st * 1024 + (ob ^ (((ob >> 9) & 1) << 5)); }
__host__ __device__ __forceinline__ void stage_rc(int b, int& R, int& C) { const int st = b / 1024, sb = b % 1024, swz = sb ^ (((sb >> 9) & 1) << 5); R = (st >> 1) * 16 + swz / 64; C = (st & 1) * 32 + (swz % 64) / 2; }
__host__ __device__ __forceinline__ int perm32(int rho) { const int n = rho >> 4, i = rho & 15; return 8 * (i >> 2) + 4 * n + (i & 3); }

struct Unit { int pm, pn; };
struct Gemm { const bf16_t* A; const bf16_t* Bt; int lda, K; };

struct StaticOrder {
    int nM, nN, nwg, G, c;
    __device__ void init(int M, int N, int G_, int c_) { nM = M / BM; nN = N / BM; nwg = nM * nN; G = G_; c = c_; }
    __device__ bool next(int i, Unit& u) const {
        const long L = (long)i * G + c; if (L >= nwg) return false;
        int wgid = (int)L; { const int q = nwg / NXCD, r = nwg % NXCD, xcd = wgid % NXCD, off = wgid / NXCD; wgid = (xcd < r ? xcd * (q + 1) : r * (q + 1) + (xcd - r) * q) + off; }
        const int nig = WGM * nN, gid = wgid / nig, fm = gid * WGM, gsz = (nM - fm) < WGM ? (nM - fm) : WGM;
        u.pm = fm + ((wgid % nig) % gsz); u.pn = (wgid % nig) / gsz; return true;
    }
};

struct EpiRes {
    static constexpr bool KSCALE = true;
    static constexpr bool PERM = true;
    const float* base32; const bf16_t* base16; float* out32; bf16_t* out16; int ldc; u64* rss; const u64* yss;
    __device__ __forceinline__ void kscale(f32x4 (&acc)[2][2][4][2], const Unit& u, int t, int tid_) const {
        asm volatile("" : "+v"(tid_)); const int row0 = u.pm * BM + (__builtin_amdgcn_readfirstlane(tid_ >> 6) >> 2) * 64 + (tid_ & 15);
#pragma unroll
        for (int ai = 0; ai < 2; ++ai)
#pragma unroll
            for (int m = 0; m < 4; ++m) { const u64* yq = yss + (size_t)(row0 + ai * HALF + m * 16) * 4 + (t == 8 ? 0 : 1);
                const float wp = (t == 8) ? (1.f / 512.f) : (1.f / 768.f);
                const float vp = fx_get(yq) * wp + 1e-6f, vn = fx_get(yq + 1) * (1.f / 768.f) + 1e-6f;
                const float sc = __builtin_amdgcn_sqrtf(vn * __builtin_amdgcn_rcpf(vp));
#pragma unroll
                for (int bj = 0; bj < 2; ++bj)
#pragma unroll
                    for (int n = 0; n < 2; ++n) acc[ai][bj][m][n] *= sc;
                asm volatile("" ::: "memory"); }
    }
    __device__ __forceinline__ void operator()(const f32x4 (&acc)[2][2][4][2], const Unit& u, int tid_) const {
        asm volatile("" : "+v"(tid_)); const int lane = tid_ & 63, wid_ = __builtin_amdgcn_readfirstlane(tid_ >> 6), wr = wid_ >> 2, wc = wid_ & 3, fr = lane & 15, fq = lane >> 4;
        const int row0 = u.pm * BM + wr * 64 + fr, col0 = u.pn * BM + wc * 32 + 8 * fq;
#pragma unroll
        for (int ai = 0; ai < 2; ++ai)
#pragma unroll
            for (int m = 0; m < 4; ++m) { const size_t off = (size_t)(row0 + ai * HALF + m * 16) * ldc + col0; float ss = 0.f;
                const float rc = yss ? 1.0f / sqrtf(fx_get(yss + (size_t)(row0 + ai * HALF + m * 16) * 4 + 2) * (1.f / 768.f) + 1e-6f) : 1.0f;
#pragma unroll
                for (int bj = 0; bj < 2; ++bj) { f32x4 b0, b1;
                    if (base16) { const u32x4 w = *(const u32x4*)(base16 + off + bj * HALF); b0 = (f32x4){bflo(w.x), bfhi(w.x), bflo(w.y), bfhi(w.y)}; b1 = (f32x4){bflo(w.z), bfhi(w.z), bflo(w.w), bfhi(w.w)}; }
                    else { b0 = *(const f32x4*)(base32 + off + bj * HALF); b1 = *(const f32x4*)(base32 + off + bj * HALF + 4); }
                    const f32x4 v0 = b0 + acc[ai][bj][m][0] * rc, v1 = b1 + acc[ai][bj][m][1] * rc;
                    if (out16) { u32x4 w; w.x = cvt_pk_bf16(v0[0], v0[1]); w.y = cvt_pk_bf16(v0[2], v0[3]); w.z = cvt_pk_bf16(v1[0], v1[1]); w.w = cvt_pk_bf16(v1[2], v1[3]); *(u32x4*)(out16 + off + bj * HALF) = w; }
                    if (out32) { *(f32x4*)(out32 + off + bj * HALF) = v0; *(f32x4*)(out32 + off + bj * HALF + 4) = v1; }
                    ss += (v0[0] * v0[0] + v0[1] * v0[1]) + (v0[2] * v0[2] + v0[3] * v0[3]) + (v1[0] * v1[0] + v1[1] * v1[1]) + (v1[2] * v1[2] + v1[3] * v1[3]); }
                if (rss) {
                    ss += __builtin_bit_cast(float, __builtin_amdgcn_ds_bpermute((lane ^ 16) << 2, __builtin_bit_cast(int, ss)));
                    ss += __builtin_bit_cast(float, __builtin_amdgcn_ds_bpermute((lane ^ 32) << 2, __builtin_bit_cast(int, ss)));
                    if (fq == 0) fx_add(rss + row0 + ai * HALF + m * 16, ss); } }
    }
};
struct EpiBf {
    static constexpr bool KSCALE = false;
    static constexpr bool PERM = true;
    bf16_t* O; bf16_t* O2; int ldc; int mode; const u64* rss; int rstride; float invw; u64* css;
    __device__ __forceinline__ void operator()(const f32x4 (&acc)[2][2][4][2], const Unit& u, int tid_) const {
        asm volatile("" : "+v"(tid_)); const int lane = tid_ & 63, wid_ = __builtin_amdgcn_readfirstlane(tid_ >> 6), wr = wid_ >> 2, wc = wid_ & 3, fr = lane & 15, fq = lane >> 4;
        const int row0 = u.pm * BM + wr * 64 + fr, cw = wc * 32 + 8 * fq;
        if (mode == 2) {
#pragma unroll
            for (int ai = 0; ai < 2; ++ai)
#pragma unroll
                for (int m = 0; m < 4; ++m) { const int r = row0 + ai * HALF + m * 16; bf16_t* rowp = O + (size_t)r * ldc + u.pn * HALF + cw;
                    const float rs = 1.0f / sqrtf(fx_get(rss + (size_t)r * rstride) * invw + 1e-6f);
                    float v[8];
#pragma unroll
                    for (int n = 0; n < 2; ++n)
#pragma unroll
                        for (int j = 0; j < 4; ++j) { const float g = acc[ai][0][m][n][j] * rs, up = acc[ai][1][m][n][j] * rs;
                            const float e = __builtin_amdgcn_exp2f(-g * 1.4426950408889634f); v[n * 4 + j] = g * __builtin_amdgcn_rcpf(1.0f + e) * up; }
                    u32x4 w; w.x = cvt_pk_bf16(v[0], v[1]); w.y = cvt_pk_bf16(v[2], v[3]); w.z = cvt_pk_bf16(v[4], v[5]); w.w = cvt_pk_bf16(v[6], v[7]);
                    *(u32x4*)rowp = w; }
        } else {
#pragma unroll
            for (int ai = 0; ai < 2; ++ai)
#pragma unroll
                for (int m = 0; m < 4; ++m) { const size_t r = (size_t)(row0 + ai * HALF + m * 16);
                    const float rs = rss ? 1.0f / sqrtf(fx_get(rss + r * rstride) * invw + 1e-6f) : 1.0f; float ss = 0.f;
#pragma unroll
                    for (int bj = 0; bj < 2; ++bj) { const f32x4 v0 = acc[ai][bj][m][0] * rs, v1 = acc[ai][bj][m][1] * rs;
                        ss += (v0[0] * v0[0] + v0[1] * v0[1]) + (v0[2] * v0[2] + v0[3] * v0[3]) + (v1[0] * v1[0] + v1[1] * v1[1]) + (v1[2] * v1[2] + v1[3] * v1[3]);
                        u32x4 w; w.x = cvt_pk_bf16(v0[0], v0[1]); w.y = cvt_pk_bf16(v0[2], v0[3]); w.z = cvt_pk_bf16(v1[0], v1[1]); w.w = cvt_pk_bf16(v1[2], v1[3]);
                        bf16_t* p;
                        if (mode == 0) p = O + r * ldc + u.pn * BM + bj * HALF + cw;
                        else p = (bj == 0) ? (O + r * 768 + u.pn * 192 + cw) : (O2 + r * 512 + u.pn * 128 + cw);
                        *(u32x4*)p = w; }
                    if (css != nullptr && u.pn < 4) {
                        ss += __builtin_bit_cast(float, __builtin_amdgcn_ds_bpermute((lane ^ 16) << 2, __builtin_bit_cast(int, ss)));
                        ss += __builtin_bit_cast(float, __builtin_amdgcn_ds_bpermute((lane ^ 32) << 2, __builtin_bit_cast(int, ss)));
                        if (fq == 0) fx_add(css + r * 2 + (u.pn >> 1), ss); } }
        }
    }
};

template <class Epi, class Sched, bool ALIGN_EPI = true, bool SP2 = true>
__device__ __forceinline__ void gemm_phase(LAS unsigned char* lds, const Gemm g, const Sched& S, const Epi& E, const int tid) {
    const int wid = __builtin_amdgcn_readfirstlane(tid >> 6), lane = tid & 63, wr = wid >> 2, wc = wid & 3, fr = lane & 15, fq = lane >> 4;
    const int K = g.K, nt = K / BK, lda = g.lda;
    unsigned voffA[2], voffB[2];
#pragma unroll
    for (int i = 0; i < 2; ++i) { int R, C; stage_rc(tid * 16 + i * 8192, R, C); const int Rb = Epi::PERM ? ((R & ~31) + perm32(R & 31)) : R;
        voffA[i] = (unsigned)(R * lda + C) * 2u; voffB[i] = (unsigned)(Rb * K + C) * 2u; }
    const size_t kstep = (size_t)(BK * 2);
    const size_t hstepA = (size_t)HALF * lda * 2, hstepB = (size_t)HALF * K * 2;
    const size_t tstepA = 2 * hstepA, tstepB = 2 * hstepB;
    const unsigned ldsw = (unsigned)wid * 1024u;
    const int aoff = lds_byte(wr * 64 + fr, fq * 8), boff = lds_byte(wc * 32 + fr, fq * 8);
#define PG8_SA(b, h) (((b) * 2 + (h)) * HTB)
#define PG8_SB(b, h) ((4 + (b) * 2 + (h)) * HTB)
#define PG8_STAGE(bufoff, gbase, voff) do { _Pragma("unroll") for (int _i = 0; _i < 2; ++_i) \
        __builtin_amdgcn_global_load_lds((const unsigned*)((const char*)(gbase) + (voff)[_i]), (LAS unsigned*)(lds + (bufoff) + ldsw + _i * 8192), 16, 0, 0); } while (0)
#define PG8_LDA(dst, b, h) do { _Pragma("unroll") for (int m = 0; m < 4; ++m) _Pragma("unroll") for (int k = 0; k < 2; ++k) dst[m][k] = *(const LAS bf16x8*)(lds + PG8_SA(b, h) + aoff + m * 2048 + k * 1024); } while (0)
#define PG8_LDB(dst, b, h) do { _Pragma("unroll") for (int n = 0; n < 2; ++n) _Pragma("unroll") for (int k = 0; k < 2; ++k) dst[n][k] = *(const LAS bf16x8*)(lds + PG8_SB(b, h) + boff + n * 2048 + k * 1024); } while (0)
#define PG8_MMA(ai, bj, At, Bt) do { __builtin_amdgcn_s_setprio(1); _Pragma("unroll") for (int m = 0; m < 4; ++m) _Pragma("unroll") for (int n = 0; n < 2; ++n) _Pragma("unroll") for (int k = 0; k < 2; ++k) \
        acc[ai][bj][m][n] = __builtin_amdgcn_mfma_f32_16x16x32_bf16(Bt[n][k], At[m][k], acc[ai][bj][m][n], 0, 0, 0); __builtin_amdgcn_s_setprio(0); } while (0)
#define PG8_WAIT_V(n) asm volatile("s_waitcnt vmcnt(" #n ")" ::: "memory")
#define PG8_WAIT_L(n) asm volatile("s_waitcnt lgkmcnt(" #n ")" ::: "memory")
#define PG8_BAR __builtin_amdgcn_s_barrier()
#define PG8_SCHED __builtin_amdgcn_sched_barrier(0)
    Unit cur, nxt; int ui = 0;
    if (!S.next(0, cur)) return;
    f32x4 acc[2][2][4][2];
#pragma unroll
    for (int a = 0; a < 2; ++a)
#pragma unroll
        for (int b = 0; b < 2; ++b)
#pragma unroll
            for (int m = 0; m < 4; ++m)
#pragma unroll
                for (int n = 0; n < 2; ++n) acc[a][b][m][n] = (f32x4){0.f, 0.f, 0.f, 0.f};
    bf16x8 At[4][2], B0[2][2], B1[2][2];
    const char* cA = (const char*)g.A + (size_t)cur.pm * tstepA; const char* cB = (const char*)g.Bt + (size_t)cur.pn * tstepB;
    if constexpr (SP2) {
        PG8_STAGE(PG8_SB(0, 0), cB, voffB); PG8_STAGE(PG8_SB(0, 1), cB + hstepB, voffB); PG8_STAGE(PG8_SA(0, 0), cA, voffA); PG8_STAGE(PG8_SA(0, 1), cA + hstepA, voffA);
        if (wr == 1) PG8_BAR;
        PG8_WAIT_V(2); PG8_BAR;
        PG8_STAGE(PG8_SB(1, 0), cB + kstep, voffB); PG8_STAGE(PG8_SA(1, 0), cA + kstep, voffA); PG8_STAGE(PG8_SB(1, 1), cB + hstepB + kstep, voffB);
        PG8_WAIT_V(6); PG8_BAR;
    } else {
        PG8_STAGE(PG8_SB(0, 0), cB, voffB); PG8_STAGE(PG8_SA(0, 0), cA, voffA); PG8_STAGE(PG8_SB(0, 1), cB + hstepB, voffB); PG8_STAGE(PG8_SA(0, 1), cA + hstepA, voffA);
        if (wr == 1) PG8_BAR;
        PG8_WAIT_V(4); PG8_BAR;
        PG8_STAGE(PG8_SB(1, 0), cB + kstep, voffB); PG8_STAGE(PG8_SA(1, 0), cA + kstep, voffA); PG8_STAGE(PG8_SB(1, 1), cB + hstepB + kstep, voffB);
        PG8_WAIT_V(6); PG8_BAR;
    }
    for (;;) {
        const bool has_next = S.next(ui + 1, nxt);
        const char* nA = has_next ? (const char*)g.A + (size_t)nxt.pm * tstepA : cA; const char* nB = has_next ? (const char*)g.Bt + (size_t)nxt.pn * tstepB : cB;
        for (int t = 0; t < nt; t += 2) {
            const bool last = (t == nt - 2);
            const char* a1 = cA + (size_t)(t + 1) * kstep;
            const char* a2 = last ? nA : cA + (size_t)(t + 2) * kstep; const char* b2 = last ? nB : cB + (size_t)(t + 2) * kstep;
            const char* a3 = a2 + kstep; const char* b3 = b2 + kstep;
            if constexpr (Epi::KSCALE) { if (E.yss != nullptr && (t == 8 || t == 20)) E.kscale(acc, cur, t, tid); }
            if constexpr (SP2) {
            PG8_LDB(B0, 0, 0); PG8_LDB(B1, 0, 1); PG8_SCHED; PG8_LDA(At, 0, 0); PG8_STAGE(PG8_SA(1, 1), a1 + hstepA, voffA);
            PG8_WAIT_V(8); PG8_WAIT_L(0); PG8_BAR; PG8_MMA(0, 0, At, B0); PG8_MMA(0, 1, At, B1); PG8_BAR; PG8_SCHED;
            PG8_LDA(At, 0, 1); PG8_STAGE(PG8_SB(0, 0), b2, voffB); PG8_STAGE(PG8_SB(0, 1), b2 + hstepB, voffB); PG8_STAGE(PG8_SA(0, 0), a2, voffA);
            PG8_WAIT_V(8); PG8_WAIT_L(0); PG8_BAR; PG8_MMA(1, 0, At, B0); PG8_MMA(1, 1, At, B1); PG8_BAR; PG8_SCHED;
            PG8_LDB(B0, 1, 0); PG8_LDB(B1, 1, 1); PG8_SCHED; PG8_LDA(At, 1, 0); PG8_STAGE(PG8_SA(0, 1), a2 + hstepA, voffA);
            PG8_WAIT_V(8); PG8_WAIT_L(0); PG8_BAR; PG8_MMA(0, 0, At, B0); PG8_MMA(0, 1, At, B1); PG8_BAR; PG8_SCHED;
            PG8_LDA(At, 1, 1); PG8_STAGE(PG8_SB(1, 0), b3, voffB); PG8_STAGE(PG8_SB(1, 1), b3 + hstepB, voffB); PG8_STAGE(PG8_SA(1, 0), a3, voffA);
            PG8_WAIT_V(8); PG8_WAIT_L(0); PG8_BAR; PG8_MMA(1, 0, At, B0); PG8_MMA(1, 1, At, B1); PG8_BAR; PG8_SCHED;
            } else {
            PG8_LDB(B0, 0, 0); PG8_SCHED; PG8_LDA(At, 0, 0); PG8_STAGE(PG8_SA(1, 1), a1 + hstepA, voffA);
            PG8_WAIT_L(8); PG8_BAR; PG8_WAIT_L(0); PG8_MMA(0, 0, At, B0); PG8_BAR; PG8_SCHED;
            PG8_LDB(B1, 0, 1); PG8_STAGE(PG8_SB(0, 0), b2, voffB);
            PG8_BAR; PG8_WAIT_L(0); PG8_MMA(0, 1, At, B1); PG8_BAR;
            PG8_LDA(At, 0, 1); PG8_STAGE(PG8_SA(0, 0), a2, voffA);
            PG8_BAR; PG8_WAIT_L(0); PG8_MMA(1, 0, At, B0); PG8_BAR; PG8_SCHED;
            PG8_STAGE(PG8_SB(0, 1), b2 + hstepB, voffB);
            PG8_WAIT_V(6); PG8_BAR; PG8_MMA(1, 1, At, B1); PG8_BAR;
            PG8_LDB(B0, 1, 0); PG8_SCHED; PG8_LDA(At, 1, 0); PG8_STAGE(PG8_SA(0, 1), a2 + hstepA, voffA);
            PG8_WAIT_L(8); PG8_BAR; PG8_WAIT_L(0); PG8_MMA(0, 0, At, B0); PG8_BAR; PG8_SCHED;
            PG8_LDB(B1, 1, 1); PG8_STAGE(PG8_SB(1, 0), b3, voffB);
            PG8_BAR; PG8_WAIT_L(0); PG8_MMA(0, 1, At, B1); PG8_BAR;
            PG8_LDA(At, 1, 1); PG8_STAGE(PG8_SA(1, 0), a3, voffA);
            PG8_BAR; PG8_WAIT_L(0); PG8_MMA(1, 0, At, B0); PG8_BAR; PG8_SCHED;
            PG8_STAGE(PG8_SB(1, 1), b3 + hstepB, voffB);
            PG8_WAIT_V(6); PG8_BAR; PG8_MMA(1, 1, At, B1); PG8_BAR;
            }
        }
        if constexpr (ALIGN_EPI) { if (wr == 0) PG8_BAR; }
        E(acc, cur, tid);
        if (!has_next) break;
#pragma unroll
        for (int a = 0; a < 2; ++a)
#pragma unroll
            for (int b = 0; b < 2; ++b)
#pragma unroll
                for (int m = 0; m < 4; ++m)
#pragma unroll
                    for (int n = 0; n < 2; ++n) acc[a][b][m][n] = (f32x4){0.f, 0.f, 0.f, 0.f};
        cur = nxt; cA = nA; cB = nB; ++ui;
        if constexpr (ALIGN_EPI) { if (wr == 1) PG8_BAR; }
    }
    PG8_WAIT_V(0);
    if constexpr (!ALIGN_EPI) { if (wr == 0) PG8_BAR; }
    PG8_BAR;
#undef PG8_SA
#undef PG8_SB
#undef PG8_STAGE
#undef PG8_LDA
#undef PG8_LDB
#undef PG8_MMA
#undef PG8_WAIT_V
#undef PG8_WAIT_L
#undef PG8_BAR
#undef PG8_SCHED
}
}

namespace att {
constexpr int KVBLK = 64, QBLK = 32;
constexpr float THR = 8.f;
#define SBAR() __builtin_amdgcn_sched_barrier(0)
__device__ __forceinline__ int crow(int r, int hi) { return (r & 3) + 8 * (r >> 2) + 4 * hi; }
__device__ __forceinline__ float dbias(int d) {
    const int ad = d < 0 ? -d : d;
    const int c = (ad <= 64 ? 1 : 0) + ((((d & 3) == 0) && ad <= 256) ? 1 : 0) + ((((d & 15) == 0) && ad <= 1024) ? 1 : 0);
    return c == 0 ? -__builtin_inff() : (c == 1 ? 0.f : (c == 2 ? 1.f : 1.5849625007211562f));
}
template <bool MASK>
__device__ __forceinline__ void partialSM(f32x16& p0, f32x16& p1, float& m_reg, float& mn, float& alpha, const float C, const float thr, const int dbase, const int dwave, const LAS float* tb) {
    if constexpr (MASK) {
        if ((dwave - 31 > 256 && dwave + 63 <= 1024) || (dwave + 63 < -256 && dwave - 31 >= -1024)) {
            const int tl = dbase & 15; const float ninf = -__builtin_inff();
#pragma unroll
            for (int r = 0; r < 8; ++r) { const bool hit = tl == ((16 - ((r & 3) + 8 * (r >> 2))) & 15);
                p0[r] = hit ? p0[r] * C : ninf; p0[r + 8] = hit ? p0[r + 8] * C : ninf; p1[r] = hit ? p1[r] * C : ninf; p1[r + 8] = hit ? p1[r + 8] * C : ninf; }
        } else {
            { const LAS float* tl_ = tb + dbase;
#pragma unroll
              for (int r = 0; r < 16; ++r) { const int c = (r & 3) + 8 * (r >> 2); p0[r] = fmaf(p0[r], C, tl_[c]); p1[r] = fmaf(p1[r], C, tl_[c + 32]); } }
        }
        float pmax = p0[0];
#pragma unroll
        for (int r = 1; r < 16; ++r) pmax = fmaxf(pmax, p0[r]);
#pragma unroll
        for (int r = 0; r < 16; ++r) pmax = fmaxf(pmax, p1[r]);
        { auto rr = __builtin_amdgcn_permlane32_swap(__float_as_uint(pmax), __float_as_uint(pmax), false, false);
          pmax = fmaxf(__uint_as_float(rr[0]), __uint_as_float(rr[1])); }
        if (__builtin_expect(__all(pmax - m_reg <= thr), 1)) { mn = m_reg; alpha = 1.f; }
        else { mn = fmaxf(m_reg, pmax); alpha = __builtin_amdgcn_exp2f(m_reg - mn); m_reg = mn; }
#pragma unroll
        for (int r = 0; r < 16; ++r) { p0[r] = p0[r] - mn; p1[r] = p1[r] - mn; }
#pragma unroll
        for (int r = 0; r < 16; ++r) p0[r] = __builtin_amdgcn_exp2f(p0[r]);
    } else {
        float pmax = p0[0];
#pragma unroll
        for (int r = 1; r < 16; ++r) pmax = fmaxf(pmax, p0[r]);
#pragma unroll
        for (int r = 0; r < 16; ++r) pmax = fmaxf(pmax, p1[r]);
        { auto rr = __builtin_amdgcn_permlane32_swap(__float_as_uint(pmax), __float_as_uint(pmax), false, false);
          pmax = fmaxf(__uint_as_float(rr[0]), __uint_as_float(rr[1])); }
        if (__builtin_expect(__all(pmax - m_reg <= thr), 1)) { mn = m_reg; alpha = 1.f; }
        else { mn = fmaxf(m_reg, pmax); alpha = __builtin_amdgcn_exp2f((m_reg - mn) * C); m_reg = mn; }
        const float mnC = -mn * C;
#pragma unroll
        for (int r = 0; r < 16; ++r) p0[r] = fmaf(p0[r], C, mnC);
#pragma unroll
        for (int r = 0; r < 16; ++r) p1[r] = fmaf(p1[r], C, mnC);
#pragma unroll
        for (int r = 0; r < 16; ++r) p0[r] = __builtin_amdgcn_exp2f(p0[r]);
    }
}
__device__ __forceinline__ void finishSM(f32x16& p0, f32x16& p1, float alpha, float& l_reg, bf16x8& pa0, bf16x8& pa1, bf16x8& pa2, bf16x8& pa3) {
#pragma unroll
    for (int r = 0; r < 16; ++r) p1[r] = __builtin_amdgcn_exp2f(p1[r]);
    float ps = 0;
#pragma unroll
    for (int r = 0; r < 16; ++r) ps += p0[r];
#pragma unroll
    for (int r = 0; r < 16; ++r) ps += p1[r];
    { auto rr = __builtin_amdgcn_permlane32_swap(__float_as_uint(ps), __float_as_uint(ps), false, false);
      ps = __uint_as_float(rr[0]) + __uint_as_float(rr[1]); }
    l_reg = l_reg * alpha + ps;
#define PK4(P, BASE, OUT) do { unsigned a0 = cvt_pk_bf16(P[BASE + 0], P[BASE + 1]), a1 = cvt_pk_bf16(P[BASE + 2], P[BASE + 3]);   \
    unsigned b0 = cvt_pk_bf16(P[BASE + 4], P[BASE + 5]), b1 = cvt_pk_bf16(P[BASE + 6], P[BASE + 7]);                              \
    auto r0 = __builtin_amdgcn_permlane32_swap(a0, b0, false, false); auto r1 = __builtin_amdgcn_permlane32_swap(a1, b1, false, false); \
    u32x4 w = {r0[0], r1[0], r0[1], r1[1]}; OUT = __builtin_bit_cast(bf16x8, w); } while (0)
    PK4(p0, 0, pa0); PK4(p0, 8, pa1); PK4(p1, 0, pa2); PK4(p1, 8, pa3);
#undef PK4
}
template <int DK>
__device__ __forceinline__ void qkt(f32x16& p0, f32x16& p1, const LAS char* Ks, const bf16x8* qr, const int (&kb)[4], int hi, const LAS char* lds0, unsigned qoff) {
    constexpr int RB = DK * 2;
    p0 = f32x16{}; p1 = f32x16{};
    if constexpr (DK == 128) {
#pragma unroll
        for (int d0 = 0; d0 < 8; ++d0) {
            const bf16x8 b0 = *(const LAS bf16x8*)(Ks + kb[d0 & 3] + (d0 >> 2) * 128);
            const bf16x8 b1 = *(const LAS bf16x8*)(Ks + kb[d0 & 3] + (d0 >> 2) * 128 + 32 * RB);
            p0 = __builtin_amdgcn_mfma_f32_32x32x16_bf16(b0, qr[d0], p0, 0, 0, 0);
            p1 = __builtin_amdgcn_mfma_f32_32x32x16_bf16(b1, qr[d0], p1, 0, 0, 0); }
    } else {
        asm volatile("" : "+v"(qoff));
        bf16x8 b0[2][2], b1[2][2], q[2][2];
#define QK_LD(g, s) do { _Pragma("unroll") for (int e = 0; e < 2; ++e) { const int d0 = 2 * (g) + e; \
            b0[s][e] = *(const LAS bf16x8*)(Ks + kb[d0 & 3] + (d0 >> 2) * 128); b1[s][e] = *(const LAS bf16x8*)(Ks + kb[d0 & 3] + (d0 >> 2) * 128 + 32 * RB); \
            if (d0 >= 6) q[s][e] = *(const LAS bf16x8*)(lds0 + qoff + (d0 - 6) * 1024); } } while (0)
#define QK_MM(g, s) do { _Pragma("unroll") for (int e = 0; e < 2; ++e) { const int d0 = 2 * (g) + e; \
            if (d0 >= 6) { p0 = __builtin_amdgcn_mfma_f32_32x32x16_bf16(b0[s][e], q[s][e], p0, 0, 0, 0); p1 = __builtin_amdgcn_mfma_f32_32x32x16_bf16(b1[s][e], q[s][e], p1, 0, 0, 0); } \
            else { p0 = __builtin_amdgcn_mfma_f32_32x32x16_bf16(b0[s][e], qr[d0], p0, 0, 0, 0); p1 = __builtin_amdgcn_mfma_f32_32x32x16_bf16(b1[s][e], qr[d0], p1, 0, 0, 0); } } } while (0)
        QK_LD(0, 0); SBAR();
        QK_LD(1, 1); SBAR(); QK_MM(0, 0); SBAR();
        QK_LD(2, 0); SBAR(); QK_MM(1, 1); SBAR();
        QK_LD(3, 1); SBAR(); QK_MM(2, 0); SBAR();
        QK_LD(4, 0); SBAR(); QK_MM(3, 1); SBAR();
        QK_LD(5, 1); SBAR(); QK_MM(4, 0); SBAR();
        QK_MM(5, 1); SBAR();
#undef QK_LD
#undef QK_MM
    }
}
__device__ __forceinline__ int v_st(int k, int c) { const int kk = (k & ~0xC) | ((k & 4) << 1) | ((k & 8) >> 1); return ((kk >> 3) * 4 + (c >> 5)) * 512 + ((kk & 7) * 32 + (c & 31)) * 2; }
__device__ __forceinline__ int v_rd_base(int lane) { return ((lane & 3) << 3) | (((lane >> 2) & 3) << 6) | (((lane >> 4) & 1) << 5) | (((lane >> 5) & 1) << 8); }
constexpr int v_rd_off(int d0, int ks, int half) { return d0 * 512 + ks * 4096 + half * 2048; }
template <int OFF> __device__ __forceinline__ s16x4 tr_read(int vb) {
    s16x4 r; asm volatile("ds_read_b64_tr_b16 %0, %1 offset:%2" : "=&v"(r) : "v"(vb), "i"(OFF) : "memory"); return r;
}
template <int D0> __device__ __forceinline__ void pv_one(f32x16& od, int vb, bf16x8 pa0, bf16x8 pa1, bf16x8 pa2, bf16x8 pa3) {
    const s16x4 l0 = tr_read<v_rd_off(D0, 0, 0)>(vb), h0 = tr_read<v_rd_off(D0, 0, 1)>(vb), l1 = tr_read<v_rd_off(D0, 1, 0)>(vb), h1 = tr_read<v_rd_off(D0, 1, 1)>(vb);
    const s16x4 l2 = tr_read<v_rd_off(D0, 2, 0)>(vb), h2 = tr_read<v_rd_off(D0, 2, 1)>(vb), l3 = tr_read<v_rd_off(D0, 3, 0)>(vb), h3 = tr_read<v_rd_off(D0, 3, 1)>(vb);
    asm volatile("s_waitcnt lgkmcnt(0)" ::: "memory"); SBAR();
#define PKV(L, H) (bf16x8){L[0], L[1], L[2], L[3], H[0], H[1], H[2], H[3]}
    od = __builtin_amdgcn_mfma_f32_32x32x16_bf16(pa0, PKV(l0, h0), od, 0, 0, 0);
    od = __builtin_amdgcn_mfma_f32_32x32x16_bf16(pa1, PKV(l1, h1), od, 0, 0, 0);
    od = __builtin_amdgcn_mfma_f32_32x32x16_bf16(pa2, PKV(l2, h2), od, 0, 0, 0);
    od = __builtin_amdgcn_mfma_f32_32x32x16_bf16(pa3, PKV(l3, h3), od, 0, 0, 0);
#undef PKV
}
__device__ __forceinline__ void pv_d0(f32x16* o, int vb, bf16x8 pa0, bf16x8 pa1, bf16x8 pa2, bf16x8 pa3) {
    pv_one<0>(o[0], vb, pa0, pa1, pa2, pa3); pv_one<1>(o[1], vb, pa0, pa1, pa2, pa3); pv_one<2>(o[2], vb, pa0, pa1, pa2, pa3); pv_one<3>(o[3], vb, pa0, pa1, pa2, pa3);
}

template <int DK, bool MASK, int SDEPTH>
__device__ __forceinline__ void attn_unit(const bf16_t* __restrict__ Qb, const int ldq, const bf16_t* __restrict__ Kh, const int ldk, const bf16_t* __restrict__ Vh, const int ldv,
                                          bf16_t* __restrict__ Ob, const int ldo, const int NT, const float scale, LAS char* lds, const f32x2* __restrict__ ropeA, const int qpos0, const int dq0, const int tid, u64* __restrict__ yss) {
    constexpr int RB = DK * 2, SHM_V = KVBLK * 128 * 2, SHM_K = KVBLK * RB;
    const int wid = tid >> 6, lane = tid & 63, r32 = lane & 31, hi = lane >> 5;
    LAS char* V_lds = lds; LAS char* K_lds = lds + 2 * SHM_V;
    const float C = scale * 1.4426950408889634f;
    const float thr = MASK ? THR * 1.4426950408889634f : THR / scale;
    float m_reg = -1e30f, l_reg = 0; f32x16 o[4] = {}; bf16x8 qr[(DK == 192) ? 6 : 8];
    const unsigned qoff = 2 * SHM_V + 2 * SHM_K + 2048 + wid * 6144 + lane * 16;
    int kb[4];
#pragma unroll
    for (int k = 0; k < 4; ++k) kb[k] = r32 * RB + ((hi ^ (r32 & 1)) << 4) + ((k ^ ((r32 & 7) >> 1)) << 5);
    int tq = tid; asm volatile("" : "+v"(tq));
    const bf16_t* Qw = Qb + (size_t)(unsigned)(((tq >> 6) * QBLK + (tq & 31)) * ldq + ((tq >> 5) & 1) * 8);
    constexpr int NQR = (DK == 192) ? 6 : 8;
#pragma unroll
    for (int d0 = 0; d0 < NQR; ++d0) qr[d0] = *(const bf16x8*)(Qw + d0 * 16);
    if constexpr (DK == 192) {
        *(LAS bf16x8*)(lds + qoff) = *(const bf16x8*)(Qw + 6 * 16); *(LAS bf16x8*)(lds + qoff + 1024) = *(const bf16x8*)(Qw + 7 * 16);
        const f32x2* rp = ropeA + (size_t)(unsigned)((qpos0 + (tq >> 6) * QBLK + (tq & 31)) * 32 + ((tq >> 5) & 1) * 8);
#pragma unroll
        for (int dd = 0; dd < 2; ++dd) {
            bf16x8 x1 = *(const bf16x8*)(Qw + (8 + dd) * 16), x2 = *(const bf16x8*)(Qw + (10 + dd) * 16);
#pragma unroll
            for (int e = 0; e < 8; ++e) { const f32x2 cs = rp[dd * 16 + e]; const float a = bf2f((unsigned short)x1[e]), b = bf2f((unsigned short)x2[e]);
                x1[e] = (short)f2bf(a * cs.x - b * cs.y); x2[e] = (short)f2bf(b * cs.x + a * cs.y); }
            *(LAS bf16x8*)(lds + qoff + (2 + dd) * 1024) = x1; *(LAS bf16x8*)(lds + qoff + (4 + dd) * 1024) = x2;
        }
        asm volatile("s_waitcnt lgkmcnt(0)" ::: "memory");
    }
    const LAS float* tbias = (const LAS float*)(lds + 69632) + 1344;
    if constexpr (MASK) { for (int i = tid; i < 2688; i += 512) *(LAS float*)(lds + 69632 + 4 * i) = dbias(i - 1344); }
    const int sr = tid >> 4, sc = (tid & 15) * 8, vst0 = v_st(sr, sc); constexpr int vst1d = 8192;
    const int kst0 = sr * RB + ((sc * 2) ^ ((sr & 7) << 4));
    const int kr2 = tid >> 3, kc2 = 128 + (tid & 7) * 8, kst2 = kr2 * RB + ((kc2 * 2) ^ ((kr2 & 7) << 4));
    const int vb0 = (int)(uintptr_t)V_lds + v_rd_base(lane);
    bf16x8 vs0[SDEPTH], vs1[SDEPTH], ks0[SDEPTH], ks1[SDEPTH], ks2[SDEPTH];
    const unsigned voV0 = (unsigned)(sr * ldv + sc) * 2u, voK0 = (unsigned)(sr * ldk + sc) * 2u, voK2 = (unsigned)(kr2 * ldk + kc2) * 2u;
#define SLOAD(i, k0) do { const char* Vt = (const char*)Vh + (size_t)(k0) * (size_t)(ldv * 2); const char* Kt = (const char*)Kh + (size_t)(k0) * (size_t)(ldk * 2); \
    vs0[i] = *(const bf16x8*)(Vt + (size_t)voV0); vs1[i] = *(const bf16x8*)(Vt + (size_t)(ldv * 64) + (size_t)voV0); \
    ks0[i] = *(const bf16x8*)(Kt + (size_t)voK0); ks1[i] = *(const bf16x8*)(Kt + (size_t)(ldk * 64) + (size_t)voK0); \
    if constexpr (DK == 192) ks2[i] = *(const bf16x8*)(Kt + (size_t)voK2); } while (0)
#define SWRITE(b, i) do { *(LAS bf16x8*)(V_lds + (b) * SHM_V + vst0) = vs0[i]; *(LAS bf16x8*)(V_lds + (b) * SHM_V + vst1d + vst0) = vs1[i]; \
    *(LAS bf16x8*)(K_lds + (b) * SHM_K + kst0) = ks0[i]; *(LAS bf16x8*)(K_lds + (b) * SHM_K + 32 * RB + kst0) = ks1[i]; \
    if constexpr (DK == 192) *(LAS bf16x8*)(K_lds + (b) * SHM_K + kst2) = ks2[i]; } while (0)
#define SWAIT() do { if constexpr (SDEPTH == 2) { if constexpr (DK == 192) asm volatile("s_waitcnt vmcnt(5)" ::: "memory"); else asm volatile("s_waitcnt vmcnt(4)" ::: "memory"); } \
    else asm volatile("s_waitcnt vmcnt(0)" ::: "memory"); } while (0)
#define RESC(a) do { if (__any((a) < 1.f)) { int t3 = tid; asm volatile("" : "+v"(t3)); LAS float* al3 = (LAS float*)(lds + 2 * SHM_V + 2 * SHM_K) + (t3 >> 6) * 64 + 32; \
    if (((t3 >> 5) & 1) == 0) al3[t3 & 31] = (a); asm volatile("s_waitcnt lgkmcnt(0)" ::: "memory"); const LAS float* ar3 = al3 + 4 * ((t3 >> 5) & 1); \
    _Pragma("unroll") for (int d = 0; d < 4; ++d) _Pragma("unroll") for (int r = 0; r < 16; ++r) o[d][r] *= ar3[(r & 3) + 8 * (r >> 2)]; } } while (0)
    f32x16 pA0, pA1, pB0, pB1; float mnA, mnB, alA, alB; bf16x8 pa0, pa1, pa2, pa3;
    const int dw0 = dq0 - __builtin_amdgcn_readfirstlane(wid) * QBLK;
    const int db0 = dq0 + 4 * hi - (wid * QBLK + r32);
    constexpr int SE = 0, SO = SDEPTH - 1;
    SLOAD(SE, 0); asm volatile("s_waitcnt vmcnt(0)" ::: "memory"); SWRITE(0, SE); __syncthreads();
    qkt<DK>(pA0, pA1, K_lds, qr, kb, hi, lds, qoff); partialSM<MASK>(pA0, pA1, m_reg, mnA, alA, C, thr, db0, dw0, tbias);
    SLOAD(SO, KVBLK); if constexpr (SDEPTH == 2) { if (2 < NT) SLOAD(SE, 2 * KVBLK); }
    SWAIT(); SWRITE(1, SO); __syncthreads();
    for (int j = 1; j + 1 < NT; j += 2) {
        SBAR(); qkt<DK>(pB0, pB1, K_lds + SHM_K, qr, kb, hi, lds, qoff);
        finishSM(pA0, pA1, alA, l_reg, pa0, pa1, pa2, pa3); SBAR();
        SLOAD(SO, (j + SDEPTH) * KVBLK); SBAR();
        pv_d0(o, vb0, pa0, pa1, pa2, pa3); partialSM<MASK>(pB0, pB1, m_reg, mnB, alB, C, thr, db0 + j * KVBLK, dw0 + j * KVBLK, tbias);
        __syncthreads(); SWAIT(); SWRITE(0, SE);
        RESC(alB); __syncthreads();
        SBAR(); qkt<DK>(pA0, pA1, K_lds, qr, kb, hi, lds, qoff);
        finishSM(pB0, pB1, alB, l_reg, pa0, pa1, pa2, pa3); SBAR();
        if (SDEPTH == 1 || j + 3 < NT) SLOAD(SE, (j + 1 + SDEPTH) * KVBLK); SBAR();
        pv_d0(o, vb0 + SHM_V, pa0, pa1, pa2, pa3); partialSM<MASK>(pA0, pA1, m_reg, mnA, alA, C, thr, db0 + (j + 1) * KVBLK, dw0 + (j + 1) * KVBLK, tbias);
        __syncthreads(); SWAIT(); SWRITE(1, SO);
        RESC(alA); __syncthreads();
    }
    SBAR(); qkt<DK>(pB0, pB1, K_lds + SHM_K, qr, kb, hi, lds, qoff);
    finishSM(pA0, pA1, alA, l_reg, pa0, pa1, pa2, pa3); SBAR();
    pv_d0(o, vb0, pa0, pa1, pa2, pa3); partialSM<MASK>(pB0, pB1, m_reg, mnB, alB, C, thr, db0 + (NT - 1) * KVBLK, dw0 + (NT - 1) * KVBLK, tbias);
    __syncthreads(); RESC(alB);
    finishSM(pB0, pB1, alB, l_reg, pa0, pa1, pa2, pa3); SBAR();
    pv_d0(o, vb0 + SHM_V, pa0, pa1, pa2, pa3);
    int to = tid; asm volatile("" : "+v"(to));
    { LAS float* li3 = (LAS float*)(lds + 2 * SHM_V + 2 * SHM_K) + (to >> 6) * 64;
      if (((to >> 5) & 1) == 0) li3[to & 31] = l_reg; asm volatile("s_waitcnt lgkmcnt(0)" ::: "memory"); }
    float rli[16];
    { const LAS float* lr3 = (const LAS float*)(lds + 2 * SHM_V + 2 * SHM_K) + (to >> 6) * 64 + 4 * ((to >> 5) & 1);
#pragma unroll
      for (int r = 0; r < 16; ++r) rli[r] = __builtin_amdgcn_rcpf(lr3[(r & 3) + 8 * (r >> 2)]); }
    const unsigned ooff = (unsigned)((((to >> 6) * QBLK + 4 * ((to >> 5) & 1)) * ldo + (to & 31)) * 2);
    float sq[16];
#pragma unroll
    for (int r = 0; r < 16; ++r) { sq[r] = 0.f;
#pragma unroll
        for (int d0 = 0; d0 < 4; ++d0) { const float v = o[d0][r] * rli[r]; sq[r] += v * v;
            *(bf16_t*)((char*)Ob + (size_t)(ooff + (unsigned)((((r & 3) + 8 * (r >> 2)) * ldo + d0 * 32) * 2))) = f2bf(v); } }
#pragma unroll
    for (int r = 0; r < 16; ++r) {
#pragma unroll
        for (int x = 1; x < 32; x <<= 1) sq[r] += __builtin_bit_cast(float, __builtin_amdgcn_ds_bpermute(((to & 63) ^ x) << 2, __builtin_bit_cast(int, sq[r])));
        if ((to & 31) == r) fx_add(yss + (size_t)((to >> 6) * QBLK + 4 * ((to >> 5) & 1) + (r & 3) + 8 * (r >> 2)) * 4, sq[r]); }
#undef SLOAD
#undef SWRITE
#undef SWAIT
#undef RESC
}
}

struct TrJob { const float* W; bf16_t* WT; const float* gain; int N, Kd, mode, item; };
__device__ __forceinline__ void tr_load(const TrJob& j, int lane, f32x4 (&v)[8]) {
    const int nblk = j.N / 32, kb = j.item / nblk, nb = j.item % nblk, k0 = 64 * kb, n0 = 32 * nb;
    const float* p = j.W + (size_t)(k0 + (lane >> 3)) * j.N + n0 + 4 * (lane & 7);
#pragma unroll
    for (int i = 0; i < 8; ++i) v[i] = *(const f32x4*)(p + (size_t)(8 * i) * j.N);
}
__device__ __forceinline__ void tr_write(LAS float* scr, int lane, const f32x4 (&v)[8]) {
#pragma unroll
    for (int i = 0; i < 8; ++i) { LAS float* d = scr + (8 * i + (lane >> 3)) * 33 + 4 * (lane & 7); d[0] = v[i].x; d[1] = v[i].y; d[2] = v[i].z; d[3] = v[i].w; }
}
__device__ __forceinline__ void tr_store(const TrJob& j, LAS float* scr, int lane) {
    const int nblk = j.N / 32, kb = j.item / nblk, nb = j.item % nblk, k0 = 64 * kb, n0 = 32 * nb;
    const int rb = (j.mode == 0) ? n0 : (256 * (n0 >> 7) + (n0 & 127) + (j.mode == 2 ? 128 : 0));
    const int c = lane & 7;
    f32x4 g0 = {1.f, 1.f, 1.f, 1.f}, g1 = g0;
    if (j.gain) { g0 = *(const f32x4*)(j.gain + k0 + 8 * c); g1 = *(const f32x4*)(j.gain + k0 + 8 * c + 4); }
    asm volatile("s_waitcnt lgkmcnt(0)" ::: "memory");
#pragma unroll
    for (int jj = 0; jj < 4; ++jj) { const int n = (lane >> 3) + 8 * jj; const LAS float* s = scr + (8 * c) * 33 + n;
        u32x4 o; o.x = cvt_pk_bf16(s[0 * 33] * g0.x, s[1 * 33] * g0.y); o.y = cvt_pk_bf16(s[2 * 33] * g0.z, s[3 * 33] * g0.w);
        o.z = cvt_pk_bf16(s[4 * 33] * g1.x, s[5 * 33] * g1.y); o.w = cvt_pk_bf16(s[6 * 33] * g1.z, s[7 * 33] * g1.w);
        *(u32x4*)(j.WT + (size_t)(rb + n) * j.Kd + k0 + 8 * c) = o; }
    asm volatile("s_waitcnt lgkmcnt(0)" ::: "memory");
}

struct Args { const float* in[16]; float* out; unsigned char* ws; int ph_lo, ph_hi; };

constexpr int I_IN = 32 * 146, I_UQ = 8 * 24, I_UKV = 8 * 32, I_OUT = 32 * 64, I_G = 32 * 176, I_DN = 88 * 64;
constexpr int I_LAYER = I_IN + I_UQ + I_UKV + I_OUT + 2 * I_G + I_DN;
constexpr int TR_P0 = I_IN + I_UQ + I_UKV, TR_P1 = I_LAYER + I_IN + I_UQ + I_UKV;
static_assert((TR_P1 - TR_P0) % 16 == 0 && (2 * I_LAYER - TR_P1) % 16 == 0, "filler ranges are whole queue entries");
template <class ArgsT>
__device__ __forceinline__ TrJob tr_job(const ArgsT& a, unsigned char* ws, int it) {
    const int l = it / I_LAYER; int r = it % I_LAYER; unsigned char* wl = ws + WS_W + (size_t)l * W_LAYER;
    const float* W; bf16_t* WT; const float* gain; int N, Kd, mode = 0;
    const float *p1 = a.in[1], *p2 = a.in[2], *p3 = a.in[3], *p4 = a.in[4], *p5 = a.in[5], *p6 = a.in[6], *p9 = a.in[9], *p10 = a.in[10], *p11 = a.in[11], *p12 = a.in[12], *p13 = a.in[13], *p14 = a.in[14];
    asm volatile("" : "+s"(p1), "+s"(p2), "+s"(p3), "+s"(p4), "+s"(p5), "+s"(p6)); asm volatile("" : "+s"(p9), "+s"(p10), "+s"(p11), "+s"(p12), "+s"(p13), "+s"(p14));
    if (r < I_IN) { W = p2 + (size_t)l * DM * INW; WT = (bf16_t*)(wl + W_IN); gain = p1 + l * DM; N = INW; Kd = DM; }
    else if ((r -= I_IN) < I_UQ) { W = p4 + (size_t)l * 512 * 768; WT = (bf16_t*)(wl + W_UQ); gain = p3 + l * 512; N = 768; Kd = 512; }
    else if ((r -= I_UQ) < I_UKV) { W = p6 + (size_t)l * 512 * 1024; WT = (bf16_t*)(wl + W_UKV); gain = p5 + l * 512; N = 1024; Kd = 512; }
    else if ((r -= I_UKV) < I_OUT) { W = p10 + (size_t)l * DM * DM; WT = (bf16_t*)(wl + W_OUT); gain = p9 + l * DM; N = DM; Kd = DM; }
    else if ((r -= I_OUT) < I_G) { W = p12 + (size_t)l * DM * DFF; WT = (bf16_t*)(wl + W_GU); gain = p11 + l * DM; N = DFF; Kd = DM; mode = 1; }
    else if ((r -= I_G) < I_G) { W = p13 + (size_t)l * DM * DFF; WT = (bf16_t*)(wl + W_GU); gain = p11 + l * DM; N = DFF; Kd = DM; mode = 2; }
    else { r -= I_G; W = p14 + (size_t)l * DFF * DM; WT = (bf16_t*)(wl + W_DN); gain = nullptr; N = DM; Kd = DFF; }
    TrJob j; j.W = W; j.WT = WT; j.gain = gain; j.N = N; j.Kd = Kd; j.mode = mode; j.item = r; return j;
}
__device__ __forceinline__ void ph_prologue(const Args& a, LAS unsigned char* lds, int gw, int NGW, int lane, int wave) {
    LAS float* scr = (LAS float*)(lds + wave * 16384);
    unsigned char* ws = a.ws;
    { f32x4 v[8]; int it = gw; TrJob cur = tr_job(a, ws, it < TR_P0 ? it : 0);
      if (it < TR_P0) tr_load(cur, lane, v);
      while (it < TR_P0) {
          const int nit = it + NGW;
          tr_write(scr, lane, v);
          TrJob nxt = cur;
          if (nit < TR_P0) { nxt = tr_job(a, ws, nit); tr_load(nxt, lane, v); }
          tr_store(cur, scr, lane);
          cur = nxt; it = nit;
      } }
    const int gt = gw * 64 + lane, NGT = NGW * 64;
    for (int l = 0; l < 2; ++l) { u32x4* z = (u32x4*)(ws + WS_W + (size_t)l * W_LAYER + W_IN + (size_t)INW * DM * 2);
        for (int i = gt; i < (INP - INW) * DM * 2 / 16; i += NGT) z[i] = (u32x4){0u, 0u, 0u, 0u}; }
    { u64* rss = (u64*)(ws + WS_CTL + RSS_OFF); bf16_t* XB = (bf16_t*)(ws + WS_XN);
      for (int i = gt; i < 3 * T; i += NGT) rss[T + i] = 0ull;
      { u64* yz = (u64*)(ws + WS_CTL + YSS_OFF); for (int i = gt; i < 2 * T * 4; i += NGT) yz[i] = 0ull; }
      { u64* cz = (u64*)(ws + WS_CTL + CSS_OFF); for (int i = gt; i < 2 * T * 2; i += NGT) cz[i] = 0ull; }
      for (int m = gw; m < T; m += NGW) {
          const f32x4* xr = (const f32x4*)(a.in[0] + (size_t)m * DM) + lane; u32x2* o = (u32x2*)(XB + (size_t)m * DM) + lane; float sq = 0.f;
#pragma unroll
          for (int j = 0; j < 8; ++j) { const f32x4 v = xr[64 * j]; sq += (v.x * v.x + v.y * v.y) + (v.z * v.z + v.w * v.w);
              u32x2 w; w.x = cvt_pk_bf16(v.x, v.y); w.y = cvt_pk_bf16(v.z, v.w); o[64 * j] = w; }
          sq = wave_sum(sq, lane); if (lane == 0) rss[m] = (u64)(sq * FXS + 0.5f); } }
    f32x2* ra = (f32x2*)(ws + WS_ROPEA); f32x2* r1 = (f32x2*)(ws + WS_ROPE1);
    for (int i = gt; i < 4096 * 32 + 4096 * 64; i += NGT) {
        int pos, fi; float inv; f32x2* dst;
        if (i < 4096 * 32) { pos = i >> 5; fi = i & 31; inv = __builtin_amdgcn_exp2f(-(float)(2 * fi) * (13.287712379549449f / 64.f)); dst = ra + i; }
        else { const int j = i - 4096 * 32; pos = j >> 6; fi = j & 63; inv = __builtin_amdgcn_exp2f(-(float)(2 * fi) * (13.287712379549449f / 128.f)); dst = r1 + j; }
        const float ang = (float)pos * inv;
        const double rev = (double)ang * 0.15915494309189535; const float fr = (float)(rev - __builtin_rint(rev));
        *dst = (f32x2){__builtin_amdgcn_cosf(fr), __builtin_amdgcn_sinf(fr)};
    }
}

__device__ __forceinline__ void ph_norm_bf16(const float* x, const float* g, bf16_t* out, int gw, int NGW, int lane) {
    for (int m = gw; m < T; m += NGW) {
        const f32x4* xr = (const f32x4*)(x + (size_t)m * DM) + lane; f32x4 v[8]; float s = 0.f;
#pragma unroll
        for (int j = 0; j < 8; ++j) { v[j] = xr[64 * j]; s += (v[j].x * v[j].x + v[j].y * v[j].y) + (v[j].z * v[j].z + v[j].w * v[j].w); }
        const float rs = 1.0f / sqrtf(wave_sum(s, lane) * (1.f / DM) + EPS);
        u32x2* o = (u32x2*)(out + (size_t)m * DM) + lane;
#pragma unroll
        for (int j = 0; j < 8; ++j) { const f32x4 gg = ((const f32x4*)g)[lane + 64 * j]; u32x2 w; w.x = cvt_pk_bf16(v[j].x * rs * gg.x, v[j].y * rs * gg.y); w.y = cvt_pk_bf16(v[j].z * rs * gg.z, v[j].w * rs * gg.w); o[64 * j] = w; }
    }
}
__device__ __forceinline__ void unpack8(const u32x4 w, float (&x)[8]) { x[0] = bflo(w.x); x[1] = bfhi(w.x); x[2] = bflo(w.y); x[3] = bfhi(w.y); x[4] = bflo(w.z); x[5] = bfhi(w.z); x[6] = bflo(w.w); x[7] = bfhi(w.w); }
__device__ __forceinline__ u32x4 pack8(const float (&x)[8]) { u32x4 o; o.x = cvt_pk_bf16(x[0], x[1]); o.y = cvt_pk_bf16(x[2], x[3]); o.z = cvt_pk_bf16(x[4], x[5]); o.w = cvt_pk_bf16(x[6], x[7]); return o; }
__device__ __forceinline__ void ph_final(const bf16_t* xb, float* out, const float* g, int gw, int NGW, int lane) {
    for (int m0 = gw; m0 < T; m0 += 2 * NGW) {
        float v[2][4][8]; float s[2] = {0.f, 0.f};
#pragma unroll
        for (int rr = 0; rr < 2; ++rr) { const int mr = (m0 + rr * NGW < T) ? m0 + rr * NGW : m0; const u32x4* xr = (const u32x4*)(xb + (size_t)mr * DM) + lane;
#pragma unroll
            for (int j = 0; j < 4; ++j) { unpack8(xr[64 * j], v[rr][j]);
#pragma unroll
                for (int e = 0; e < 8; ++e) s[rr] += v[rr][j][e] * v[rr][j][e]; } }
#pragma unroll
        for (int rr = 0; rr < 2; ++rr) { if (m0 + rr * NGW >= T) continue; f32x4* o = (f32x4*)(out + (size_t)(m0 + rr * NGW) * DM) + 2 * lane;
            const float rs = 1.0f / sqrtf(wave_sum(s[rr], lane) * (1.f / DM) + EPS);
#pragma unroll
            for (int j = 0; j < 4; ++j) { const f32x4 g0 = ((const f32x4*)g)[2 * (lane + 64 * j)], g1 = ((const f32x4*)g)[2 * (lane + 64 * j) + 1];
                o[128 * j] = (f32x4){v[rr][j][0] * rs * g0.x, v[rr][j][1] * rs * g0.y, v[rr][j][2] * rs * g0.z, v[rr][j][3] * rs * g0.w};
                o[128 * j + 1] = (f32x4){v[rr][j][4] * rs * g1.x, v[rr][j][5] * rs * g1.y, v[rr][j][6] * rs * g1.z, v[rr][j][7] * rs * g1.w}; } }
    }
}
__device__ __forceinline__ void ph_prep(const Args& a, int l, int gw, int NGW, int lane) {
    bf16_t* PROJ = (bf16_t*)(a.ws + WS_BIG); bf16_t* KA = (bf16_t*)(a.ws + WS_KA);
    const f32x2* ra = (const f32x2*)(a.ws + WS_ROPEA); const f32x2* r1 = (const f32x2*)(a.ws + WS_ROPE1);
    const float* gq = a.in[3] + l * 512; const float* gkv = a.in[5] + l * 512; const float* cqn = a.in[7] + l * 128; const float* ckn = a.in[8] + l * 128;
    const int j8 = lane & 7, hd = lane >> 3;
    for (int m0 = gw; m0 < T; m0 += 2 * NGW) {
#pragma unroll
      for (int rr = 0; rr < 2; ++rr) { const int m = m0 + rr * NGW; if (m >= T) continue;
        bf16_t* P = PROJ + (size_t)m * INP; const int s = m & (SEQ - 1);
        if (lane < 4) {
            float x1[8], x2[8]; unpack8(*(const u32x4*)(P + PA_KR + 8 * lane), x1); unpack8(*(const u32x4*)(P + PA_KR + 32 + 8 * lane), x2);
            const f32x4* cp = (const f32x4*)(ra + s * 32 + 8 * lane);
#pragma unroll
            for (int e2 = 0; e2 < 4; ++e2) { const f32x4 cs = cp[e2];
                const float a0 = x1[2 * e2], b0 = x2[2 * e2], a1 = x1[2 * e2 + 1], b1 = x2[2 * e2 + 1];
                x1[2 * e2] = a0 * cs.x - b0 * cs.y; x2[2 * e2] = b0 * cs.x + a0 * cs.y; x1[2 * e2 + 1] = a1 * cs.z - b1 * cs.w; x2[2 * e2 + 1] = b1 * cs.z + a1 * cs.w; }
            const u32x4 y1 = pack8(x1), y2 = pack8(x2); bf16_t* kp = KA + (size_t)m * 768 + 128 + 8 * lane;
#pragma unroll
            for (int h = 0; h < 4; ++h) { *(u32x4*)(kp + h * 192) = y1; *(u32x4*)(kp + h * 192 + 32) = y2; }
        }
        { const f32x4* cp = (const f32x4*)(r1 + s * 64 + 8 * j8); const f32x4 c0 = cp[0], c1 = cp[1], c2 = cp[2], c3 = cp[3];
#pragma unroll
          for (int pass = 0; pass < 2; ++pass) { const int head = 8 * pass + hd;
              if (head < 12) { bf16_t* hp = P + PB_Q + head * 128 + 8 * j8; float x1[8], x2[8]; unpack8(*(const u32x4*)hp, x1); unpack8(*(const u32x4*)(hp + 64), x2);
                  const float cc[8] = {c0.x, c0.z, c1.x, c1.z, c2.x, c2.z, c3.x, c3.z}, sn[8] = {c0.y, c0.w, c1.y, c1.w, c2.y, c2.w, c3.y, c3.w};
#pragma unroll
                  for (int e = 0; e < 8; ++e) { const float p = x1[e], q = x2[e]; x1[e] = p * cc[e] - q * sn[e]; x2[e] = q * cc[e] + p * sn[e]; }
                  *(u32x4*)hp = pack8(x1); *(u32x4*)(hp + 64) = pack8(x2); } } }
        { const int half = j8 >> 2, jj = j8 & 3; bf16_t* hp = P + PC_Q + hd * 128 + 64 * half + 8 * jj;
          float x1[8], x2[8]; unpack8(*(const u32x4*)hp, x1); unpack8(*(const u32x4*)(hp + 32), x2);
          const f32x4* cp = (const f32x4*)(ra + (half ? (s & 63) : (s >> 6)) * 32 + 8 * jj); const f32x4 c0 = cp[0], c1 = cp[1], c2 = cp[2], c3 = cp[3];
          const float* g = (hd < 6 ? cqn : ckn) + 64 * half + 8 * jj; const f32x4 ga = *(const f32x4*)g, gb = *(const f32x4*)(g + 4), gc = *(const f32x4*)(g + 32), gd = *(const f32x4*)(g + 36);
          float ss = 0.f;
#pragma unroll
          for (int e = 0; e < 8; ++e) ss += x1[e] * x1[e] + x2[e] * x2[e];
          ss += __builtin_bit_cast(float, __builtin_amdgcn_ds_bpermute((lane ^ 1) << 2, __builtin_bit_cast(int, ss)));
          ss += __builtin_bit_cast(float, __builtin_amdgcn_ds_bpermute((lane ^ 2) << 2, __builtin_bit_cast(int, ss)));
          ss += __builtin_bit_cast(float, __builtin_amdgcn_ds_bpermute((lane ^ 4) << 2, __builtin_bit_cast(int, ss)));
          const float rs = 1.0f / sqrtf(ss * (1.f / 128.f) + EPS);
          const float g1[8] = {ga.x, ga.y, ga.z, ga.w, gb.x, gb.y, gb.z, gb.w}, g2[8] = {gc.x, gc.y, gc.z, gc.w, gd.x, gd.y, gd.z, gd.w};
          const float cc[8] = {c0.x, c0.z, c1.x, c1.z, c2.x, c2.z, c3.x, c3.z}, sn[8] = {c0.y, c0.w, c1.y, c1.w, c2.y, c2.w, c3.y, c3.w};
#pragma unroll
          for (int e = 0; e < 8; ++e) { const float p = x1[e] * rs * g1[e], q = x2[e] * rs * g2[e]; x1[e] = p * cc[e] - q * sn[e]; x2[e] = q * cc[e] + p * sn[e]; }
          *(u32x4*)hp = pack8(x1); *(u32x4*)(hp + 32) = pack8(x2); }
      }
    }
}
__device__ __forceinline__ void ph_ynorm(bf16_t* Y, const float* g, int gw, int NGW, int lane) {
    for (int m = gw; m < T; m += NGW) {
        u32x4* p = (u32x4*)(Y + (size_t)m * DM) + lane; float x[4][8]; float sa = 0.f, sb = 0.f, sc = 0.f;
#pragma unroll
        for (int j = 0; j < 4; ++j) { const u32x4 w = p[64 * j];
            x[j][0] = bflo(w.x); x[j][1] = bfhi(w.x); x[j][2] = bflo(w.y); x[j][3] = bfhi(w.y); x[j][4] = bflo(w.z); x[j][5] = bfhi(w.z); x[j][6] = bflo(w.w); x[j][7] = bfhi(w.w);
            float ss = 0.f;
#pragma unroll
            for (int e = 0; e < 8; ++e) ss += x[j][e] * x[j][e];
            if (j == 0) sa += ss; else if (j == 1) sb += ss; else if (j == 2) { if (lane < 32) sb += ss; else sc += ss; } else sc += ss; }
        const float ra_ = 1.0f / sqrtf(wave_sum(sa, lane) * (1.f / 512.f) + EPS), rb_ = 1.0f / sqrtf(wave_sum(sb, lane) * (1.f / 768.f) + EPS), rc_ = 1.0f / sqrtf(wave_sum(sc, lane) * (1.f / 768.f) + EPS);
#pragma unroll
        for (int j = 0; j < 4; ++j) { const float rs = (j == 0) ? ra_ : (j == 1) ? rb_ : (j == 2) ? (lane < 32 ? rb_ : rc_) : rc_;
            const float* gp = g + (lane + 64 * j) * 8; const f32x4 g0 = *(const f32x4*)gp, g1 = *(const f32x4*)(gp + 4);
            u32x4 o; o.x = cvt_pk_bf16(x[j][0] * rs * g0.x, x[j][1] * rs * g0.y); o.y = cvt_pk_bf16(x[j][2] * rs * g0.z, x[j][3] * rs * g0.w);
            o.z = cvt_pk_bf16(x[j][4] * rs * g1.x, x[j][5] * rs * g1.y); o.w = cvt_pk_bf16(x[j][6] * rs * g1.z, x[j][7] * rs * g1.w);
            p[64 * j] = o; }
    }
}

#if defined(__HIP_DEVICE_COMPILE__)
__device__ __forceinline__ void ph_attention(const __attribute__((address_space(4))) Args* ap, int l, LAS unsigned char* lds, const int rep) {
    volatile LAS int* slot = (volatile LAS int*)(lds + LDS_SLOT);
#if !defined(NO_ATT_A)
    for (;;) {
        asm volatile("" : "+s"(ap));
        unsigned char* ws = ap->ws;
        const bf16_t* QA = (const bf16_t*)(ws + WS_QA); const bf16_t* KA = (const bf16_t*)(ws + WS_KA);
        const bf16_t* VA = (const bf16_t*)(ws + WS_VA); bf16_t* Y = (bf16_t*)(ws + WS_XN); const f32x2* ra = (const f32x2*)(ws + WS_ROPEA);
        if (threadIdx.x == 0) *slot = (int)__hip_atomic_fetch_add((unsigned*)(ws + WS_CTL) + 64 * (1 + l + 4 * rep), 1u, __ATOMIC_RELAXED, __HIP_MEMORY_SCOPE_AGENT);
        __syncthreads(); const int u = __builtin_amdgcn_readfirstlane(*slot); __syncthreads();
        if (u >= 256) break;
        int tid = threadIdx.x; asm volatile("" : "+v"(tid));
        const int b = u >> 6, h = (u >> 4) & 3, qb = u & 15; const size_t row = (size_t)b * SEQ + qb * 256;
        att::attn_unit<192, false, 1>(QA + row * 768 + h * 192, 768, KA + (size_t)b * SEQ * 768 + h * 192, 768, VA + (size_t)b * SEQ * 512 + h * 128, 512,
                                      Y + row * DM + h * 128, DM, SEQ / 64, 0.07216878364870322f, (LAS char*)lds, ra, qb * 256, 0, tid, (u64*)(ws + WS_CTL + YSS_OFF) + ((size_t)l * T + row) * 4 + 0);
    }
#endif
    for (;;) {
        asm volatile("" : "+s"(ap));
        unsigned char* ws = ap->ws;
        const bf16_t* PROJ = (const bf16_t*)(ws + WS_BIG); bf16_t* Y = (bf16_t*)(ws + WS_XN);
        if (threadIdx.x == 0) *slot = (int)__hip_atomic_fetch_add((unsigned*)(ws + WS_CTL) + 64 * (3 + l + 4 * rep), 1u, __ATOMIC_RELAXED, __HIP_MEMORY_SCOPE_AGENT);
        __syncthreads(); const int v = __builtin_amdgcn_readfirstlane(*slot); __syncthreads();
        if (v >= 768) break;
        int tid = threadIdx.x; asm volatile("" : "+v"(tid));
#if !defined(NO_ATT_C)
        if (v < 384) { const int b = v / 96, h = (v >> 4) % 6, qb = v & 15, kvh = h / 3; const size_t row = (size_t)b * SEQ + qb * 256;
            att::attn_unit<128, false, 1>(PROJ + row * INP + PC_Q + h * 128, INP, PROJ + (size_t)b * SEQ * INP + PC_K + kvh * 128, INP, PROJ + (size_t)b * SEQ * INP + PC_V + kvh * 128, INP,
                                          Y + row * DM + 1280 + h * 128, DM, SEQ / 64, 0.08838834764831845f, (LAS char*)lds, nullptr, 0, 0, tid, (u64*)(ws + WS_CTL + YSS_OFF) + ((size_t)l * T + row) * 4 + 2);
        } else
#endif
#if !defined(NO_ATT_B)
        { const int w = v - 384, b = w / 96, h = (w >> 4) % 6, qb = w & 15; const size_t row = (size_t)b * SEQ + qb * 256;
            const int q0 = qb * 256, lo = q0 - 1024 < 0 ? 0 : q0 - 1024, hi_ = q0 + 1280 > SEQ ? SEQ : q0 + 1280;
            att::attn_unit<128, true, 1>(PROJ + row * INP + PB_Q + h * 128, INP, PROJ + ((size_t)b * SEQ + lo) * INP + PB_K + h * 128, INP, PROJ + ((size_t)b * SEQ + lo) * INP + PB_V + h * 128, INP,
                                         Y + row * DM + 512 + h * 128, DM, (hi_ - lo) / 64, 0.08838834764831845f, (LAS char*)lds, nullptr, 0, lo - q0, tid, (u64*)(ws + WS_CTL + YSS_OFF) + ((size_t)l * T + row) * 4 + 1);
        }
#endif
        {}
    }
    { const int it0 = (l == 0) ? TR_P0 : TR_P1, it1 = (l == 0) ? TR_P1 : 2 * I_LAYER, nun = (it1 - it0) / 16;
      for (;;) {
        asm volatile("" : "+s"(ap));
        unsigned char* ws = ap->ws;
        if (threadIdx.x == 0) *slot = (int)__hip_atomic_fetch_add((unsigned*)(ws + WS_CTL) + 64 * (9 + l + 2 * rep), 1u, __ATOMIC_RELAXED, __HIP_MEMORY_SCOPE_AGENT);
        __syncthreads(); const int c = __builtin_amdgcn_readfirstlane(*slot); __syncthreads();
        if (c >= nun) break;
        int tid = threadIdx.x; asm volatile("" : "+v"(tid));
        const int lane = tid & 63, wave = __builtin_amdgcn_readfirstlane(tid >> 6);
        const Args a = *ap;
        const TrJob j0 = tr_job(a, ws, it0 + 16 * c + wave), j1 = tr_job(a, ws, it0 + 16 * c + 8 + wave);
        f32x4 v0[8], v1[8]; tr_load(j0, lane, v0); tr_load(j1, lane, v1);
        LAS float* scr = (LAS float*)(lds + wave * 16384);
        tr_write(scr, lane, v0); tr_store(j0, scr, lane);
        tr_write(scr, lane, v1); tr_store(j1, scr, lane);
      } }
}
#endif
#if defined(__HIP_DEVICE_COMPILE__)
typedef const __attribute__((address_space(4))) Args* ArgsP;
template <int PH, int REP = 0>
__device__ __forceinline__ void run_phase(ArgsP ap, LAS unsigned char* lds) {
    asm volatile("" : "+s"(ap));
    const Args a = *ap;
    int tid = threadIdx.x, bid = blockIdx.x, G = gridDim.x; asm volatile("" : "+v"(tid)); asm volatile("" : "+s"(bid), "+s"(G));
    const int lane = tid & 63, wave = __builtin_amdgcn_readfirstlane(tid >> 6);
    const int gw = bid * NWAVES + wave, NGW = G * NWAVES;
    unsigned char* ws = a.ws;
    bf16_t* XN = (bf16_t*)(ws + WS_XN); bf16_t* BIG = (bf16_t*)(ws + WS_BIG); bf16_t* XB2 = (bf16_t*)(ws + WS_QA); u64* rss = (u64*)(ws + WS_CTL + RSS_OFF);
    if constexpr (PH == 0) ph_prologue(a, lds, gw, NGW, lane, wave);
    else if constexpr (PH == NPH - 1) ph_final(XN, a.out, a.in[15], gw, NGW, lane);
    else {
        constexpr int l = (PH - 1) / 6, sp = (PH - 1) % 6; unsigned char* wl = ws + WS_W + (size_t)l * W_LAYER;
        bf16_t* R1 = (bf16_t*)a.out;
        u64* css = (u64*)(ws + WS_CTL + CSS_OFF) + (size_t)l * T * 2;
        if constexpr (sp == 0) { pg8::Gemm g{(l == 0) ? XN : R1, (const bf16_t*)(wl + W_IN), DM, DM}; pg8::StaticOrder S; S.init(T, INP, G, bid);
            pg8::EpiBf E{BIG, nullptr, INP, 0, rss + (2 * l) * T, 1, 1.f / 2048.f, css}; pg8::gemm_phase(lds, g, S, E, tid); }
        else if constexpr (sp == 1) {
            { pg8::Gemm g{BIG + PA_CQ, (const bf16_t*)(wl + W_UQ), INP, 512}; pg8::StaticOrder S; S.init(T, 768, G, bid);
              pg8::EpiBf E{(bf16_t*)(ws + WS_QA), nullptr, 768, 0, css, 2, 1.f / 512.f, nullptr}; pg8::gemm_phase(lds, g, S, E, tid); }
            { pg8::Gemm g{BIG + PA_CKV, (const bf16_t*)(wl + W_UKV), INP, 512}; pg8::StaticOrder S; S.init(T, 1024, G, bid);
              pg8::EpiBf E{(bf16_t*)(ws + WS_KA), (bf16_t*)(ws + WS_VA), 0, 1, css + 1, 2, 1.f / 512.f, nullptr}; pg8::gemm_phase(lds, g, S, E, tid); }
            ph_prep(a, l, gw, NGW, lane);
        }
        else if constexpr (sp == 2) ph_attention(ap, l, lds, REP);
        else if constexpr (sp == 3) { pg8::Gemm g{XN, (const bf16_t*)(wl + W_OUT), DM, DM}; pg8::StaticOrder S; S.init(T, DM, G, bid);
            pg8::EpiRes E{(l == 0) ? a.in[0] : nullptr, (l == 0) ? nullptr : R1, nullptr, XB2, DM, rss + (2 * l + 1) * T, (const u64*)(ws + WS_CTL + YSS_OFF) + (size_t)l * T * 4}; pg8::gemm_phase(lds, g, S, E, tid); }
        else if constexpr (sp == 4) { pg8::Gemm g{XB2, (const bf16_t*)(wl + W_GU), DM, DM}; pg8::StaticOrder S; S.init(T, 2 * DFF, G, bid);
            pg8::EpiBf E{BIG, nullptr, DFF, 2, rss + (2 * l + 1) * T, 1, 1.f / 2048.f, nullptr}; pg8::gemm_phase(lds, g, S, E, tid); }
        else { pg8::Gemm g{BIG, (const bf16_t*)(wl + W_DN), DFF, DFF}; pg8::StaticOrder S; S.init(T, DM, G, bid);
            pg8::EpiRes E{nullptr, XB2, nullptr, (l == 0) ? R1 : XN, DM, (l == 0) ? rss + 2 * T : nullptr, nullptr}; pg8::gemm_phase(lds, g, S, E, tid); }
    }
}

#endif
__global__ void __launch_bounds__(NWAVES * 64, 2) mega_fwd(Args a_unused) {
#if defined(__HIP_DEVICE_COMPILE__)
    extern __shared__ __attribute__((aligned(16))) unsigned char lds_raw[];
    LAS unsigned char* lds = (LAS unsigned char*)lds_raw;
    ArgsP ap = (ArgsP)__builtin_amdgcn_kernarg_segment_ptr();
    const int ph_lo = ap->ph_lo, ph_hi = ap->ph_hi;
    XcdBarrier xbar; xbar.bar = (unsigned*)(ap->ws + WS_CTL) + 4096; xbar.x = 0; xbar.st = (volatile LAS unsigned*)(lds + LDS_SLOT + 16);
    if (ph_hi - ph_lo > 1) {
        if (threadIdx.x < 2) xbar.st[threadIdx.x] = 0u;
        __syncthreads();
        xbar = xcd_barrier_post(xbar.bar, xbar.st);
    }
#define GRID_BAR() do { xcd_barrier(xbar); } while (0)
#define RUN_AGAIN(PH) do { if (ph_lo <= (PH) && (PH) + 1 < ph_hi) { run_phase<PH, 1>(ap, lds); GRID_BAR(); } } while (0)
#define RUN_PHASE(PH) do { if (ph_lo <= (PH) && (PH) < ph_hi) { run_phase<PH>(ap, lds); if ((PH) + 1 < ph_hi) { if ((PH) == 0) { __syncthreads(); cg::this_grid().sync(); } else GRID_BAR(); } } } while (0)
#define PA(PH) do { if (PROBE_ATT) RUN_AGAIN(PH); } while (0)
#define PG(PH) do { if (PROBE_GEMM) RUN_AGAIN(PH); } while (0)
#define PE(PH) do { if (PROBE_ELEM) RUN_AGAIN(PH); } while (0)
    RUN_PHASE(0); PE(0); RUN_PHASE(1); RUN_PHASE(2); RUN_PHASE(3); PA(3); RUN_PHASE(4); RUN_PHASE(5); PG(5); RUN_PHASE(6);
    RUN_PHASE(7); RUN_PHASE(8); RUN_PHASE(9); PA(9); RUN_PHASE(10); RUN_PHASE(11); PG(11); RUN_PHASE(12); RUN_PHASE(13);
#undef RUN_PHASE
#endif
}

extern "C" void kernel_launch(void* const* d_in, const int* in_sizes, int n_in, void* d_out, int out_size, void* d_ws, size_t ws_size, hipStream_t stream) {
    static int grid = 0;
    if (grid == 0) {
        if (n_in != 16 || out_size != T * DM || ws_size < WS_END) { fprintf(stderr, "kernel_launch: unexpected shapes n_in %d out %d ws %zu (need %zu)\n", n_in, out_size, ws_size, (size_t)WS_END); grid = -1; return; }
        int dev = 0, cus = 0, per_cu = 0;
        hipGetDevice(&dev); hipDeviceGetAttribute(&cus, hipDeviceAttributeMultiprocessorCount, dev);
        if (hipFuncSetAttribute((const void*)mega_fwd, hipFuncAttributeMaxDynamicSharedMemorySize, LDS_BYTES) != hipSuccess) { fprintf(stderr, "kernel_launch: hipFuncSetAttribute failed\n"); grid = -1; return; }
        hipOccupancyMaxActiveBlocksPerMultiprocessor(&per_cu, (const void*)mega_fwd, NWAVES * 64, LDS_BYTES);
        (void)hipGetLastError();
        if (per_cu < 1) per_cu = 1;
        grid = cus * 1;
    }
    if (grid < 0) return;
    hipMemsetAsync((char*)d_ws + WS_CTL, 0, 32768, stream);
    Args a{};
    for (int i = 0; i < 16; ++i) a.in[i] = (const float*)d_in[i];
    a.out = (float*)d_out; a.ws = (unsigned char*)d_ws;
#if MK_SINGLE
    a.ph_lo = 0; a.ph_hi = NPH;
    void* args[] = {&a};
    hipError_t e = hipLaunchCooperativeKernel((const void*)mega_fwd, dim3(grid), dim3(NWAVES * 64), args, LDS_BYTES, stream);
    if (e != hipSuccess) fprintf(stderr, "cooperative launch failed: %s (grid %d)\n", hipGetErrorString(e), grid);
#else
    for (int ph = 0; ph < NPH; ++ph) { a.ph_lo = ph; a.ph_hi = ph + 1;
        hipLaunchKernelGGL(mega_fwd, dim3(grid), dim3(NWAVES * 64), LDS_BYTES, stream, a); }
#endif
}
```

```cpp
#include <hip/hip_runtime.h>
#include <hip/hip_cooperative_groups.h>
#include <cstdio>
#include <cstdint>
namespace cg = cooperative_groups;

#ifndef PROBE_ATT
#define PROBE_ATT 0
#endif
#ifndef PROBE_GEMM
#define PROBE_GEMM 0
#endif
#ifndef PROBE_ELEM
#define PROBE_ELEM 0
#endif
#ifndef MK_SINGLE
#define MK_SINGLE 1
#endif

#define LAS __attribute__((address_space(3)))
typedef unsigned short bf16_t;
typedef short bf16x8 __attribute__((ext_vector_type(8)));
typedef short s16x4 __attribute__((ext_vector_type(4)));
typedef float f32x4 __attribute__((ext_vector_type(4)));
typedef float f32x2 __attribute__((ext_vector_type(2)));
typedef float f32x16 __attribute__((ext_vector_type(16)));
typedef unsigned u32x4 __attribute__((ext_vector_type(4)));
typedef unsigned u32x2 __attribute__((ext_vector_type(2)));
typedef unsigned long long u64;
constexpr float FXS = 1048576.f, FXI = 1.f / 1048576.f;
__device__ __forceinline__ void fx_add(u64* p, float v) { atomicAdd(p, (u64)(v * FXS + 0.5f)); }
__device__ __forceinline__ float fx_get(const u64* p) { return (float)(*p) * FXI; }

constexpr int NB = 4, SEQ = 4096, T = NB * SEQ, DM = 2048, INW = 4672, INP = 4864, DFF = 5632;
constexpr int NWAVES = 8;
constexpr int NPH = 14;
constexpr float EPS = 1e-6f;
constexpr int PA_CQ = 0, PA_CKV = 512, PA_KR = 1024, PB_Q = 1088, PB_K = 1856, PB_V = 2624, PC_Q = 3392, PC_K = 4160, PC_V = 4416;

constexpr size_t WS_CTL = 0, CTL_BYTES = 4u << 20;
constexpr size_t RSS_OFF = 512 * 1024;
constexpr size_t YSS_OFF = 1024 * 1024;
constexpr size_t CSS_OFF = 2048 * 1024;
constexpr size_t WS_ROPEA = WS_CTL + CTL_BYTES;
constexpr size_t WS_ROPE1 = WS_ROPEA + (size_t)4096 * 32 * 8;
constexpr size_t WS_W = WS_ROPE1 + (size_t)4096 * 64 * 8;
constexpr size_t W_IN = 0, W_UQ = W_IN + (size_t)INP * DM * 2, W_UKV = W_UQ + (size_t)768 * 512 * 2, W_OUT = W_UKV + (size_t)1024 * 512 * 2,
                 W_GU = W_OUT + (size_t)DM * DM * 2, W_DN = W_GU + (size_t)2 * DFF * DM * 2, W_LAYER = W_DN + (size_t)DM * DFF * 2;
constexpr size_t WS_XN = WS_W + 2 * W_LAYER;
constexpr size_t WS_BIG = WS_XN + (size_t)T * DM * 2;
constexpr size_t BIG_BYTES = (size_t)T * DFF * 2;
constexpr size_t WS_QA = WS_BIG + BIG_BYTES;
constexpr size_t WS_KA = WS_QA + (size_t)T * 768 * 2;
constexpr size_t WS_VA = WS_KA + (size_t)T * 768 * 2;
constexpr size_t WS_END = WS_VA + (size_t)T * 512 * 2;
static_assert((size_t)T * INP * 2 <= BIG_BYTES, "PROJ fits under FF");
static_assert(WS_END <= (size_t)536870912, "workspace map fits 512 MiB");

constexpr int LDS_SLOT = 139264;
constexpr int LDS_BYTES = LDS_SLOT + 256;

__device__ __forceinline__ unsigned cvt_pk_bf16(float lo, float hi) { unsigned r; asm volatile("v_cvt_pk_bf16_f32 %0, %1, %2" : "=v"(r) : "v"(lo), "v"(hi)); return r; }
__device__ __forceinline__ float bf2f(unsigned short b) { return __uint_as_float(((unsigned)b) << 16); }
__device__ __forceinline__ float bflo(unsigned w) { return __uint_as_float(w << 16); }
__device__ __forceinline__ float bfhi(unsigned w) { return __uint_as_float(w & 0xffff0000u); }
__device__ __forceinline__ unsigned short f2bf(float f) { return (unsigned short)(cvt_pk_bf16(f, f) & 0xffffu); }
__device__ __forceinline__ float wave_sum(float v, const int lane) {
#pragma unroll
    for (int o = 1; o < 64; o <<= 1) v += __builtin_bit_cast(float, __builtin_amdgcn_ds_bpermute((lane ^ o) << 2, __builtin_bit_cast(int, v)));
    return v;
}


#define XB_TMO      128
#define XB_XCNT(j)  (256  + 64 * (j))
#define XB_XSUB(j)  (1280 + 64 * (j))
#define XB_XGEN(j)  (2304 + 64 * (j))
#define XB_TOP      3328
#define XB_TOPGEN   3392
#define XCD_BAR_WORDS 3456
#define XB_SPIN_CAP (1u << 18)
__device__ __forceinline__ unsigned xb_ld(unsigned* p)              { return __hip_atomic_load(p, __ATOMIC_RELAXED, __HIP_MEMORY_SCOPE_AGENT); }
__device__ __forceinline__ unsigned xb_add(unsigned* p, unsigned v) { return __hip_atomic_fetch_add(p, v, __ATOMIC_RELAXED, __HIP_MEMORY_SCOPE_AGENT); }
__device__ __forceinline__ unsigned xb_xcc_id() { return (unsigned)__builtin_amdgcn_s_getreg((3 << 11) | 20) & 0xFu; }
#define XB_SPIN(cond, bar) do { unsigned _sp = 0; while (cond) { __builtin_amdgcn_s_sleep(1); \
    if ((++_sp & 255u) == 0u) { if (xb_ld(&(bar)[XB_TMO])) break; if (_sp > XB_SPIN_CAP) { atomicAdd(&(bar)[XB_TMO], 1u); break; } } } } while (0)
struct XcdBarrier { unsigned* bar; unsigned x; volatile LAS unsigned* st; };
__device__ __forceinline__ XcdBarrier xcd_barrier_post(unsigned* bar, volatile LAS unsigned* st) {
    XcdBarrier b; b.bar = bar; b.x = xb_xcc_id(); b.st = st;
    if (threadIdx.x == 0) (void)xb_add(&bar[XB_XCNT(b.x)], 1u);
    return b;
}
__device__ __forceinline__ void xcd_barrier_complete(unsigned* bar, unsigned x, unsigned& nloc, unsigned& nx) {
    const unsigned G = gridDim.x * gridDim.y * gridDim.z;
    unsigned sum, cnt, mine, sp = 0u;
    for (;;) {
        sum = 0u; cnt = 0u; mine = 0u;
#pragma unroll
        for (unsigned j = 0; j < 16; ++j) { const unsigned c = xb_ld(&bar[XB_XCNT(j)]); sum += c; cnt += (c > 0u) ? 1u : 0u; mine = (j == x) ? c : mine; }
        if (sum == G) break;
        __builtin_amdgcn_s_sleep(1);
        if ((++sp & 255u) == 0u) { if (xb_ld(&bar[XB_TMO])) break; if (sp > XB_SPIN_CAP) { atomicAdd(&bar[XB_TMO], 1u); break; } }
    }
    nloc = mine > 0u ? mine : 1u; nx = cnt > 0u ? cnt : 1u;
}
__device__ __forceinline__ void xcd_barrier(const XcdBarrier& b) {
    asm volatile("s_waitcnt vmcnt(0)" ::: "memory");
    __syncthreads();
    if (threadIdx.x == 0) {
        unsigned* bar = b.bar;
        __builtin_amdgcn_s_waitcnt(0);
        unsigned nloc = b.st[0], nx = b.st[1];
        if (nloc == 0u) { xcd_barrier_complete(bar, b.x, nloc, nx); b.st[0] = nloc; b.st[1] = nx; }
        const unsigned old = xb_add(&bar[XB_XSUB(b.x)], 1u);
        const unsigned gen = old / nloc;
        if (old + 1u == (gen + 1u) * nloc) {
            __builtin_amdgcn_fence(__ATOMIC_RELEASE, "agent");
            asm volatile("s_waitcnt vmcnt(0)" ::: "memory");
            const unsigned og = xb_add(&bar[XB_TOP], 1u);
            const unsigned tg = og / nx;
            if (og + 1u == (tg + 1u) * nx) xb_add(&bar[XB_TOPGEN], 1u);
            else XB_SPIN(xb_ld(&bar[XB_TOPGEN]) == tg, bar);
            __builtin_amdgcn_fence(__ATOMIC_ACQUIRE, "agent");
            xb_add(&bar[XB_XGEN(b.x)], 1u);
            asm volatile("s_waitcnt vmcnt(0)" ::: "memory");
        } else {
            XB_SPIN(xb_ld(&bar[XB_XGEN(b.x)]) == gen, bar);
            __builtin_amdgcn_fence(__ATOMIC_ACQUIRE, "agent");
            asm volatile("s_waitcnt vmcnt(0)" ::: "memory");
        }
    }
    __syncthreads();
}

namespace pg8 {
constexpr int BM = 256, BK = 64, HALF = 128, HTB = HALF * BK * 2, STAGE_BYTES = 8 * HTB, NXCD = 8, WGM = 8;
__host__ __device__ __forceinline__ int lds_byte(int r, int c) { const int st = (r >> 4) * 2 + (c >> 5), rr = r & 15, cc = c & 31, ob = rr * 64 + cc * 2; return st * 1024 + (ob ^ (((ob >> 9) & 1) << 5)); }
__host__ __device__ __forceinline__ void stage_rc(int b, int& R, int& C) { const int st = b / 1024, sb = b % 1024, swz = sb ^ (((sb >> 9) & 1) << 5); R = (st >> 1) * 16 + swz / 64; C = (st & 1) * 32 + (swz % 64) / 2; }
__host__ __device__ __forceinline__ int perm32(int rho) { const int n = rho >> 4, i = rho & 15; return 8 * (i >> 2) + 4 * n + (i & 3); }

struct Unit { int pm, pn; };
struct Gemm { const bf16_t* A; const bf16_t* Bt; int lda, K; };

struct StaticOrder {
    int nM, nN, nwg, G, c;
    __device__ void init(int M, int N, int G_, int c_) { nM = M / BM; nN = N / BM; nwg = nM * nN; G = G_; c = c_; }
    __device__ bool next(int i, Unit& u) const {
        const long L = (long)i * G + c; if (L >= nwg) return false;
        int wgid = (int)L; { const int q = nwg / NXCD, r = nwg % NXCD, xcd = wgid % NXCD, off = wgid / NXCD; wgid = (xcd < r ? xcd * (q + 1) : r * (q + 1) + (xcd - r) * q) + off; }
        const int nig = WGM * nN, gid = wgid / nig, fm = gid * WGM, gsz = (nM - fm) < WGM ? (nM - fm) : WGM;
        u.pm = fm + ((wgid % nig) % gsz); u.pn = (wgid % nig) / gsz; return true;
    }
};

struct EpiRes {
    static constexpr bool KSCALE = true;
    static constexpr bool PERM = true;
    const float* base32; const bf16_t* base16; float* out32; bf16_t* out16; int ldc; u64* rss; const u64* yss;
    __device__ __forceinline__ void kscale(f32x4 (&acc)[2][2][4][2], const Unit& u, int t, int tid_) const {
        asm volatile("" : "+v"(tid_)); const int row0 = u.pm * BM + (__builtin_amdgcn_readfirstlane(tid_ >> 6) >> 2) * 64 + (tid_ & 15);
#pragma unroll
        for (int ai = 0; ai < 2; ++ai)
#pragma unroll
            for (int m = 0; m < 4; ++m) { const u64* yq = yss + (size_t)(row0 + ai * HALF + m * 16) * 4 + (t == 8 ? 0 : 1);
                const float wp = (t == 8) ? (1.f / 512.f) : (1.f / 768.f);
                const float vp = fx_get(yq) * wp + 1e-6f, vn = fx_get(yq + 1) * (1.f / 768.f) + 1e-6f;
                const float sc = __builtin_amdgcn_sqrtf(vn * __builtin_amdgcn_rcpf(vp));
#pragma unroll
                for (int bj = 0; bj < 2; ++bj)
#pragma unroll
                    for (int n = 0; n < 2; ++n) acc[ai][bj][m][n] *= sc;
                asm volatile("" ::: "memory"); }
    }
    __device__ __forceinline__ void operator()(const f32x4 (&acc)[2][2][4][2], const Unit& u, int tid_) const {
        asm volatile("" : "+v"(tid_)); const int lane = tid_ & 63, wid_ = __builtin_amdgcn_readfirstlane(tid_ >> 6), wr = wid_ >> 2, wc = wid_ & 3, fr = lane & 15, fq = lane >> 4;
        const int row0 = u.pm * BM + wr * 64 + fr, col0 = u.pn * BM + wc * 32 + 8 * fq;
#pragma unroll
        for (int ai = 0; ai < 2; ++ai)
#pragma unroll
            for (int m = 0; m < 4; ++m) { const size_t off = (size_t)(row0 + ai * HALF + m * 16) * ldc + col0; float ss = 0.f;
                const float rc = yss ? 1.0f / sqrtf(fx_get(yss + (size_t)(row0 + ai * HALF + m * 16) * 4 + 2) * (1.f / 768.f) + 1e-6f) : 1.0f;
#pragma unroll
                for (int bj = 0; bj < 2; ++bj) { f32x4 b0, b1;
                    if (base16) { const u32x4 w = *(const u32x4*)(base16 + off + bj * HALF); b0 = (f32x4){bflo(w.x), bfhi(w.x), bflo(w.y), bfhi(w.y)}; b1 = (f32x4){bflo(w.z), bfhi(w.z), bflo(w.w), bfhi(w.w)}; }
                    else { b0 = *(const f32x4*)(base32 + off + bj * HALF); b1 = *(const f32x4*)(base32 + off + bj * HALF + 4); }
                    const f32x4 v0 = b0 + acc[ai][bj][m][0] * rc, v1 = b1 + acc[ai][bj][m][1] * rc;
                    if (out16) { u32x4 w; w.x = cvt_pk_bf16(v0[0], v0[1]); w.y = cvt_pk_bf16(v0[2], v0[3]); w.z = cvt_pk_bf16(v1[0], v1[1]); w.w = cvt_pk_bf16(v1[2], v1[3]); *(u32x4*)(out16 + off + bj * HALF) = w; }
                    if (out32) { *(f32x4*)(out32 + off + bj * HALF) = v0; *(f32x4*)(out32 + off + bj * HALF + 4) = v1; }
                    ss += (v0[0] * v0[0] + v0[1] * v0[1]) + (v0[2] * v0[2] + v0[3] * v0[3]) + (v1[0] * v1[0] + v1[1] * v1[1]) + (v1[2] * v1[2] + v1[3] * v1[3]); }
                if (rss) {
                    ss += __builtin_bit_cast(float, __builtin_amdgcn_ds_bpermute((lane ^ 16) << 2, __builtin_bit_cast(int, ss)));
                    ss += __builtin_bit_cast(float, __builtin_amdgcn_ds_bpermute((lane ^ 32) << 2, __builtin_bit_cast(int, ss)));
                    if (fq == 0) fx_add(rss + row0 + ai * HALF + m * 16, ss); } }
    }
};
struct EpiBf {
    static constexpr bool KSCALE = false;
    static constexpr bool PERM = true;
    bf16_t* O; bf16_t* O2; int ldc; int mode; const u64* rss; int rstride; float invw; u64* css;
    __device__ __forceinline__ void operator()(const f32x4 (&acc)[2][2][4][2], const Unit& u, int tid_) const {
        asm volatile("" : "+v"(tid_)); const int lane = tid_ & 63, wid_ = __builtin_amdgcn_readfirstlane(tid_ >> 6), wr = wid_ >> 2, wc = wid_ & 3, fr = lane & 15, fq = lane >> 4;
        const int row0 = u.pm * BM + wr * 64 + fr, cw = wc * 32 + 8 * fq;
        if (mode == 2) {
#pragma unroll
            for (int ai = 0; ai < 2; ++ai)
#pragma unroll
                for (int m = 0; m < 4; ++m) { const int r = row0 + ai * HALF + m * 16; bf16_t* rowp = O + (size_t)r * ldc + u.pn * HALF + cw;
                    const float rs = 1.0f / sqrtf(fx_get(rss + (size_t)r * rstride) * invw + 1e-6f);
                    float v[8];
#pragma unroll
                    for (int n = 0; n < 2; ++n)
#pragma unroll
                        for (int j = 0; j < 4; ++j) { const float g = acc[ai][0][m][n][j] * rs, up = acc[ai][1][m][n][j] * rs;
                            const float e = __builtin_amdgcn_exp2f(-g * 1.4426950408889634f); v[n * 4 + j] = g * __builtin_amdgcn_rcpf(1.0f + e) * up; }
                    u32x4 w; w.x = cvt_pk_bf16(v[0], v[1]); w.y = cvt_pk_bf16(v[2], v[3]); w.z = cvt_pk_bf16(v[4], v[5]); w.w = cvt_pk_bf16(v[6], v[7]);
                    *(u32x4*)rowp = w; }
        } else {
#pragma unroll
            for (int ai = 0; ai < 2; ++ai)
#pragma unroll
                for (int m = 0; m < 4; ++m) { const size_t r = (size_t)(row0 + ai * HALF + m * 16);
                    const float rs = rss ? 1.0f / sqrtf(fx_get(rss + r * rstride) * invw + 1e-6f) : 1.0f; float ss = 0.f;
#pragma unroll
                    for (int bj = 0; bj < 2; ++bj) { const f32x4 v0 = acc[ai][bj][m][0] * rs, v1 = acc[ai][bj][m][1] * rs;
                        ss += (v0[0] * v0[0] + v0[1] * v0[1]) + (v0[2] * v0[2] + v0[3] * v0[3]) + (v1[0] * v1[0] + v1[1] * v1[1]) + (v1[2] * v1[2] + v1[3] * v1[3]);
                        u32x4 w; w.x = cvt_pk_bf16(v0[0], v0[1]); w.y = cvt_pk_bf16(v0[2], v0[3]); w.z = cvt_pk_bf16(v1[0], v1[1]); w.w = cvt_pk_bf16(v1[2], v1[3]);
                        bf16_t* p;
                        if (mode == 0) p = O + r * ldc + u.pn * BM + bj * HALF + cw;
                        else p = (bj == 0) ? (O + r * 768 + u.pn * 192 + cw) : (O2 + r * 512 + u.pn * 128 + cw);
                        *(u32x4*)p = w; }
                    if (css != nullptr && u.pn < 4) {
                        ss += __builtin_bit_cast(float, __builtin_amdgcn_ds_bpermute((lane ^ 16) << 2, __builtin_bit_cast(int, ss)));
                        ss += __builtin_bit_cast(float, __builtin_amdgcn_ds_bpermute((lane ^ 32) << 2, __builtin_bit_cast(int, ss)));
                        if (fq == 0) fx_add(css + r * 2 + (u.pn >> 1), ss); } }
        }
    }
};

template <class Epi, class Sched, bool ALIGN_EPI = true, bool SP2 = true>
__device__ __forceinline__ void gemm_phase(LAS unsigned char* lds, const Gemm g, const Sched& S, const Epi& E, const int tid) {
    const int wid = __builtin_amdgcn_readfirstlane(tid >> 6), lane = tid & 63, wr = wid >> 2, wc = wid & 3, fr = lane & 15, fq = lane >> 4;
    const int K = g.K, nt = K / BK, lda = g.lda;
    unsigned voffA[2], voffB[2];
#pragma unroll
    for (int i = 0; i < 2; ++i) { int R, C; stage_rc(tid * 16 + i * 8192, R, C); const int Rb = Epi::PERM ? ((R & ~31) + perm32(R & 31)) : R;
        voffA[i] = (unsigned)(R * lda + C) * 2u; voffB[i] = (unsigned)(Rb * K + C) * 2u; }
    const size_t kstep = (size_t)(BK * 2);
    const size_t hstepA = (size_t)HALF * lda * 2, hstepB = (size_t)HALF * K * 2;
    const size_t tstepA = 2 * hstepA, tstepB = 2 * hstepB;
    const unsigned ldsw = (unsigned)wid * 1024u;
    const int aoff = lds_byte(wr * 64 + fr, fq * 8), boff = lds_byte(wc * 32 + fr, fq * 8);
#define PG8_SA(b, h) (((b) * 2 + (h)) * HTB)
#define PG8_SB(b, h) ((4 + (b) * 2 + (h)) * HTB)
#define PG8_STAGE(bufoff, gbase, voff) do { _Pragma("unroll") for (int _i = 0; _i < 2; ++_i) \
        __builtin_amdgcn_global_load_lds((const unsigned*)((const char*)(gbase) + (voff)[_i]), (LAS unsigned*)(lds + (bufoff) + ldsw + _i * 8192), 16, 0, 0); } while (0)
#define PG8_LDA(dst, b, h) do { _Pragma("unroll") for (int m = 0; m < 4; ++m) _Pragma("unroll") for (int k = 0; k < 2; ++k) dst[m][k] = *(const LAS bf16x8*)(lds + PG8_SA(b, h) + aoff + m * 2048 + k * 1024); } while (0)
#define PG8_LDB(dst, b, h) do { _Pragma("unroll") for (int n = 0; n < 2; ++n) _Pragma("unroll") for (int k = 0; k < 2; ++k) dst[n][k] = *(const LAS bf16x8*)(lds + PG8_SB(b, h) + boff + n * 2048 + k * 1024); } while (0)
#define PG8_MMA(ai, bj, At, Bt) do { __builtin_amdgcn_s_setprio(1); _Pragma("unroll") for (int m = 0; m < 4; ++m) _Pragma("unroll") for (int n = 0; n < 2; ++n) _Pragma("unroll") for (int k = 0; k < 2; ++k) \
        acc[ai][bj][m][n] = __builtin_amdgcn_mfma_f32_16x16x32_bf16(Bt[n][k], At[m][k], acc[ai][bj][m][n], 0, 0, 0); __builtin_amdgcn_s_setprio(0); } while (0)
#define PG8_WAIT_V(n) asm volatile("s_waitcnt vmcnt(" #n ")" ::: "memory")
#define PG8_WAIT_L(n) asm volatile("s_waitcnt lgkmcnt(" #n ")" ::: "memory")
#define PG8_BAR __builtin_amdgcn_s_barrier()
#define PG8_SCHED __builtin_amdgcn_sched_barrier(0)
    Unit cur, nxt; int ui = 0;
    if (!S.next(0, cur)) return;
    f32x4 acc[2][2][4][2];
#pragma unroll
    for (int a = 0; a < 2; ++a)
#pragma unroll
        for (int b = 0; b < 2; ++b)
#pragma unroll
            for (int m = 0; m < 4; ++m)
#pragma unroll
                for (int n = 0; n < 2; ++n) acc[a][b][m][n] = (f32x4){0.f, 0.f, 0.f, 0.f};
    bf16x8 At[4][2], B0[2][2], B1[2][2];
    const char* cA = (const char*)g.A + (size_t)cur.pm * tstepA; const char* cB = (const char*)g.Bt + (size_t)cur.pn * tstepB;
    if constexpr (SP2) {
        PG8_STAGE(PG8_SB(0, 0), cB, voffB); PG8_STAGE(PG8_SB(0, 1), cB + hstepB, voffB); PG8_STAGE(PG8_SA(0, 0), cA, voffA); PG8_STAGE(PG8_SA(0, 1), cA + hstepA, voffA);
        if (wr == 1) PG8_BAR;
        PG8_WAIT_V(2); PG8_BAR;
        PG8_STAGE(PG8_SB(1, 0), cB + kstep, voffB); PG8_STAGE(PG8_SA(1, 0), cA + kstep, voffA); PG8_STAGE(PG8_SB(1, 1), cB + hstepB + kstep, voffB);
        PG8_WAIT_V(6); PG8_BAR;
    } else {
        PG8_STAGE(PG8_SB(0, 0), cB, voffB); PG8_STAGE(PG8_SA(0, 0), cA, voffA); PG8_STAGE(PG8_SB(0, 1), cB + hstepB, voffB); PG8_STAGE(PG8_SA(0, 1), cA + hstepA, voffA);
        if (wr == 1) PG8_BAR;
        PG8_WAIT_V(4); PG8_BAR;
        PG8_STAGE(PG8_SB(1, 0), cB + kstep, voffB); PG8_STAGE(PG8_SA(1, 0), cA + kstep, voffA); PG8_STAGE(PG8_SB(1, 1), cB + hstepB + kstep, voffB);
        PG8_WAIT_V(6); PG8_BAR;
    }
    for (;;) {
        const bool has_next = S.next(ui + 1, nxt);
        const char* nA = has_next ? (const char*)g.A + (size_t)nxt.pm * tstepA : cA; const char* nB = has_next ? (const char*)g.Bt + (size_t)nxt.pn * tstepB : cB;
        for (int t = 0; t < nt; t += 2) {
            const bool last = (t == nt - 2);
            const char* a1 = cA + (size_t)(t + 1) * kstep;
            const char* a2 = last ? nA : cA + (size_t)(t + 2) * kstep; const char* b2 = last ? nB : cB + (size_t)(t + 2) * kstep;
            const char* a3 = a2 + kstep; const char* b3 = b2 + kstep;
            if constexpr (Epi::KSCALE) { if (E.yss != nullptr && (t == 8 || t == 20)) E.kscale(acc, cur, t, tid); }
            if constexpr (SP2) {
            PG8_LDB(B0, 0, 0); PG8_LDB(B1, 0, 1); PG8_SCHED; PG8_LDA(At, 0, 0); PG8_STAGE(PG8_SA(1, 1), a1 + hstepA, voffA);
            PG8_WAIT_V(8); PG8_WAIT_L(0); PG8_BAR; PG8_MMA(0, 0, At, B0); PG8_MMA(0, 1, At, B1); PG8_BAR; PG8_SCHED;
            PG8_LDA(At, 0, 1); PG8_STAGE(PG8_SB(0, 0), b2, voffB); PG8_STAGE(PG8_SB(0, 1), b2 + hstepB, voffB); PG8_STAGE(PG8_SA(0, 0), a2, voffA);
            PG8_WAIT_V(8); PG8_WAIT_L(0); PG8_BAR; PG8_MMA(1, 0, At, B0); PG8_MMA(1, 1, At, B1); PG8_BAR; PG8_SCHED;
            PG8_LDB(B0, 1, 0); PG8_LDB(B1, 1, 1); PG8_SCHED; PG8_LDA(At, 1, 0); PG8_STAGE(PG8_SA(0, 1), a2 + hstepA, voffA);
            PG8_WAIT_V(8); PG8_WAIT_L(0); PG8_BAR; PG8_MMA(0, 0, At, B0); PG8_MMA(0, 1, At, B1); PG8_BAR; PG8_SCHED;
            PG8_LDA(At, 1, 1); PG8_STAGE(PG8_SB(1, 0), b3, voffB); PG8_STAGE(PG8_SB(1, 1), b3 + hstepB, voffB); PG8_STAGE(PG8_SA(1, 0), a3, voffA);
            PG8_WAIT_V(8); PG8_WAIT_L(0); PG8_BAR; PG8_MMA(1, 0, At, B0); PG8_MMA(1, 1, At, B1); PG8_BAR; PG8_SCHED;
            } else {
            PG8_LDB(B0, 0, 0); PG8_SCHED; PG8_LDA(At, 0, 0); PG8_STAGE(PG8_SA(1, 1), a1 + hstepA, voffA);
            PG8_WAIT_L(8); PG8_BAR; PG8_WAIT_L(0); PG8_MMA(0, 0, At, B0); PG8_BAR; PG8_SCHED;
            PG8_LDB(B1, 0, 1); PG8_STAGE(PG8_SB(0, 0), b2, voffB);
            PG8_BAR; PG8_WAIT_L(0); PG8_MMA(0, 1, At, B1); PG8_BAR;
            PG8_LDA(At, 0, 1); PG8_STAGE(PG8_SA(0, 0), a2, voffA);
            PG8_BAR; PG8_WAIT_L(0); PG8_MMA(1, 0, At, B0); PG8_BAR; PG8_SCHED;
            PG8_STAGE(PG8_SB(0, 1), b2 + hstepB, voffB);
            PG8_WAIT_V(6); PG8_BAR; PG8_MMA(1, 1, At, B1); PG8_BAR;
            PG8_LDB(B0, 1, 0); PG8_SCHED; PG8_LDA(At, 1, 0); PG8_STAGE(PG8_SA(0, 1), a2 + hstepA, voffA);
            PG8_WAIT_L(8); PG8_BAR; PG8_WAIT_L(0); PG8_MMA(0, 0, At, B0); PG8_BAR; PG8_SCHED;
            PG8_LDB(B1, 1, 1); PG8_STAGE(PG8_SB(1, 0), b3, voffB);
            PG8_BAR; PG8_WAIT_L(0); PG8_MMA(0, 1, At, B1); PG8_BAR;
            PG8_LDA(At, 1, 1); PG8_STAGE(PG8_SA(1, 0), a3, voffA);
            PG8_BAR; PG8_WAIT_L(0); PG8_MMA(1, 0, At, B0); PG8_BAR; PG8_SCHED;
            PG8_STAGE(PG8_SB(1, 1), b3 + hstepB, voffB);
            PG8_WAIT_V(6); PG8_BAR; PG8_MMA(1, 1, At, B1); PG8_BAR;
            }
        }
        if constexpr (ALIGN_EPI) { if (wr == 0) PG8_BAR; }
        E(acc, cur, tid);
        if (!has_next) break;
#pragma unroll
        for (int a = 0; a < 2; ++a)
#pragma unroll
            for (int b = 0; b < 2; ++b)
#pragma unroll
                for (int m = 0; m < 4; ++m)
#pragma unroll
                    for (int n = 0; n < 2; ++n) acc[a][b][m][n] = (f32x4){0.f, 0.f, 0.f, 0.f};
        cur = nxt; cA = nA; cB = nB; ++ui;
        if constexpr (ALIGN_EPI) { if (wr == 1) PG8_BAR; }
    }
    PG8_WAIT_V(0);
    if constexpr (!ALIGN_EPI) { if (wr == 0) PG8_BAR; }
    PG8_BAR;
#undef PG8_SA
#undef PG8_SB
#undef PG8_STAGE
#undef PG8_LDA
#undef PG8_LDB
#undef PG8_MMA
#undef PG8_WAIT_V
#undef PG8_WAIT_L
#undef PG8_BAR
#undef PG8_SCHED
}
}

namespace att {
constexpr int KVBLK = 64, QBLK = 32;
constexpr float THR = 8.f;
#define SBAR() __builtin_amdgcn_sched_barrier(0)
__device__ __forceinline__ int crow(int r, int hi) { return (r & 3) + 8 * (r >> 2) + 4 * hi; }
__device__ __forceinline__ float dbias(int d) {
    const int ad = d < 0 ? -d : d;
    const int c = (ad <= 64 ? 1 : 0) + ((((d & 3) == 0) && ad <= 256) ? 1 : 0) + ((((d & 15) == 0) && ad <= 1024) ? 1 : 0);
    return c == 0 ? -__builtin_inff() : (c == 1 ? 0.f : (c == 2 ? 1.f : 1.5849625007211562f));
}
template <bool MASK, bool FIRST = false>
__device__ __forceinline__ void partialSM(f32x16& p0, f32x16& p1, float& m_reg, float& mn, float& alpha, const float C, const float thr, const int dbase, const int dwave, const LAS float* tb) {
    if constexpr (MASK) {
        if ((dwave - 31 > 256 && dwave + 63 <= 1024) || (dwave + 63 < -256 && dwave - 31 >= -1024)) {
            const int tl = dbase & 15; const float ninf = -__builtin_inff();
#pragma unroll
            for (int r = 0; r < 8; ++r) { const bool hit = tl == ((16 - ((r & 3) + 8 * (r >> 2))) & 15);
                p0[r] = hit ? p0[r] * C : ninf; p0[r + 8] = hit ? p0[r + 8] * C : ninf; p1[r] = hit ? p1[r] * C : ninf; p1[r + 8] = hit ? p1[r + 8] * C : ninf; }
        } else {
            { const LAS float* tl_ = tb + dbase;
#pragma unroll
              for (int r = 0; r < 16; ++r) { const int c = (r & 3) + 8 * (r >> 2); p0[r] = fmaf(p0[r], C, tl_[c]); p1[r] = fmaf(p1[r], C, tl_[c + 32]); } }
        }
        float pmax = p0[0];
#pragma unroll
        for (int r = 1; r < 16; ++r) pmax = fmaxf(pmax, p0[r]);
#pragma unroll
        for (int r = 0; r < 16; ++r) pmax = fmaxf(pmax, p1[r]);
        { auto rr = __builtin_amdgcn_permlane32_swap(__float_as_uint(pmax), __float_as_uint(pmax), false, false);
          pmax = fmaxf(__uint_as_float(rr[0]), __uint_as_float(rr[1])); }
        if (__builtin_expect(__all(pmax - m_reg <= thr), 1)) { mn = m_reg; alpha = 1.f; }
        else { mn = fmaxf(m_reg, pmax); alpha = __builtin_amdgcn_exp2f(m_reg - mn); m_reg = mn; }
#pragma unroll
        for (int r = 0; r < 16; ++r) { p0[r] = p0[r] - mn; p1[r] = p1[r] - mn; }
#pragma unroll
        for (int r = 0; r < 16; ++r) p0[r] = __builtin_amdgcn_exp2f(p0[r]);
    } else {
        float pmax = p0[0];
#pragma unroll
        for (int r = 1; r < 16; ++r) pmax = fmaxf(pmax, p0[r]);
#pragma unroll
        for (int r = 0; r < 16; ++r) pmax = fmaxf(pmax, p1[r]);
        { auto rr = __builtin_amdgcn_permlane32_swap(__float_as_uint(pmax), __float_as_uint(pmax), false, false);
          pmax = fmaxf(__uint_as_float(rr[0]), __uint_as_float(rr[1])); }
        if constexpr (FIRST) { m_reg = pmax; mn = pmax; alpha = 1.f;
#pragma unroll
            for (int r = 0; r < 16; ++r) { p0[r] -= pmax; p1[r] -= pmax; }
        } else if (__builtin_expect(__all(pmax <= thr), 1)) { mn = m_reg; alpha = 1.f; }
        else { const float d = fmaxf(pmax, 0.f); alpha = __builtin_amdgcn_exp2f(-d); m_reg += d; mn = m_reg;
#pragma unroll
            for (int r = 0; r < 16; ++r) { p0[r] -= d; p1[r] -= d; } }
#pragma unroll
        for (int r = 0; r < 16; ++r) p0[r] = __builtin_amdgcn_exp2f(p0[r]);
    }
}
__device__ __forceinline__ void finishSM(f32x16& p0, f32x16& p1, float alpha, float& l_reg, bf16x8& pa0, bf16x8& pa1, bf16x8& pa2, bf16x8& pa3) {
#pragma unroll
    for (int r = 0; r < 16; ++r) p1[r] = __builtin_amdgcn_exp2f(p1[r]);
    float ps = 0;
#pragma unroll
    for (int r = 0; r < 16; ++r) ps += p0[r];
#pragma unroll
    for (int r = 0; r < 16; ++r) ps += p1[r];
    { auto rr = __builtin_amdgcn_permlane32_swap(__float_as_uint(ps), __float_as_uint(ps), false, false);
      ps = __uint_as_float(rr[0]) + __uint_as_float(rr[1]); }
    l_reg = l_reg * alpha + ps;
#define PK4(P, BASE, OUT) do { unsigned a0 = cvt_pk_bf16(P[BASE + 0], P[BASE + 1]), a1 = cvt_pk_bf16(P[BASE + 2], P[BASE + 3]);   \
    unsigned b0 = cvt_pk_bf16(P[BASE + 4], P[BASE + 5]), b1 = cvt_pk_bf16(P[BASE + 6], P[BASE + 7]);                              \
    auto r0 = __builtin_amdgcn_permlane32_swap(a0, b0, false, false); auto r1 = __builtin_amdgcn_permlane32_swap(a1, b1, false, false); \
    u32x4 w = {r0[0], r1[0], r0[1], r1[1]}; OUT = __builtin_bit_cast(bf16x8, w); } while (0)
    PK4(p0, 0, pa0); PK4(p0, 8, pa1); PK4(p1, 0, pa2); PK4(p1, 8, pa3);
#undef PK4
}
template <int DK>
__device__ __forceinline__ void qkt(f32x16& p0, f32x16& p1, const LAS char* Ks, const bf16x8* qr, const int (&kb)[4], int hi, const LAS char* lds0, unsigned qoff, const float init) {
    constexpr int RB = DK * 2;
#pragma unroll
    for (int r = 0; r < 16; ++r) { p0[r] = init; p1[r] = init; }
    if constexpr (DK == 128) {
#pragma unroll
        for (int d0 = 0; d0 < 8; ++d0) {
            const bf16x8 b0 = *(const LAS bf16x8*)(Ks + kb[d0 & 3] + (d0 >> 2) * 128);
            const bf16x8 b1 = *(const LAS bf16x8*)(Ks + kb[d0 & 3] + (d0 >> 2) * 128 + 32 * RB);
            p0 = __builtin_amdgcn_mfma_f32_32x32x16_bf16(b0, qr[d0], p0, 0, 0, 0);
            p1 = __builtin_amdgcn_mfma_f32_32x32x16_bf16(b1, qr[d0], p1, 0, 0, 0); }
    } else {
        asm volatile("" : "+v"(qoff));
        bf16x8 b0[2][2], b1[2][2], q[2][2];
#define QK_LD(g, s) do { _Pragma("unroll") for (int e = 0; e < 2; ++e) { const int d0 = 2 * (g) + e; \
            b0[s][e] = *(const LAS bf16x8*)(Ks + kb[d0 & 3] + (d0 >> 2) * 128); b1[s][e] = *(const LAS bf16x8*)(Ks + kb[d0 & 3] + (d0 >> 2) * 128 + 32 * RB); \
            if (d0 >= 6) q[s][e] = *(const LAS bf16x8*)(lds0 + qoff + (d0 - 6) * 1024); } } while (0)
#define QK_MM(g, s) do { _Pragma("unroll") for (int e = 0; e < 2; ++e) { const int d0 = 2 * (g) + e; \
            if (d0 >= 6) { p0 = __builtin_amdgcn_mfma_f32_32x32x16_bf16(b0[s][e], q[s][e], p0, 0, 0, 0); p1 = __builtin_amdgcn_mfma_f32_32x32x16_bf16(b1[s][e], q[s][e], p1, 0, 0, 0); } \
            else { p0 = __builtin_amdgcn_mfma_f32_32x32x16_bf16(b0[s][e], qr[d0], p0, 0, 0, 0); p1 = __builtin_amdgcn_mfma_f32_32x32x16_bf16(b1[s][e], qr[d0], p1, 0, 0, 0); } } } while (0)
        QK_LD(0, 0); SBAR();
        QK_LD(1, 1); SBAR(); QK_MM(0, 0); SBAR();
        QK_LD(2, 0); SBAR(); QK_MM(1, 1); SBAR();
        QK_LD(3, 1); SBAR(); QK_MM(2, 0); SBAR();
        QK_LD(4, 0); SBAR(); QK_MM(3, 1); SBAR();
        QK_LD(5, 1); SBAR(); QK_MM(4, 0); SBAR();
        QK_MM(5, 1); SBAR();
#undef QK_LD
#undef QK_MM
    }
}
__device__ __forceinline__ int v_st(int k, int c) { const int kk = (k & ~0xC) | ((k & 4) << 1) | ((k & 8) >> 1); return ((kk >> 3) * 4 + (c >> 5)) * 512 + ((kk & 7) * 32 + (c & 31)) * 2; }
__device__ __forceinline__ int v_rd_base(int lane) { return ((lane & 3) << 3) | (((lane >> 2) & 3) << 6) | (((lane >> 4) & 1) << 5) | (((lane >> 5) & 1) << 8); }
constexpr int v_rd_off(int d0, int ks, int half) { return d0 * 512 + ks * 4096 + half * 2048; }
template <int OFF> __device__ __forceinline__ s16x4 tr_read(int vb) {
    s16x4 r; asm volatile("ds_read_b64_tr_b16 %0, %1 offset:%2" : "=&v"(r) : "v"(vb), "i"(OFF) : "memory"); return r;
}
template <int D0> __device__ __forceinline__ void pv_one(f32x16& od, int vb, bf16x8 pa0, bf16x8 pa1, bf16x8 pa2, bf16x8 pa3) {
    const s16x4 l0 = tr_read<v_rd_off(D0, 0, 0)>(vb), h0 = tr_read<v_rd_off(D0, 0, 1)>(vb), l1 = tr_read<v_rd_off(D0, 1, 0)>(vb), h1 = tr_read<v_rd_off(D0, 1, 1)>(vb);
    const s16x4 l2 = tr_read<v_rd_off(D0, 2, 0)>(vb), h2 = tr_read<v_rd_off(D0, 2, 1)>(vb), l3 = tr_read<v_rd_off(D0, 3, 0)>(vb), h3 = tr_read<v_rd_off(D0, 3, 1)>(vb);
    asm volatile("s_waitcnt lgkmcnt(0)" ::: "memory"); SBAR();
#define PKV(L, H) (bf16x8){L[0], L[1], L[2], L[3], H[0], H[1], H[2], H[3]}
    od = __builtin_amdgcn_mfma_f32_32x32x16_bf16(pa0, PKV(l0, h0), od, 0, 0, 0);
    od = __builtin_amdgcn_mfma_f32_32x32x16_bf16(pa1, PKV(l1, h1), od, 0, 0, 0);
    od = __builtin_amdgcn_mfma_f32_32x32x16_bf16(pa2, PKV(l2, h2), od, 0, 0, 0);
    od = __builtin_amdgcn_mfma_f32_32x32x16_bf16(pa3, PKV(l3, h3), od, 0, 0, 0);
#undef PKV
}
__device__ __forceinline__ void pv_d0(f32x16* o, int vb, bf16x8 pa0, bf16x8 pa1, bf16x8 pa2, bf16x8 pa3) {
    pv_one<0>(o[0], vb, pa0, pa1, pa2, pa3); pv_one<1>(o[1], vb, pa0, pa1, pa2, pa3); pv_one<2>(o[2], vb, pa0, pa1, pa2, pa3); pv_one<3>(o[3], vb, pa0, pa1, pa2, pa3);
}

template <int DK, bool MASK, int SDEPTH>
__device__ __forceinline__ void attn_unit(const bf16_t* __restrict__ Qb, const int ldq, const bf16_t* __restrict__ Kh, const int ldk, const bf16_t* __restrict__ Vh, const int ldv,
                                          bf16_t* __restrict__ Ob, const int ldo, const int NT, const float scale, LAS char* lds, const f32x2* __restrict__ ropeA, const int qpos0, const int dq0, const int tid, u64* __restrict__ yss) {
    constexpr int RB = DK * 2, SHM_V = KVBLK * 128 * 2, SHM_K = KVBLK * RB;
    const int wid = tid >> 6, lane = tid & 63, r32 = lane & 31, hi = lane >> 5;
    LAS char* V_lds = lds; LAS char* K_lds = lds + 2 * SHM_V;
    const float C = scale * 1.4426950408889634f;
    const float thr = THR * 1.4426950408889634f;
    float m_reg = -1e30f, l_reg = 0; f32x16 o[4] = {}; bf16x8 qr[(DK == 192) ? 6 : 8];
    const unsigned qoff = 2 * SHM_V + 2 * SHM_K + 2048 + wid * 6144 + lane * 16;
    int kb[4];
#pragma unroll
    for (int k = 0; k < 4; ++k) kb[k] = r32 * RB + ((hi ^ (r32 & 1)) << 4) + ((k ^ ((r32 & 7) >> 1)) << 5);
    int tq = tid; asm volatile("" : "+v"(tq));
    const bf16_t* Qw = Qb + (size_t)(unsigned)(((tq >> 6) * QBLK + (tq & 31)) * ldq + ((tq >> 5) & 1) * 8);
    constexpr int NQR = (DK == 192) ? 6 : 8;
#pragma unroll
    for (int d0 = 0; d0 < NQR; ++d0) qr[d0] = *(const bf16x8*)(Qw + d0 * 16);
    const float qs = MASK ? 1.f : C;
    auto scl8 = [&](bf16x8 x) -> bf16x8 {
#pragma unroll
        for (int e = 0; e < 8; ++e) x[e] = (short)f2bf(bf2f((unsigned short)x[e]) * qs); return x; };
    if constexpr (!MASK) {
#pragma unroll
        for (int d0 = 0; d0 < NQR; ++d0) qr[d0] = scl8(qr[d0]); }
    if constexpr (DK == 192) {
        *(LAS bf16x8*)(lds + qoff) = scl8(*(const bf16x8*)(Qw + 6 * 16)); *(LAS bf16x8*)(lds + qoff + 1024) = scl8(*(const bf16x8*)(Qw + 7 * 16));
        const f32x2* rp = ropeA + (size_t)(unsigned)((qpos0 + (tq >> 6) * QBLK + (tq & 31)) * 32 + ((tq >> 5) & 1) * 8);
#pragma unroll
        for (int dd = 0; dd < 2; ++dd) {
            bf16x8 x1 = *(const bf16x8*)(Qw + (8 + dd) * 16), x2 = *(const bf16x8*)(Qw + (10 + dd) * 16);
#pragma unroll
            for (int e = 0; e < 8; ++e) { const f32x2 cs = rp[dd * 16 + e]; const float a = bf2f((unsigned short)x1[e]), b = bf2f((unsigned short)x2[e]);
                x1[e] = (short)f2bf((a * cs.x - b * cs.y) * qs); x2[e] = (short)f2bf((b * cs.x + a * cs.y) * qs); }
            *(LAS bf16x8*)(lds + qoff + (2 + dd) * 1024) = x1; *(LAS bf16x8*)(lds + qoff + (4 + dd) * 1024) = x2;
        }
        asm volatile("s_waitcnt lgkmcnt(0)" ::: "memory");
    }
    const LAS float* tbias = (const LAS float*)(lds + 69632) + 1344;
    if constexpr (MASK) { for (int i = tid; i < 2688; i += 512) *(LAS float*)(lds + 69632 + 4 * i) = dbias(i - 1344); }
    const int sr = tid >> 4, sc = (tid & 15) * 8, vst0 = v_st(sr, sc); constexpr int vst1d = 8192;
    const int kst0 = sr * RB + ((sc * 2) ^ ((sr & 7) << 4));
    const int kr2 = tid >> 3, kc2 = 128 + (tid & 7) * 8, kst2 = kr2 * RB + ((kc2 * 2) ^ ((kr2 & 7) << 4));
    const int vb0 = (int)(uintptr_t)V_lds + v_rd_base(lane);
    bf16x8 vs0[SDEPTH], vs1[SDEPTH], ks0[SDEPTH], ks1[SDEPTH], ks2[SDEPTH];
    const unsigned voV0 = (unsigned)(sr * ldv + sc) * 2u, voK0 = (unsigned)(sr * ldk + sc) * 2u, voK2 = (unsigned)(kr2 * ldk + kc2) * 2u;
#define SLOAD(i, k0) do { const char* Vt = (const char*)Vh + (size_t)(k0) * (size_t)(ldv * 2); const char* Kt = (const char*)Kh + (size_t)(k0) * (size_t)(ldk * 2); \
    vs0[i] = *(const bf16x8*)(Vt + (size_t)voV0); vs1[i] = *(const bf16x8*)(Vt + (size_t)(ldv * 64) + (size_t)voV0); \
    ks0[i] = *(const bf16x8*)(Kt + (size_t)voK0); ks1[i] = *(const bf16x8*)(Kt + (size_t)(ldk * 64) + (size_t)voK0); \
    if constexpr (DK == 192) ks2[i] = *(const bf16x8*)(Kt + (size_t)voK2); } while (0)
#define SWRITE(b, i) do { *(LAS bf16x8*)(V_lds + (b) * SHM_V + vst0) = vs0[i]; *(LAS bf16x8*)(V_lds + (b) * SHM_V + vst1d + vst0) = vs1[i]; \
    *(LAS bf16x8*)(K_lds + (b) * SHM_K + kst0) = ks0[i]; *(LAS bf16x8*)(K_lds + (b) * SHM_K + 32 * RB + kst0) = ks1[i]; \
    if constexpr (DK == 192) *(LAS bf16x8*)(K_lds + (b) * SHM_K + kst2) = ks2[i]; } while (0)
#define SWAIT() do { if constexpr (SDEPTH == 2) { if constexpr (DK == 192) asm volatile("s_waitcnt vmcnt(5)" ::: "memory"); else asm volatile("s_waitcnt vmcnt(4)" ::: "memory"); } \
    else asm volatile("s_waitcnt vmcnt(0)" ::: "memory"); } while (0)
#define RESC(a) do { if (__any((a) < 1.f)) { int t3 = tid; asm volatile("" : "+v"(t3)); LAS float* al3 = (LAS float*)(lds + 2 * SHM_V + 2 * SHM_K) + (t3 >> 6) * 64 + 32; \
    if (((t3 >> 5) & 1) == 0) al3[t3 & 31] = (a); asm volatile("s_waitcnt lgkmcnt(0)" ::: "memory"); const LAS float* ar3 = al3 + 4 * ((t3 >> 5) & 1); \
    _Pragma("unroll") for (int d = 0; d < 4; ++d) _Pragma("unroll") for (int r = 0; r < 16; ++r) o[d][r] *= ar3[(r & 3) + 8 * (r >> 2)]; } } while (0)
    f32x16 pA0, pA1, pB0, pB1; float mnA, mnB, alA, alB; bf16x8 pa0, pa1, pa2, pa3;
    const int dw0 = dq0 - __builtin_amdgcn_readfirstlane(wid) * QBLK;
    const int db0 = dq0 + 4 * hi - (wid * QBLK + r32);
    constexpr int SE = 0, SO = SDEPTH - 1;
    SLOAD(SE, 0); asm volatile("s_waitcnt vmcnt(0)" ::: "memory"); SWRITE(0, SE); __syncthreads();
    qkt<DK>(pA0, pA1, K_lds, qr, kb, hi, lds, qoff, 0.f); partialSM<MASK, true>(pA0, pA1, m_reg, mnA, alA, C, thr, db0, dw0, tbias);
    SLOAD(SO, KVBLK); if constexpr (SDEPTH == 2) { if (2 < NT) SLOAD(SE, 2 * KVBLK); }
    SWAIT(); SWRITE(1, SO); __syncthreads();
    for (int j = 1; j + 1 < NT; j += 2) {
        SBAR(); qkt<DK>(pB0, pB1, K_lds + SHM_K, qr, kb, hi, lds, qoff, MASK ? 0.f : -m_reg);
        finishSM(pA0, pA1, alA, l_reg, pa0, pa1, pa2, pa3); SBAR();
        SLOAD(SO, (j + SDEPTH) * KVBLK); SBAR();
        pv_d0(o, vb0, pa0, pa1, pa2, pa3); partialSM<MASK>(pB0, pB1, m_reg, mnB, alB, C, thr, db0 + j * KVBLK, dw0 + j * KVBLK, tbias);
        __syncthreads(); SWAIT(); SWRITE(0, SE);
        RESC(alB); __syncthreads();
        SBAR(); qkt<DK>(pA0, pA1, K_lds, qr, kb, hi, lds, qoff, MASK ? 0.f : -m_reg);
        finishSM(pB0, pB1, alB, l_reg, pa0, pa1, pa2, pa3); SBAR();
        if (SDEPTH == 1 || j + 3 < NT) SLOAD(SE, (j + 1 + SDEPTH) * KVBLK); SBAR();
        pv_d0(o, vb0 + SHM_V, pa0, pa1, pa2, pa3); partialSM<MASK>(pA0, pA1, m_reg, mnA, alA, C, thr, db0 + (j + 1) * KVBLK, dw0 + (j + 1) * KVBLK, tbias);
        __syncthreads(); SWAIT(); SWRITE(1, SO);
        RESC(alA); __syncthreads();
    }
    SBAR(); qkt<DK>(pB0, pB1, K_lds + SHM_K, qr, kb, hi, lds, qoff, MASK ? 0.f : -m_reg);
    finishSM(pA0, pA1, alA, l_reg, pa0, pa1, pa2, pa3); SBAR();
    pv_d0(o, vb0, pa0, pa1, pa2, pa3); partialSM<MASK>(pB0, pB1, m_reg, mnB, alB, C, thr, db0 + (NT - 1) * KVBLK, dw0 + (NT - 1) * KVBLK, tbias);
    __syncthreads(); RESC(alB);
    finishSM(pB0, pB1, alB, l_reg, pa0, pa1, pa2, pa3); SBAR();
    pv_d0(o, vb0 + SHM_V, pa0, pa1, pa2, pa3);
    int to = tid; asm volatile("" : "+v"(to));
    { LAS float* li3 = (LAS float*)(lds + 2 * SHM_V + 2 * SHM_K) + (to >> 6) * 64;
      if (((to >> 5) & 1) == 0) li3[to & 31] = l_reg; asm volatile("s_waitcnt lgkmcnt(0)" ::: "memory"); }
    float rli[16];
    { const LAS float* lr3 = (const LAS float*)(lds + 2 * SHM_V + 2 * SHM_K) + (to >> 6) * 64 + 4 * ((to >> 5) & 1);
#pragma unroll
      for (int r = 0; r < 16; ++r) rli[r] = __builtin_amdgcn_rcpf(lr3[(r & 3) + 8 * (r >> 2)]); }
    const unsigned ooff = (unsigned)((((to >> 6) * QBLK + 4 * ((to >> 5) & 1)) * ldo + (to & 31)) * 2);
    float sq[16];
#pragma unroll
    for (int r = 0; r < 16; ++r) { sq[r] = 0.f;
#pragma unroll
        for (int d0 = 0; d0 < 4; ++d0) { const float v = o[d0][r] * rli[r]; sq[r] += v * v;
            *(bf16_t*)((char*)Ob + (size_t)(ooff + (unsigned)((((r & 3) + 8 * (r >> 2)) * ldo + d0 * 32) * 2))) = f2bf(v); } }
#pragma unroll
    for (int r = 0; r < 16; ++r) {
#pragma unroll
        for (int x = 1; x < 32; x <<= 1) sq[r] += __builtin_bit_cast(float, __builtin_amdgcn_ds_bpermute(((to & 63) ^ x) << 2, __builtin_bit_cast(int, sq[r])));
        if ((to & 31) == r) fx_add(yss + (size_t)((to >> 6) * QBLK + 4 * ((to >> 5) & 1) + (r & 3) + 8 * (r >> 2)) * 4, sq[r]); }
#undef SLOAD
#undef SWRITE
#undef SWAIT
#undef RESC
}
}

struct TrJob { const float* W; bf16_t* WT; const float* gain; int N, Kd, mode, item; };
__device__ __forceinline__ void tr_load(const TrJob& j, int lane, f32x4 (&v)[8]) {
    const int nblk = j.N / 32, kb = j.item / nblk, nb = j.item % nblk, k0 = 64 * kb, n0 = 32 * nb;
    const float* p = j.W + (size_t)(k0 + (lane >> 3)) * j.N + n0 + 4 * (lane & 7);
#pragma unroll
    for (int i = 0; i < 8; ++i) v[i] = *(const f32x4*)(p + (size_t)(8 * i) * j.N);
}
__device__ __forceinline__ void tr_write(LAS float* scr, int lane, const f32x4 (&v)[8]) {
#pragma unroll
    for (int i = 0; i < 8; ++i) { LAS float* d = scr + (8 * i + (lane >> 3)) * 33 + 4 * (lane & 7); d[0] = v[i].x; d[1] = v[i].y; d[2] = v[i].z; d[3] = v[i].w; }
}
__device__ __forceinline__ void tr_store(const TrJob& j, LAS float* scr, int lane) {
    const int nblk = j.N / 32, kb = j.item / nblk, nb = j.item % nblk, k0 = 64 * kb, n0 = 32 * nb;
    const int rb = (j.mode == 0) ? n0 : (256 * (n0 >> 7) + (n0 & 127) + (j.mode == 2 ? 128 : 0));
    const int c = lane & 7;
    f32x4 g0 = {1.f, 1.f, 1.f, 1.f}, g1 = g0;
    if (j.gain) { g0 = *(const f32x4*)(j.gain + k0 + 8 * c); g1 = *(const f32x4*)(j.gain + k0 + 8 * c + 4); }
    asm volatile("s_waitcnt lgkmcnt(0)" ::: "memory");
#pragma unroll
    for (int jj = 0; jj < 4; ++jj) { const int n = (lane >> 3) + 8 * jj; const LAS float* s = scr + (8 * c) * 33 + n;
        u32x4 o; o.x = cvt_pk_bf16(s[0 * 33] * g0.x, s[1 * 33] * g0.y); o.y = cvt_pk_bf16(s[2 * 33] * g0.z, s[3 * 33] * g0.w);
        o.z = cvt_pk_bf16(s[4 * 33] * g1.x, s[5 * 33] * g1.y); o.w = cvt_pk_bf16(s[6 * 33] * g1.z, s[7 * 33] * g1.w);
        *(u32x4*)(j.WT + (size_t)(rb + n) * j.Kd + k0 + 8 * c) = o; }
    asm volatile("s_waitcnt lgkmcnt(0)" ::: "memory");
}

struct Args { const float* in[16]; float* out; unsigned char* ws; int ph_lo, ph_hi; };

constexpr int I_IN = 32 * 146, I_UQ = 8 * 24, I_UKV = 8 * 32, I_OUT = 32 * 64, I_G = 32 * 176, I_DN = 88 * 64;
constexpr int I_LAYER = I_IN + I_UQ + I_UKV + I_OUT + 2 * I_G + I_DN;
constexpr int TR_P0 = I_IN + I_UQ + I_UKV, TR_P1 = I_LAYER + I_IN + I_UQ + I_UKV;
static_assert((TR_P1 - TR_P0) % 16 == 0 && (2 * I_LAYER - TR_P1) % 16 == 0, "filler ranges are whole queue entries");
template <class ArgsT>
__device__ __forceinline__ TrJob tr_job(const ArgsT& a, unsigned char* ws, int it) {
    const int l = it / I_LAYER; int r = it % I_LAYER; unsigned char* wl = ws + WS_W + (size_t)l * W_LAYER;
    const float* W; bf16_t* WT; const float* gain; int N, Kd, mode = 0;
    const float *p1 = a.in[1], *p2 = a.in[2], *p3 = a.in[3], *p4 = a.in[4], *p5 = a.in[5], *p6 = a.in[6], *p9 = a.in[9], *p10 = a.in[10], *p11 = a.in[11], *p12 = a.in[12], *p13 = a.in[13], *p14 = a.in[14];
    asm volatile("" : "+s"(p1), "+s"(p2), "+s"(p3), "+s"(p4), "+s"(p5), "+s"(p6)); asm volatile("" : "+s"(p9), "+s"(p10), "+s"(p11), "+s"(p12), "+s"(p13), "+s"(p14));
    if (r < I_IN) { W = p2 + (size_t)l * DM * INW; WT = (bf16_t*)(wl + W_IN); gain = p1 + l * DM; N = INW; Kd = DM; }
    else if ((r -= I_IN) < I_UQ) { W = p4 + (size_t)l * 512 * 768; WT = (bf16_t*)(wl + W_UQ); gain = p3 + l * 512; N = 768; Kd = 512; }
    else if ((r -= I_UQ) < I_UKV) { W = p6 + (size_t)l * 512 * 1024; WT = (bf16_t*)(wl + W_UKV); gain = p5 + l * 512; N = 1024; Kd = 512; }
    else if ((r -= I_UKV) < I_OUT) { W = p10 + (size_t)l * DM * DM; WT = (bf16_t*)(wl + W_OUT); gain = p9 + l * DM; N = DM; Kd = DM; }
    else if ((r -= I_OUT) < I_G) { W = p12 + (size_t)l * DM * DFF; WT = (bf16_t*)(wl + W_GU); gain = p11 + l * DM; N = DFF; Kd = DM; mode = 1; }
    else if ((r -= I_G) < I_G) { W = p13 + (size_t)l * DM * DFF; WT = (bf16_t*)(wl + W_GU); gain = p11 + l * DM; N = DFF; Kd = DM; mode = 2; }
    else { r -= I_G; W = p14 + (size_t)l * DFF * DM; WT = (bf16_t*)(wl + W_DN); gain = nullptr; N = DM; Kd = DFF; }
    TrJob j; j.W = W; j.WT = WT; j.gain = gain; j.N = N; j.Kd = Kd; j.mode = mode; j.item = r; return j;
}
__device__ __forceinline__ void ph_prologue(const Args& a, LAS unsigned char* lds, int gw, int NGW, int lane, int wave) {
    LAS float* scr = (LAS float*)(lds + wave * 16384);
    unsigned char* ws = a.ws;
    { f32x4 v[8]; int it = gw; TrJob cur = tr_job(a, ws, it < TR_P0 ? it : 0);
      if (it < TR_P0) tr_load(cur, lane, v);
      while (it < TR_P0) {
          const int nit = it + NGW;
          tr_write(scr, lane, v);
          TrJob nxt = cur;
          if (nit < TR_P0) { nxt = tr_job(a, ws, nit); tr_load(nxt, lane, v); }
          tr_store(cur, scr, lane);
          cur = nxt; it = nit;
      } }
    const int gt = gw * 64 + lane, NGT = NGW * 64;
    for (int l = 0; l < 2; ++l) { u32x4* z = (u32x4*)(ws + WS_W + (size_t)l * W_LAYER + W_IN + (size_t)INW * DM * 2);
        for (int i = gt; i < (INP - INW) * DM * 2 / 16; i += NGT) z[i] = (u32x4){0u, 0u, 0u, 0u}; }
    { u64* rss = (u64*)(ws + WS_CTL + RSS_OFF); bf16_t* XB = (bf16_t*)(ws + WS_XN);
      for (int i = gt; i < 3 * T; i += NGT) rss[T + i] = 0ull;
      { u64* yz = (u64*)(ws + WS_CTL + YSS_OFF); for (int i = gt; i < 2 * T * 4; i += NGT) yz[i] = 0ull; }
      { u64* cz = (u64*)(ws + WS_CTL + CSS_OFF); for (int i = gt; i < 2 * T * 2; i += NGT) cz[i] = 0ull; }
      for (int m = gw; m < T; m += NGW) {
          const f32x4* xr = (const f32x4*)(a.in[0] + (size_t)m * DM) + lane; u32x2* o = (u32x2*)(XB + (size_t)m * DM) + lane; float sq = 0.f;
#pragma unroll
          for (int j = 0; j < 8; ++j) { const f32x4 v = xr[64 * j]; sq += (v.x * v.x + v.y * v.y) + (v.z * v.z + v.w * v.w);
              u32x2 w; w.x = cvt_pk_bf16(v.x, v.y); w.y = cvt_pk_bf16(v.z, v.w); o[64 * j] = w; }
          sq = wave_sum(sq, lane); if (lane == 0) rss[m] = (u64)(sq * FXS + 0.5f); } }
    f32x2* ra = (f32x2*)(ws + WS_ROPEA); f32x2* r1 = (f32x2*)(ws + WS_ROPE1);
    for (int i = gt; i < 4096 * 32 + 4096 * 64; i += NGT) {
        int pos, fi; float inv; f32x2* dst;
        if (i < 4096 * 32) { pos = i >> 5; fi = i & 31; inv = __builtin_amdgcn_exp2f(-(float)(2 * fi) * (13.287712379549449f / 64.f)); dst = ra + i; }
        else { const int j = i - 4096 * 32; pos = j >> 6; fi = j & 63; inv = __builtin_amdgcn_exp2f(-(float)(2 * fi) * (13.287712379549449f / 128.f)); dst = r1 + j; }
        const float ang = (float)pos * inv;
        const double rev = (double)ang * 0.15915494309189535; const float fr = (float)(rev - __builtin_rint(rev));
        *dst = (f32x2){__builtin_amdgcn_cosf(fr), __builtin_amdgcn_sinf(fr)};
    }
}

__device__ __forceinline__ void ph_norm_bf16(const float* x, const float* g, bf16_t* out, int gw, int NGW, int lane) {
    for (int m = gw; m < T; m += NGW) {
        const f32x4* xr = (const f32x4*)(x + (size_t)m * DM) + lane; f32x4 v[8]; float s = 0.f;
#pragma unroll
        for (int j = 0; j < 8; ++j) { v[j] = xr[64 * j]; s += (v[j].x * v[j].x + v[j].y * v[j].y) + (v[j].z * v[j].z + v[j].w * v[j].w); }
        const float rs = 1.0f / sqrtf(wave_sum(s, lane) * (1.f / DM) + EPS);
        u32x2* o = (u32x2*)(out + (size_t)m * DM) + lane;
#pragma unroll
        for (int j = 0; j < 8; ++j) { const f32x4 gg = ((const f32x4*)g)[lane + 64 * j]; u32x2 w; w.x = cvt_pk_bf16(v[j].x * rs * gg.x, v[j].y * rs * gg.y); w.y = cvt_pk_bf16(v[j].z * rs * gg.z, v[j].w * rs * gg.w); o[64 * j] = w; }
    }
}
__device__ __forceinline__ void unpack8(const u32x4 w, float (&x)[8]) { x[0] = bflo(w.x); x[1] = bfhi(w.x); x[2] = bflo(w.y); x[3] = bfhi(w.y); x[4] = bflo(w.z); x[5] = bfhi(w.z); x[6] = bflo(w.w); x[7] = bfhi(w.w); }
__device__ __forceinline__ u32x4 pack8(const float (&x)[8]) { u32x4 o; o.x = cvt_pk_bf16(x[0], x[1]); o.y = cvt_pk_bf16(x[2], x[3]); o.z = cvt_pk_bf16(x[4], x[5]); o.w = cvt_pk_bf16(x[6], x[7]); return o; }
__device__ __forceinline__ void ph_final(const bf16_t* xb, float* out, const float* g, int gw, int NGW, int lane) {
    for (int m0 = gw; m0 < T; m0 += 2 * NGW) {
        float v[2][4][8]; float s[2] = {0.f, 0.f};
#pragma unroll
        for (int rr = 0; rr < 2; ++rr) { const int mr = (m0 + rr * NGW < T) ? m0 + rr * NGW : m0; const u32x4* xr = (const u32x4*)(xb + (size_t)mr * DM) + lane;
#pragma unroll
            for (int j = 0; j < 4; ++j) { unpack8(xr[64 * j], v[rr][j]);
#pragma unroll
                for (int e = 0; e < 8; ++e) s[rr] += v[rr][j][e] * v[rr][j][e]; } }
#pragma unroll
        for (int rr = 0; rr < 2; ++rr) { if (m0 + rr * NGW >= T) continue; f32x4* o = (f32x4*)(out + (size_t)(m0 + rr * NGW) * DM) + 2 * lane;
            const float rs = 1.0f / sqrtf(wave_sum(s[rr], lane) * (1.f / DM) + EPS);
#pragma unroll
            for (int j = 0; j < 4; ++j) { const f32x4 g0 = ((const f32x4*)g)[2 * (lane + 64 * j)], g1 = ((const f32x4*)g)[2 * (lane + 64 * j) + 1];
                o[128 * j] = (f32x4){v[rr][j][0] * rs * g0.x, v[rr][j][1] * rs * g0.y, v[rr][j][2] * rs * g0.z, v[rr][j][3] * rs * g0.w};
                o[128 * j + 1] = (f32x4){v[rr][j][4] * rs * g1.x, v[rr][j][5] * rs * g1.y, v[rr][j][6] * rs * g1.z, v[rr][j][7] * rs * g1.w}; } }
    }
}
__device__ __forceinline__ void ph_prep(const Args& a, int l, int gw, int NGW, int lane) {
    bf16_t* PROJ = (bf16_t*)(a.ws + WS_BIG); bf16_t* KA = (bf16_t*)(a.ws + WS_KA);
    const f32x2* ra = (const f32x2*)(a.ws + WS_ROPEA); const f32x2* r1 = (const f32x2*)(a.ws + WS_ROPE1);
    const float* gq = a.in[3] + l * 512; const float* gkv = a.in[5] + l * 512; const float* cqn = a.in[7] + l * 128; const float* ckn = a.in[8] + l * 128;
    const int j8 = lane & 7, hd = lane >> 3;
    for (int m0 = gw; m0 < T; m0 += 2 * NGW) {
#pragma unroll
      for (int rr = 0; rr < 2; ++rr) { const int m = m0 + rr * NGW; if (m >= T) continue;
        bf16_t* P = PROJ + (size_t)m * INP; const int s = m & (SEQ - 1);
        if (lane < 4) {
            float x1[8], x2[8]; unpack8(*(const u32x4*)(P + PA_KR + 8 * lane), x1); unpack8(*(const u32x4*)(P + PA_KR + 32 + 8 * lane), x2);
            const f32x4* cp = (const f32x4*)(ra + s * 32 + 8 * lane);
#pragma unroll
            for (int e2 = 0; e2 < 4; ++e2) { const f32x4 cs = cp[e2];
                const float a0 = x1[2 * e2], b0 = x2[2 * e2], a1 = x1[2 * e2 + 1], b1 = x2[2 * e2 + 1];
                x1[2 * e2] = a0 * cs.x - b0 * cs.y; x2[2 * e2] = b0 * cs.x + a0 * cs.y; x1[2 * e2 + 1] = a1 * cs.z - b1 * cs.w; x2[2 * e2 + 1] = b1 * cs.z + a1 * cs.w; }
            const u32x4 y1 = pack8(x1), y2 = pack8(x2); bf16_t* kp = KA + (size_t)m * 768 + 128 + 8 * lane;
#pragma unroll
            for (int h = 0; h < 4; ++h) { *(u32x4*)(kp + h * 192) = y1; *(u32x4*)(kp + h * 192 + 32) = y2; }
        }
        { const f32x4* cp = (const f32x4*)(r1 + s * 64 + 8 * j8); const f32x4 c0 = cp[0], c1 = cp[1], c2 = cp[2], c3 = cp[3];
#pragma unroll
          for (int pass = 0; pass < 2; ++pass) { const int head = 8 * pass + hd;
              if (head < 12) { bf16_t* hp = P + PB_Q + head * 128 + 8 * j8; float x1[8], x2[8]; unpack8(*(const u32x4*)hp, x1); unpack8(*(const u32x4*)(hp + 64), x2);
                  const float cc[8] = {c0.x, c0.z, c1.x, c1.z, c2.x, c2.z, c3.x, c3.z}, sn[8] = {c0.y, c0.w, c1.y, c1.w, c2.y, c2.w, c3.y, c3.w};
#pragma unroll
                  for (int e = 0; e < 8; ++e) { const float p = x1[e], q = x2[e]; x1[e] = p * cc[e] - q * sn[e]; x2[e] = q * cc[e] + p * sn[e]; }
                  *(u32x4*)hp = pack8(x1); *(u32x4*)(hp + 64) = pack8(x2); } } }
        { const int half = j8 >> 2, jj = j8 & 3; bf16_t* hp = P + PC_Q + hd * 128 + 64 * half + 8 * jj;
          float x1[8], x2[8]; unpack8(*(const u32x4*)hp, x1); unpack8(*(const u32x4*)(hp + 32), x2);
          const f32x4* cp = (const f32x4*)(ra + (half ? (s & 63) : (s >> 6)) * 32 + 8 * jj); const f32x4 c0 = cp[0], c1 = cp[1], c2 = cp[2], c3 = cp[3];
          const float* g = (hd < 6 ? cqn : ckn) + 64 * half + 8 * jj; const f32x4 ga = *(const f32x4*)g, gb = *(const f32x4*)(g + 4), gc = *(const f32x4*)(g + 32), gd = *(const f32x4*)(g + 36);
          float ss = 0.f;
#pragma unroll
          for (int e = 0; e < 8; ++e) ss += x1[e] * x1[e] + x2[e] * x2[e];
          ss += __builtin_bit_cast(float, __builtin_amdgcn_ds_bpermute((lane ^ 1) << 2, __builtin_bit_cast(int, ss)));
          ss += __builtin_bit_cast(float, __builtin_amdgcn_ds_bpermute((lane ^ 2) << 2, __builtin_bit_cast(int, ss)));
          ss += __builtin_bit_cast(float, __builtin_amdgcn_ds_bpermute((lane ^ 4) << 2, __builtin_bit_cast(int, ss)));
          const float rs = 1.0f / sqrtf(ss * (1.f / 128.f) + EPS);
          const float g1[8] = {ga.x, ga.y, ga.z, ga.w, gb.x, gb.y, gb.z, gb.w}, g2[8] = {gc.x, gc.y, gc.z, gc.w, gd.x, gd.y, gd.z, gd.w};
          const float cc[8] = {c0.x, c0.z, c1.x, c1.z, c2.x, c2.z, c3.x, c3.z}, sn[8] = {c0.y, c0.w, c1.y, c1.w, c2.y, c2.w, c3.y, c3.w};
#pragma unroll
          for (int e = 0; e < 8; ++e) { const float p = x1[e] * rs * g1[e], q = x2[e] * rs * g2[e]; x1[e] = p * cc[e] - q * sn[e]; x2[e] = q * cc[e] + p * sn[e]; }
          *(u32x4*)hp = pack8(x1); *(u32x4*)(hp + 32) = pack8(x2); }
      }
    }
}
__device__ __forceinline__ void ph_ynorm(bf16_t* Y, const float* g, int gw, int NGW, int lane) {
    for (int m = gw; m < T; m += NGW) {
        u32x4* p = (u32x4*)(Y + (size_t)m * DM) + lane; float x[4][8]; float sa = 0.f, sb = 0.f, sc = 0.f;
#pragma unroll
        for (int j = 0; j < 4; ++j) { const u32x4 w = p[64 * j];
            x[j][0] = bflo(w.x); x[j][1] = bfhi(w.x); x[j][2] = bflo(w.y); x[j][3] = bfhi(w.y); x[j][4] = bflo(w.z); x[j][5] = bfhi(w.z); x[j][6] = bflo(w.w); x[j][7] = bfhi(w.w);
            float ss = 0.f;
#pragma unroll
            for (int e = 0; e < 8; ++e) ss += x[j][e] * x[j][e];
            if (j == 0) sa += ss; else if (j == 1) sb += ss; else if (j == 2) { if (lane < 32) sb += ss; else sc += ss; } else sc += ss; }
        const float ra_ = 1.0f / sqrtf(wave_sum(sa, lane) * (1.f / 512.f) + EPS), rb_ = 1.0f / sqrtf(wave_sum(sb, lane) * (1.f / 768.f) + EPS), rc_ = 1.0f / sqrtf(wave_sum(sc, lane) * (1.f / 768.f) + EPS);
#pragma unroll
        for (int j = 0; j < 4; ++j) { const float rs = (j == 0) ? ra_ : (j == 1) ? rb_ : (j == 2) ? (lane < 32 ? rb_ : rc_) : rc_;
            const float* gp = g + (lane + 64 * j) * 8; const f32x4 g0 = *(const f32x4*)gp, g1 = *(const f32x4*)(gp + 4);
            u32x4 o; o.x = cvt_pk_bf16(x[j][0] * rs * g0.x, x[j][1] * rs * g0.y); o.y = cvt_pk_bf16(x[j][2] * rs * g0.z, x[j][3] * rs * g0.w);
            o.z = cvt_pk_bf16(x[j][4] * rs * g1.x, x[j][5] * rs * g1.y); o.w = cvt_pk_bf16(x[j][6] * rs * g1.z, x[j][7] * rs * g1.w);
            p[64 * j] = o; }
    }
}

#if defined(__HIP_DEVICE_COMPILE__)
__device__ __forceinline__ void ph_attention(const __attribute__((address_space(4))) Args* ap, int l, LAS unsigned char* lds, const int rep) {
    volatile LAS int* slot = (volatile LAS int*)(lds + LDS_SLOT);
#if !defined(NO_ATT_A)
    for (;;) {
        asm volatile("" : "+s"(ap));
        unsigned char* ws = ap->ws;
        const bf16_t* QA = (const bf16_t*)(ws + WS_QA); const bf16_t* KA = (const bf16_t*)(ws + WS_KA);
        const bf16_t* VA = (const bf16_t*)(ws + WS_VA); bf16_t* Y = (bf16_t*)(ws + WS_XN); const f32x2* ra = (const f32x2*)(ws + WS_ROPEA);
        if (threadIdx.x == 0) *slot = (int)__hip_atomic_fetch_add((unsigned*)(ws + WS_CTL) + 64 * (1 + l + 4 * rep), 1u, __ATOMIC_RELAXED, __HIP_MEMORY_SCOPE_AGENT);
        __syncthreads(); const int u = __builtin_amdgcn_readfirstlane(*slot); __syncthreads();
        if (u >= 256) break;
        int tid = threadIdx.x; asm volatile("" : "+v"(tid));
        const int b = u >> 6, h = (u >> 4) & 3, qb = u & 15; const size_t row = (size_t)b * SEQ + qb * 256;
        att::attn_unit<192, false, 1>(QA + row * 768 + h * 192, 768, KA + (size_t)b * SEQ * 768 + h * 192, 768, VA + (size_t)b * SEQ * 512 + h * 128, 512,
                                      Y + row * DM + h * 128, DM, SEQ / 64, 0.07216878364870322f, (LAS char*)lds, ra, qb * 256, 0, tid, (u64*)(ws + WS_CTL + YSS_OFF) + ((size_t)l * T + row) * 4 + 0);
    }
#endif
    for (;;) {
        asm volatile("" : "+s"(ap));
        unsigned char* ws = ap->ws;
        const bf16_t* PROJ = (const bf16_t*)(ws + WS_BIG); bf16_t* Y = (bf16_t*)(ws + WS_XN);
        if (threadIdx.x == 0) *slot = (int)__hip_atomic_fetch_add((unsigned*)(ws + WS_CTL) + 64 * (3 + l + 4 * rep), 1u, __ATOMIC_RELAXED, __HIP_MEMORY_SCOPE_AGENT);
        __syncthreads(); const int v = __builtin_amdgcn_readfirstlane(*slot); __syncthreads();
        if (v >= 768) break;
        int tid = threadIdx.x; asm volatile("" : "+v"(tid));
#if !defined(NO_ATT_C)
        if (v < 384) { const int b = v / 96, h = (v >> 4) % 6, qb = v & 15, kvh = h / 3; const size_t row = (size_t)b * SEQ + qb * 256;
            att::attn_unit<128, false, 1>(PROJ + row * INP + PC_Q + h * 128, INP, PROJ + (size_t)b * SEQ * INP + PC_K + kvh * 128, INP, PROJ + (size_t)b * SEQ * INP + PC_V + kvh * 128, INP,
                                          Y + row * DM + 1280 + h * 128, DM, SEQ / 64, 0.08838834764831845f, (LAS char*)lds, nullptr, 0, 0, tid, (u64*)(ws + WS_CTL + YSS_OFF) + ((size_t)l * T + row) * 4 + 2);
        } else
#endif
#if !defined(NO_ATT_B)
        { const int w = v - 384, b = w / 96, h = (w >> 4) % 6, qb = w & 15; const size_t row = (size_t)b * SEQ + qb * 256;
            const int q0 = qb * 256, lo = q0 - 1024 < 0 ? 0 : q0 - 1024, hi_ = q0 + 1280 > SEQ ? SEQ : q0 + 1280;
            att::attn_unit<128, true, 1>(PROJ + row * INP + PB_Q + h * 128, INP, PROJ + ((size_t)b * SEQ + lo) * INP + PB_K + h * 128, INP, PROJ + ((size_t)b * SEQ + lo) * INP + PB_V + h * 128, INP,
                                         Y + row * DM + 512 + h * 128, DM, (hi_ - lo) / 64, 0.08838834764831845f, (LAS char*)lds, nullptr, 0, lo - q0, tid, (u64*)(ws + WS_CTL + YSS_OFF) + ((size_t)l * T + row) * 4 + 1);
        }
#endif
        {}
    }
    { const int it0 = (l == 0) ? TR_P0 : TR_P1, it1 = (l == 0) ? TR_P1 : 2 * I_LAYER, nun = (it1 - it0) / 16;
      for (;;) {
        asm volatile("" : "+s"(ap));
        unsigned char* ws = ap->ws;
        if (threadIdx.x == 0) *slot = (int)__hip_atomic_fetch_add((unsigned*)(ws + WS_CTL) + 64 * (9 + l + 2 * rep), 1u, __ATOMIC_RELAXED, __HIP_MEMORY_SCOPE_AGENT);
        __syncthreads(); const int c = __builtin_amdgcn_readfirstlane(*slot); __syncthreads();
        if (c >= nun) break;
        int tid = threadIdx.x; asm volatile("" : "+v"(tid));
        const int lane = tid & 63, wave = __builtin_amdgcn_readfirstlane(tid >> 6);
        const Args a = *ap;
        const TrJob j0 = tr_job(a, ws, it0 + 16 * c + wave), j1 = tr_job(a, ws, it0 + 16 * c + 8 + wave);
        f32x4 v0[8], v1[8]; tr_load(j0, lane, v0); tr_load(j1, lane, v1);
        LAS float* scr = (LAS float*)(lds + wave * 16384);
        tr_write(scr, lane, v0); tr_store(j0, scr, lane);
        tr_write(scr, lane, v1); tr_store(j1, scr, lane);
      } }
}
#endif
#if defined(__HIP_DEVICE_COMPILE__)
typedef const __attribute__((address_space(4))) Args* ArgsP;
template <int PH, int REP = 0>
__device__ __forceinline__ void run_phase(ArgsP ap, LAS unsigned char* lds) {
    asm volatile("" : "+s"(ap));
    const Args a = *ap;
    int tid = threadIdx.x, bid = blockIdx.x, G = gridDim.x; asm volatile("" : "+v"(tid)); asm volatile("" : "+s"(bid), "+s"(G));
    const int lane = tid & 63, wave = __builtin_amdgcn_readfirstlane(tid >> 6);
    const int gw = bid * NWAVES + wave, NGW = G * NWAVES;
    unsigned char* ws = a.ws;
    bf16_t* XN = (bf16_t*)(ws + WS_XN); bf16_t* BIG = (bf16_t*)(ws + WS_BIG); bf16_t* XB2 = (bf16_t*)(ws + WS_QA); u64* rss = (u64*)(ws + WS_CTL + RSS_OFF);
    if constexpr (PH == 0) ph_prologue(a, lds, gw, NGW, lane, wave);
    else if constexpr (PH == NPH - 1) ph_final(XN, a.out, a.in[15], gw, NGW, lane);
    else {
        constexpr int l = (PH - 1) / 6, sp = (PH - 1) % 6; unsigned char* wl = ws + WS_W + (size_t)l * W_LAYER;
        bf16_t* R1 = (bf16_t*)a.out;
        u64* css = (u64*)(ws + WS_CTL + CSS_OFF) + (size_t)l * T * 2;
        if constexpr (sp == 0) { pg8::Gemm g{(l == 0) ? XN : R1, (const bf16_t*)(wl + W_IN), DM, DM}; pg8::StaticOrder S; S.init(T, INP, G, bid);
            pg8::EpiBf E{BIG, nullptr, INP, 0, rss + (2 * l) * T, 1, 1.f / 2048.f, css}; pg8::gemm_phase(lds, g, S, E, tid); }
        else if constexpr (sp == 1) {
            { pg8::Gemm g{BIG + PA_CQ, (const bf16_t*)(wl + W_UQ), INP, 512}; pg8::StaticOrder S; S.init(T, 768, G, bid);
              pg8::EpiBf E{(bf16_t*)(ws + WS_QA), nullptr, 768, 0, css, 2, 1.f / 512.f, nullptr}; pg8::gemm_phase(lds, g, S, E, tid); }
            { pg8::Gemm g{BIG + PA_CKV, (const bf16_t*)(wl + W_UKV), INP, 512}; pg8::StaticOrder S; S.init(T, 1024, G, bid);
              pg8::EpiBf E{(bf16_t*)(ws + WS_KA), (bf16_t*)(ws + WS_VA), 0, 1, css + 1, 2, 1.f / 512.f, nullptr}; pg8::gemm_phase(lds, g, S, E, tid); }
            ph_prep(a, l, gw, NGW, lane);
        }
        else if constexpr (sp == 2) ph_attention(ap, l, lds, REP);
        else if constexpr (sp == 3) { pg8::Gemm g{XN, (const bf16_t*)(wl + W_OUT), DM, DM}; pg8::StaticOrder S; S.init(T, DM, G, bid);
            pg8::EpiRes E{(l == 0) ? a.in[0] : nullptr, (l == 0) ? nullptr : R1, nullptr, XB2, DM, rss + (2 * l + 1) * T, (const u64*)(ws + WS_CTL + YSS_OFF) + (size_t)l * T * 4}; pg8::gemm_phase(lds, g, S, E, tid); }
        else if constexpr (sp == 4) { pg8::Gemm g{XB2, (const bf16_t*)(wl + W_GU), DM, DM}; pg8::StaticOrder S; S.init(T, 2 * DFF, G, bid);
            pg8::EpiBf E{BIG, nullptr, DFF, 2, rss + (2 * l + 1) * T, 1, 1.f / 2048.f, nullptr}; pg8::gemm_phase(lds, g, S, E, tid); }
        else { pg8::Gemm g{BIG, (const bf16_t*)(wl + W_DN), DFF, DFF}; pg8::StaticOrder S; S.init(T, DM, G, bid);
            pg8::EpiRes E{nullptr, XB2, nullptr, (l == 0) ? R1 : XN, DM, (l == 0) ? rss + 2 * T : nullptr, nullptr}; pg8::gemm_phase(lds, g, S, E, tid); }
    }
}

#endif
__global__ void __launch_bounds__(NWAVES * 64, 2) mega_fwd(Args a_unused) {
#if defined(__HIP_DEVICE_COMPILE__)
    extern __shared__ __attribute__((aligned(16))) unsigned char lds_raw[];
    LAS unsigned char* lds = (LAS unsigned char*)lds_raw;
    ArgsP ap = (ArgsP)__builtin_amdgcn_kernarg_segment_ptr();
    const int ph_lo = ap->ph_lo, ph_hi = ap->ph_hi;
    XcdBarrier xbar; xbar.bar = (unsigned*)(ap->ws + WS_CTL) + 4096; xbar.x = 0; xbar.st = (volatile LAS unsigned*)(lds + LDS_SLOT + 16);
    if (ph_hi - ph_lo > 1) {
        if (threadIdx.x < 2) xbar.st[threadIdx.x] = 0u;
        __syncthreads();
        xbar = xcd_barrier_post(xbar.bar, xbar.st);
    }
#define GRID_BAR() do { xcd_barrier(xbar); } while (0)
#define RUN_AGAIN(PH) do { if (ph_lo <= (PH) && (PH) + 1 < ph_hi) { run_phase<PH, 1>(ap, lds); GRID_BAR(); } } while (0)
#define RUN_PHASE(PH) do { if (ph_lo <= (PH) && (PH) < ph_hi) { run_phase<PH>(ap, lds); if ((PH) + 1 < ph_hi) { if ((PH) == 0) { __syncthreads(); cg::this_grid().sync(); } else GRID_BAR(); } } } while (0)
#define PA(PH) do { if (PROBE_ATT) RUN_AGAIN(PH); } while (0)
#define PG(PH) do { if (PROBE_GEMM) RUN_AGAIN(PH); } while (0)
#define PE(PH) do { if (PROBE_ELEM) RUN_AGAIN(PH); } while (0)
    RUN_PHASE(0); PE(0); RUN_PHASE(1); RUN_PHASE(2); RUN_PHASE(3); PA(3); RUN_PHASE(4); RUN_PHASE(5); PG(5); RUN_PHASE(6);
    RUN_PHASE(7); RUN_PHASE(8); RUN_PHASE(9); PA(9); RUN_PHASE(10); RUN_PHASE(11); PG(11); RUN_PHASE(12); RUN_PHASE(13);
#undef RUN_PHASE
#endif
}

extern "C" void kernel_launch(void* const* d_in, const int* in_sizes, int n_in, void* d_out, int out_size, void* d_ws, size_t ws_size, hipStream_t stream) {
    static int grid = 0;
    if (grid == 0) {
        if (n_in != 16 || out_size != T * DM || ws_size < WS_END) { fprintf(stderr, "kernel_launch: unexpected shapes n_in %d out %d ws %zu (need %zu)\n", n_in, out_size, ws_size, (size_t)WS_END); grid = -1; return; }
        int dev = 0, cus = 0, per_cu = 0;
        hipGetDevice(&dev); hipDeviceGetAttribute(&cus, hipDeviceAttributeMultiprocessorCount, dev);
        if (hipFuncSetAttribute((const void*)mega_fwd, hipFuncAttributeMaxDynamicSharedMemorySize, LDS_BYTES) != hipSuccess) { fprintf(stderr, "kernel_launch: hipFuncSetAttribute failed\n"); grid = -1; return; }
        hipOccupancyMaxActiveBlocksPerMultiprocessor(&per_cu, (const void*)mega_fwd, NWAVES * 64, LDS_BYTES);
        (void)hipGetLastError();
        if (per_cu < 1) per_cu = 1;
        grid = cus * 1;
    }
    if (grid < 0) return;
    hipMemsetAsync((char*)d_ws + WS_CTL, 0, 32768, stream);
    Args a{};
    for (int i = 0; i < 16; ++i) a.in[i] = (const float*)d_in[i];
    a.out = (float*)d_out; a.ws = (unsigned char*)d_ws;
#if MK_SINGLE
    a.ph_lo = 0; a.ph_hi = NPH;
    void* args[] = {&a};
    hipError_t e = hipLaunchCooperativeKernel((const void*)mega_fwd, dim3(grid), dim3(NWAVES * 64), args, LDS_BYTES, stream);
    if (e != hipSuccess) fprintf(stderr, "cooperative launch failed: %s (grid %d)\n", hipGetErrorString(e), grid);
#else
    for (int ph = 0; ph < NPH; ++ph) { a.ph_lo = ph; a.ph_hi = ph + 1;
        hipLaunchKernelGGL(mega_fwd, dim3(grid), dim3(NWAVES * 64), LDS_BYTES, stream, a); }
#endif
}
```
